# Optimizing an MI355X kernel written in HIP

```python
import math
import jax, jax.numpy as jnp
from jax import lax
import numpy as np

D_MODEL = 1024
BATCH = 8
SEQ = 4096
DEPTH = 1

GRID_W = 64
CTX_LEN = 256
EPS = 1e-6
S5_WIDTH = 512
S5_GROUP = 16
S5_GROUPS = S5_WIDTH // S5_GROUP
S5_STATE = 64
S5_DT_MIN = 1e-3
S5_DT_MAX = 1e-1
S5_MAX_RE = -1e-4
DA_HEADS = 4
DA_HEAD_DIM = 64
DA_V_DIM = 2 * DA_HEAD_DIM
DA_QK_WIDTH = DA_HEADS * 2 * DA_HEAD_DIM
DA_WIDTH = DA_HEADS * DA_V_DIM
Q_BLOCK = 128
ROPE_THETA = 10000.0
ROPE_PAIRS = DA_HEAD_DIM // 4
IN_SPLITS = (S5_WIDTH, S5_WIDTH + DA_QK_WIDTH, S5_WIDTH + 2 * DA_QK_WIDTH,
             S5_WIDTH + 2 * DA_QK_WIDTH + DA_WIDTH,
             S5_WIDTH + 2 * DA_QK_WIDTH + DA_WIDTH + D_MODEL)
IN_COLS = S5_WIDTH + 2 * DA_QK_WIDTH + DA_WIDTH + 2 * D_MODEL
N_EXPERTS = 16
EC_CAPACITY = 2
D_EXPERT = 2048

kernel_name = 'hybrid_s5_diffattn_ecmoe_dit_layer'


def rms_norm(x, w):
    xf = x.astype(jnp.float32)
    y = xf * lax.rsqrt(jnp.mean(xf * xf, axis=-1, keepdims=True) + EPS)
    return (y * w.astype(jnp.float32)).astype(x.dtype)


def modulate(h, shift, scale):
    return h * (1.0 + scale) + shift


def split_in(z):
    b, l = z.shape[:2]
    u, q, k, v, ga, gb = jnp.split(z, IN_SPLITS, axis=-1)
    q = q.reshape(b, l, DA_HEADS, 2, DA_HEAD_DIM)
    k = k.reshape(b, l, DA_HEADS, 2, DA_HEAD_DIM)
    v = v.reshape(b, l, DA_HEADS, DA_V_DIM)
    return u, q, k, v, ga, gb


def rope_1d(x, ang):
    x1, x2 = jnp.split(x, 2, axis=-1)
    cos = jnp.cos(ang)[:, None, None, :].astype(x.dtype)
    sin = jnp.sin(ang)[:, None, None, :].astype(x.dtype)
    return jnp.concatenate([x1 * cos - x2 * sin, x2 * cos + x1 * sin], axis=-1)


def rope_2d(x, row_ang, col_ang):
    half = x.shape[-1] // 2
    return jnp.concatenate([rope_1d(x[..., :half], row_ang), rope_1d(x[..., half:], col_ang)], axis=-1)


def _scan_combine(e1, e2):
    a1r, a1i, b1r, b1i = e1
    a2r, a2i, b2r, b2i = e2
    return (a2r * a1r - a2i * a1i, a2r * a1i + a2i * a1r,
            a2r * b1r - a2i * b1i + b2r, a2r * b1i + a2i * b1r + b2i)


def s5_discretise(lam_re, lam_im, log_dt, b_re, b_im):
    lam_re = jnp.minimum(lam_re.astype(jnp.float32), S5_MAX_RE)
    lam_im = lam_im.astype(jnp.float32)
    dt = jnp.exp(log_dt.astype(jnp.float32))[:, None]
    mag = jnp.exp(lam_re * dt)
    lb_re = mag * jnp.cos(lam_im * dt)
    lb_im = mag * jnp.sin(lam_im * dt)
    den = lam_re * lam_re + lam_im * lam_im
    num_re = lb_re - 1.0
    co_re = (num_re * lam_re + lb_im * lam_im) / den
    co_im = (lb_im * lam_re - num_re * lam_im) / den
    br = b_re.astype(jnp.float32)
    bi = b_im.astype(jnp.float32)
    bb_re = co_re[..., None] * br - co_im[..., None] * bi
    bb_im = co_re[..., None] * bi + co_im[..., None] * br
    return lb_re, lb_im, bb_re, bb_im


def s5_scan(u, lb_re, lb_im, bb_re, bb_im, h0, reverse):
    bu_re = jnp.einsum('blgh,gph->blgp', u, bb_re)
    bu_im = jnp.einsum('blgh,gph->blgp', u, bb_im)
    if h0 is not None:
        h0_re, h0_im = h0
        edge = -1 if reverse else 0
        bu_re = bu_re.at[:, edge].add(lb_re * h0_re - lb_im * h0_im)
        bu_im = bu_im.at[:, edge].add(lb_re * h0_im + lb_im * h0_re)
    a_re = jnp.broadcast_to(lb_re, bu_re.shape)
    a_im = jnp.broadcast_to(lb_im, bu_im.shape)
    _, _, h_re, h_im = lax.associative_scan(_scan_combine, (a_re, a_im, bu_re, bu_im),
                                            reverse=reverse, axis=1)
    return h_re, h_im


def s5_readout(h_re, h_im, c_re, c_im):
    return (jnp.einsum('blgp,ghp->blgh', h_re, c_re.astype(jnp.float32))
            - jnp.einsum('blgp,ghp->blgh', h_im, c_im.astype(jnp.float32)))


def s5_output(y, u, d_skip, w_glu, dtype):
    b, l = y.shape[:2]
    y = y + d_skip.astype(jnp.float32).reshape(S5_GROUPS, S5_GROUP) * u
    y = jax.nn.gelu(y.reshape(b, l, S5_WIDTH).astype(dtype))
    return y * jax.nn.sigmoid(y @ w_glu)


def s5_mixer(u_ctx, u_lat, p, need_ctx_out):
    b = u_lat.shape[0]
    uc = u_ctx.astype(jnp.float32).reshape(b, u_ctx.shape[1], S5_GROUPS, S5_GROUP)
    ul = u_lat.astype(jnp.float32).reshape(b, u_lat.shape[1], S5_GROUPS, S5_GROUP)
    y_lat = jnp.zeros_like(ul)
    y_ctx = jnp.zeros_like(uc)
    for d, reverse in ((0, False), (1, True)):
        disc = s5_discretise(p['s5_lam_re'][d], p['s5_lam_im'][d], p['s5_log_dt'][d],
                             p['s5_b_re'][d], p['s5_b_im'][d])
        hc_re, hc_im = s5_scan(uc, *disc, None, reverse)
        edge = 0 if reverse else -1
        hl_re, hl_im = s5_scan(ul, *disc, (hc_re[:, edge], hc_im[:, edge]), reverse)
        y_lat = y_lat + s5_readout(hl_re, hl_im, p['s5_c_re'][d], p['s5_c_im'][d])
        if need_ctx_out:
            y_ctx = y_ctx + s5_readout(hc_re, hc_im, p['s5_c_re'][d], p['s5_c_im'][d])
    out_lat = s5_output(y_lat, ul, p['s5_d'], p['w_glu'], u_lat.dtype)
    out_ctx = s5_output(y_ctx, uc, p['s5_d'], p['w_glu'], u_ctx.dtype) if need_ctx_out else None
    return out_lat, out_ctx


def diff_attention(q, k, v, lam, subln_w, lam_init):
    b, lq = q.shape[:2]
    nb = lq // Q_BLOCK
    qb = jnp.moveaxis(q.reshape(b, nb, Q_BLOCK, DA_HEADS, 2, DA_HEAD_DIM), 1, 0)
    scale = DA_HEAD_DIM ** -0.5

    def one_block(qi):
        s = jnp.einsum('bqhcd,bkhcd->bchqk', qi, k).astype(jnp.float32) * scale
        pr = jax.nn.softmax(s, axis=-1)
        pd = pr[:, 0] - lam * pr[:, 1]
        return jnp.einsum('bhqk,bkhd->bqhd', pd.astype(v.dtype), v)

    o = lax.map(one_block, qb)
    o = jnp.moveaxis(o, 0, 1).reshape(b, lq, DA_HEADS, DA_V_DIM)
    o = rms_norm(o, subln_w) * (1.0 - lam_init)
    return o.reshape(b, lq, DA_WIDTH)


def merge_branches(ya, yb, ga, gb, p):
    m = jax.nn.sigmoid(ga) * (ya @ p['w_proj_a']) + jax.nn.sigmoid(gb) * (yb @ p['w_proj_b'])
    return m @ p['w_out']


def ec_moe(h, w_router, w_gate, w_up, w_down):
    b, l, d = h.shape
    cap = EC_CAPACITY * l // N_EXPERTS
    aff = jax.nn.softmax((h @ w_router).astype(jnp.float32), axis=-1)
    gates, idx = lax.top_k(jnp.swapaxes(aff, 1, 2), cap)
    xs = jax.vmap(lambda hb, ib: hb[ib])(h, idx)
    hid = jax.nn.silu(jnp.einsum('becd,edf->becf', xs, w_gate)) * jnp.einsum('becd,edf->becf', xs, w_up)
    ys = jnp.einsum('becf,efd->becd', hid, w_down) * gates[..., None].astype(h.dtype)
    return jax.vmap(lambda yb, ib: jnp.zeros((l, d), yb.dtype).at[ib.reshape(-1)].add(yb.reshape(-1, d)))(ys, idx)


def hybrid_layer(x, xc, mod_lat, mod_ctx, p, row_ang, col_ang, lam_init, need_ctx_out):
    sh_m, sc_m, g_m, sh_f, sc_f, g_f = jnp.split(mod_lat, 6, axis=-1)
    csh_m, csc_m, cg_m, csh_f, csc_f, cg_f = jnp.split(mod_ctx, 6, axis=-1)
    h = modulate(rms_norm(x, p['norm_pre_mix']), sh_m, sc_m)
    hc = modulate(rms_norm(xc, p['norm_pre_mix']), csh_m, csc_m)
    u, q, k, v, ga, gb = split_in(h @ p['w_in'])
    uc, qc, kc, vc, gac, gbc = split_in(hc @ p['w_in'])
    ya, yac = s5_mixer(uc, u, p, need_ctx_out)
    q = rope_2d(q, row_ang, col_ang)
    k = rope_2d(k, row_ang, col_ang)
    lq1, lk1, lq2, lk2 = p['da_lambda'].astype(jnp.float32)
    lam = jnp.exp(jnp.sum(lq1 * lk1)) - jnp.exp(jnp.sum(lq2 * lk2)) + lam_init
    yb = diff_attention(q, jnp.concatenate([kc, k], axis=1), jnp.concatenate([vc, v], axis=1),
                        lam, p['da_subln'], lam_init)
    x = x + g_m * rms_norm(merge_branches(ya, yb, ga, gb, p), p['norm_post_mix'])
    h = modulate(rms_norm(x, p['norm_pre_ffn']), sh_f, sc_f)
    f = ec_moe(h, p['w_router'], p['w_exp_gate'], p['w_exp_up'], p['w_exp_down'])
    x = x + g_f * rms_norm(f, p['norm_post_ffn'])
    if need_ctx_out:
        ybc = diff_attention(qc, kc, vc, lam, p['da_subln'], lam_init)
        xc = xc + cg_m * rms_norm(merge_branches(yac, ybc, gac, gbc, p), p['norm_post_mix'])
        hc = modulate(rms_norm(xc, p['norm_pre_ffn']), csh_f, csc_f)
        fc = ec_moe(hc, p['w_router'], p['w_exp_gate'], p['w_exp_up'], p['w_exp_down'])
        xc = xc + cg_f * rms_norm(fc, p['norm_post_ffn'])
    return x, xc


def setup_inputs(seed: int = 0) -> dict:
    key = jax.random.key(seed)
    ks = jax.random.split(key, 32)

    def nrm(k, shape, scale):
        return jax.random.normal(k, shape, jnp.float32) * scale

    G, P, H = S5_GROUPS, S5_STATE, S5_GROUP
    lam_im0 = jnp.pi * jnp.arange(P, dtype=jnp.float32)
    return {
        'x': nrm(ks[0], (BATCH, SEQ, D_MODEL), 1.0),
        'c': nrm(ks[1], (BATCH, D_MODEL), 1.0),
        'ctx': nrm(ks[2], (BATCH, CTX_LEN, D_MODEL), 1.0),
        'c_ctx': nrm(ks[3], (D_MODEL,), 1.0),
        'w_ada': nrm(ks[4], (DEPTH, D_MODEL, 6 * D_MODEL), 0.5 * D_MODEL ** -0.5),
        'b_ada': nrm(ks[5], (DEPTH, 6 * D_MODEL), 0.01),
        'norm_pre_mix': 1.0 + nrm(ks[6], (DEPTH, D_MODEL), 0.05),
        'norm_post_mix': 1.0 + nrm(ks[7], (DEPTH, D_MODEL), 0.05),
        'norm_pre_ffn': 1.0 + nrm(ks[8], (DEPTH, D_MODEL), 0.05),
        'norm_post_ffn': 1.0 + nrm(ks[9], (DEPTH, D_MODEL), 0.05),
        'w_in': nrm(ks[10], (DEPTH, D_MODEL, IN_COLS), D_MODEL ** -0.5),
        's5_lam_re': -0.5 + nrm(ks[11], (DEPTH, 2, G, P), 0.01),
        's5_lam_im': lam_im0 + nrm(ks[12], (DEPTH, 2, G, P), 0.01),
        's5_log_dt': jax.random.uniform(ks[13], (DEPTH, 2, G), jnp.float32,
                                        math.log(S5_DT_MIN), math.log(S5_DT_MAX)),
        's5_b_re': nrm(ks[14], (DEPTH, 2, G, P, H), (2 * H) ** -0.5),
        's5_b_im': nrm(ks[15], (DEPTH, 2, G, P, H), (2 * H) ** -0.5),
        's5_c_re': nrm(ks[16], (DEPTH, 2, G, H, P), P ** -0.5),
        's5_c_im': nrm(ks[17], (DEPTH, 2, G, H, P), P ** -0.5),
        's5_d': nrm(ks[18], (DEPTH, S5_WIDTH), 1.0),
        'w_glu': nrm(ks[19], (DEPTH, S5_WIDTH, S5_WIDTH), S5_WIDTH ** -0.5),
        'da_lambda': nrm(ks[20], (DEPTH, 4, DA_HEAD_DIM), 0.1),
        'da_subln': 1.0 + nrm(ks[21], (DEPTH, DA_V_DIM), 0.05),
        'w_proj_a': nrm(ks[22], (DEPTH, S5_WIDTH, D_MODEL), S5_WIDTH ** -0.5),
        'w_proj_b': nrm(ks[23], (DEPTH, DA_WIDTH, D_MODEL), DA_WIDTH ** -0.5),
        'w_out': nrm(ks[24], (DEPTH, D_MODEL, D_MODEL), D_MODEL ** -0.5),
        'w_router': nrm(ks[25], (DEPTH, D_MODEL, N_EXPERTS), D_MODEL ** -0.5),
        'w_exp_gate': nrm(ks[26], (DEPTH, N_EXPERTS, D_MODEL, D_EXPERT), D_MODEL ** -0.5),
        'w_exp_up': nrm(ks[27], (DEPTH, N_EXPERTS, D_MODEL, D_EXPERT), D_MODEL ** -0.5),
        'w_exp_down': nrm(ks[28], (DEPTH, N_EXPERTS, D_EXPERT, D_MODEL), D_EXPERT ** -0.5),
    }


def reference(x, c, ctx, c_ctx, w_ada, b_ada, norm_pre_mix, norm_post_mix, norm_pre_ffn,
              norm_post_ffn, w_in, s5_lam_re, s5_lam_im, s5_log_dt, s5_b_re, s5_b_im,
              s5_c_re, s5_c_im, s5_d, w_glu, da_lambda, da_subln, w_proj_a, w_proj_b,
              w_out, w_router, w_exp_gate, w_exp_up, w_exp_down):
    seq_len = x.shape[1]
    rows = seq_len // GRID_W
    row = jnp.repeat(jnp.arange(rows), GRID_W).astype(jnp.float32)
    col = jnp.tile(jnp.arange(GRID_W), rows).astype(jnp.float32)
    inv_freq = ROPE_THETA ** (-jnp.arange(ROPE_PAIRS, dtype=jnp.float32) / ROPE_PAIRS)
    row_ang = row[:, None] * inv_freq[None, :]
    col_ang = col[:, None] * inv_freq[None, :]
    xc = ctx
    for i in range(DEPTH):
        p = {
            'norm_pre_mix': norm_pre_mix[i], 'norm_post_mix': norm_post_mix[i],
            'norm_pre_ffn': norm_pre_ffn[i], 'norm_post_ffn': norm_post_ffn[i],
            'w_in': w_in[i], 's5_lam_re': s5_lam_re[i], 's5_lam_im': s5_lam_im[i],
            's5_log_dt': s5_log_dt[i], 's5_b_re': s5_b_re[i], 's5_b_im': s5_b_im[i],
            's5_c_re': s5_c_re[i], 's5_c_im': s5_c_im[i], 's5_d': s5_d[i], 'w_glu': w_glu[i],
            'da_lambda': da_lambda[i], 'da_subln': da_subln[i], 'w_proj_a': w_proj_a[i],
            'w_proj_b': w_proj_b[i], 'w_out': w_out[i], 'w_router': w_router[i],
            'w_exp_gate': w_exp_gate[i], 'w_exp_up': w_exp_up[i], 'w_exp_down': w_exp_down[i],
        }
        mod_lat = (jax.nn.silu(c) @ w_ada[i] + b_ada[i])[:, None, :]
        mod_ctx = jax.nn.silu(c_ctx) @ w_ada[i] + b_ada[i]
        lam_init = 0.8 - 0.6 * math.exp(-0.3 * i)
        x, xc = hybrid_layer(x, xc, mod_lat, mod_ctx, p, row_ang, col_ang, lam_init,
                             need_ctx_out=(i < DEPTH - 1))
    return x
```

```cpp
#include <hip/hip_runtime.h>
#include <hip/hip_cooperative_groups.h>
#include <cstdio>
#include <cstdint>
namespace cg = cooperative_groups;

#ifndef MK_PER_PHASE
#define MK_PER_PHASE 0
#endif

#define LAS __attribute__((address_space(3)))
typedef unsigned short bf16_t;
typedef short bf16x8 __attribute__((ext_vector_type(8)));
typedef short s16x4 __attribute__((ext_vector_type(4)));
typedef float f32x4 __attribute__((ext_vector_type(4)));
typedef float f32x2 __attribute__((ext_vector_type(2)));
typedef float f32x16 __attribute__((ext_vector_type(16)));
typedef unsigned u32x4 __attribute__((ext_vector_type(4)));
typedef unsigned u32x2 __attribute__((ext_vector_type(2)));

constexpr int NB = 8, SEQ = 4096, CL = 256, LT = SEQ + CL  , DM = 1024;
constexpr int MR = NB * LT  , ML = NB * SEQ  ;
constexpr int NCH = LT / 16;
constexpr int NE = 16, CAP = 512, DE = 2048;
constexpr float EPS = 1e-6f;
constexpr float QSCALE = 0.125f * 1.4426950408889634f;

constexpr size_t MiB = 1u << 20;
constexpr size_t WS_MOD = 64 * 1024;
constexpr size_t WS_MISC = 512 * 1024;
constexpr size_t WS_BCAT = 1 * MiB;
constexpr size_t WS_WCAT = 5 * MiB;
constexpr size_t WS_WIN = 13 * MiB;
constexpr size_t WS_WGLU = 21 * MiB;
constexpr size_t WS_WA = 22 * MiB, WS_WB = 23 * MiB;
constexpr size_t WS_WOUT = 24 * MiB;
constexpr size_t WS_AFF = 26 * MiB;
constexpr size_t WS_IDX = 28 * MiB;
constexpr size_t WS_GATEV = 28 * MiB + 512 * 1024;
constexpr size_t WS_SLOT = 29 * MiB;
constexpr size_t WS_HN = 32 * MiB;
constexpr size_t WS_UH = 100 * MiB;
constexpr size_t WS_Q = 168 * MiB, WS_K = 202 * MiB, WS_V = 236 * MiB;
constexpr size_t WS_GATES = 270 * MiB;
constexpr size_t WS_S = 398 * MiB;
constexpr size_t WS_OC = 466 * MiB;
constexpr size_t WS_YA = 32 * MiB;
constexpr size_t WS_YY = 398 * MiB;
constexpr size_t WS_M = 168 * MiB;
constexpr size_t WS_H2 = 32 * MiB;
constexpr size_t WS_XS = 288 * MiB;
constexpr size_t WS_WGU = 416 * MiB;
constexpr size_t WS_HID = 32 * MiB;
constexpr size_t WS_WD = 288 * MiB;
constexpr size_t WS_YS = 352 * MiB;
constexpr size_t WS_END = 544 * MiB;

constexpr int LDS_BYTES = 147456;

__device__ __forceinline__ unsigned cvt_pk_bf16(float lo, float hi) { unsigned r; asm volatile("v_cvt_pk_bf16_f32 %0, %1, %2" : "=v"(r) : "v"(lo), "v"(hi)); return r; }
__device__ __forceinline__ float bf_lo(unsigned u) { return __uint_as_float(u << 16); }
__device__ __forceinline__ float bf_hi(unsigned u) { return __uint_as_float(u & 0xffff0000u); }
__device__ __forceinline__ float bf2f(bf16_t b) { return __uint_as_float(((unsigned)b) << 16); }
__device__ __forceinline__ float sigmoidf_(float x) { return __builtin_amdgcn_rcpf(1.0f + __expf(-x)); }
__device__ __forceinline__ float wave_sum(float v) {
#pragma unroll
    for (int o = 1; o < 64; o <<= 1) v += __shfl_xor(v, o);
    return v;
}
__device__ __forceinline__ void sincos_fast(float x, float* sn, float* cs) {
    const float k = rintf(x * 0.15915494309189535f); float r = fmaf(-k, 6.28318548202514648f, x); r = fmaf(-k, -1.74845553e-07f, r);
    *sn = __sinf(r); *cs = __cosf(r); }
__device__ __forceinline__ float gelu_tanh(float x) { const float u = 0.7978845608028654f * (x + 0.044715f * x * x * x); return x * sigmoidf_(2.0f * u); }

__device__ __forceinline__ void map_tile(int wgid, int nM, int nN, int& pm, int& pn) {
    const int nwg = nM * nN, q = nwg / 8, r = nwg % 8, xcd = wgid % 8, off = wgid / 8;
    wgid = (xcd < r ? xcd * (q + 1) : r * (q + 1) + (xcd - r) * q) + off;
    const int nig = 8 * nN, gid = wgid / nig, fm = gid * 8, gsz = (nM - fm) < 8 ? (nM - fm) : 8;
    pm = fm + ((wgid % nig) % gsz); pn = (wgid % nig) / gsz;
}

namespace pg8 {
constexpr int BM = 256, BK = 64, HALF = 128, HTB = HALF * BK * 2, STAGE_BYTES = 8 * HTB;
__device__ __forceinline__ int lds_byte(int r, int c) { const int st = (r >> 4) * 2 + (c >> 5), rr = r & 15, cc = c & 31, ob = rr * 64 + cc * 2; return st * 1024 + (ob ^ (((ob >> 9) & 1) << 5)); }
__device__ __forceinline__ void stage_rc(int b, int& R, int& C) { const int st = b / 1024, sb = b % 1024, swz = sb ^ (((sb >> 9) & 1) << 5); R = (st >> 1) * 16 + swz / 64; C = (st & 1) * 32 + (swz % 64) / 2; }
__device__ __forceinline__ int perm32(int rho) { const int n = rho >> 4, i = rho & 15; return 8 * (i >> 2) + 4 * n + (i & 3); }

struct Unit { const char* a; const char* b; int r0, c0, aux; };

template <class Epi, class Sched>
__device__ __forceinline__ void gemm_phase(LAS unsigned char* lds, const int lda, const int ldb, const int K, Sched& S, const Epi& E) {
    const int tid = threadIdx.x, wid = __builtin_amdgcn_readfirstlane(tid >> 6), lane = tid & 63, wr = wid >> 2, wc = wid & 3, fr = lane & 15, fq = lane >> 4;
    const int nt = K / BK;
    unsigned voffA[2], voffB[2];
#pragma unroll
    for (int i = 0; i < 2; ++i) { int R, C; stage_rc(tid * 16 + i * 8192, R, C); const int Rb = Epi::PERM ? ((R & ~31) + perm32(R & 31)) : R;
        voffA[i] = (unsigned)(R * lda + C) * 2u; voffB[i] = (unsigned)(Rb * ldb + C) * 2u; }
    const size_t kstep = (size_t)(BK * 2);
    const size_t hstepA = (size_t)HALF * lda * 2, hstepB = (size_t)HALF * ldb * 2;
    const unsigned ldsw = (unsigned)wid * 1024u;
    const int aoff = lds_byte(wr * 64 + fr, fq * 8), boff = lds_byte(wc * 32 + fr, fq * 8);
#define PG8_SA(b, h) (((b) * 2 + (h)) * HTB)
#define PG8_SB(b, h) ((4 + (b) * 2 + (h)) * HTB)
#define PG8_STAGE(bufoff, gbase, voff) do { _Pragma("unroll") for (int _i = 0; _i < 2; ++_i) \
        __builtin_amdgcn_global_load_lds((const unsigned*)((const char*)(gbase) + (voff)[_i]), (LAS unsigned*)(lds + (bufoff) + ldsw + _i * 8192), 16, 0, 0); } while (0)
#define PG8_LDA(dst, b, h) do { _Pragma("unroll") for (int m = 0; m < 4; ++m) _Pragma("unroll") for (int k = 0; k < 2; ++k) dst[m][k] = *(const LAS bf16x8*)(lds + PG8_SA(b, h) + aoff + m * 2048 + k * 1024); } while (0)
#define PG8_LDB(dst, b, h) do { _Pragma("unroll") for (int n = 0; n < 2; ++n) _Pragma("unroll") for (int k = 0; k < 2; ++k) dst[n][k] = *(const LAS bf16x8*)(lds + PG8_SB(b, h) + boff + n * 2048 + k * 1024); } while (0)
#define PG8_MMA(ai, bj, At, Bt) do { __builtin_amdgcn_s_setprio(1); _Pragma("unroll") for (int m = 0; m < 4; ++m) _Pragma("unroll") for (int n = 0; n < 2; ++n) _Pragma("unroll") for (int k = 0; k < 2; ++k) \
        acc[ai][bj][m][n] = __builtin_amdgcn_mfma_f32_16x16x32_bf16(Bt[n][k], At[m][k], acc[ai][bj][m][n], 0, 0, 0); __builtin_amdgcn_s_setprio(0); } while (0)
#define PG8_WAIT_V(n) asm volatile("s_waitcnt vmcnt(" #n ")" ::: "memory")
#define PG8_WAIT_L(n) asm volatile("s_waitcnt lgkmcnt(" #n ")" ::: "memory")
#define PG8_BAR __builtin_amdgcn_s_barrier()
#define PG8_SCHED __builtin_amdgcn_sched_barrier(0)
    Unit cur, nxt;
    if (!S.next(cur)) return;
    f32x4 acc[2][2][4][2];
#pragma unroll
    for (int a = 0; a < 2; ++a)
#pragma unroll
        for (int b = 0; b < 2; ++b)
#pragma unroll
            for (int m = 0; m < 4; ++m)
#pragma unroll
                for (int n = 0; n < 2; ++n) acc[a][b][m][n] = (f32x4){0.f, 0.f, 0.f, 0.f};
    bf16x8 At[4][2], B0[2][2], B1[2][2];
    const char* cA = cur.a; const char* cB = cur.b;
    PG8_STAGE(PG8_SB(0, 0), cB, voffB); PG8_STAGE(PG8_SB(0, 1), cB + hstepB, voffB); PG8_STAGE(PG8_SA(0, 0), cA, voffA); PG8_STAGE(PG8_SA(0, 1), cA + hstepA, voffA);
    if (wr == 1) PG8_BAR;
    PG8_WAIT_V(2); PG8_BAR;
    PG8_STAGE(PG8_SB(1, 0), cB + kstep, voffB); PG8_STAGE(PG8_SA(1, 0), cA + kstep, voffA); PG8_STAGE(PG8_SB(1, 1), cB + hstepB + kstep, voffB);
    PG8_WAIT_V(6); PG8_BAR;
    for (;;) {
        const bool has_next = S.next(nxt);
        const char* nA = has_next ? nxt.a : cA; const char* nB = has_next ? nxt.b : cB;
#pragma unroll 1
        for (int t = 0; t < nt; t += 2) {
            const bool last = (t == nt - 2);
            const char* a1 = cA + (size_t)(t + 1) * kstep;
            const char* a2 = last ? nA : cA + (size_t)(t + 2) * kstep; const char* b2 = last ? nB : cB + (size_t)(t + 2) * kstep;
            const char* a3 = a2 + kstep; const char* b3 = b2 + kstep;
            PG8_LDB(B0, 0, 0); PG8_LDB(B1, 0, 1); PG8_SCHED; PG8_LDA(At, 0, 0); PG8_STAGE(PG8_SA(1, 1), a1 + hstepA, voffA);
            PG8_WAIT_V(8); PG8_WAIT_L(0); PG8_BAR; PG8_MMA(0, 0, At, B0); PG8_MMA(0, 1, At, B1); PG8_BAR; PG8_SCHED;
            PG8_LDA(At, 0, 1); PG8_STAGE(PG8_SB(0, 0), b2, voffB); PG8_STAGE(PG8_SB(0, 1), b2 + hstepB, voffB); PG8_STAGE(PG8_SA(0, 0), a2, voffA);
            PG8_WAIT_V(8); PG8_WAIT_L(0); PG8_BAR; PG8_MMA(1, 0, At, B0); PG8_MMA(1, 1, At, B1); PG8_BAR; PG8_SCHED;
            PG8_LDB(B0, 1, 0); PG8_LDB(B1, 1, 1); PG8_SCHED; PG8_LDA(At, 1, 0); PG8_STAGE(PG8_SA(0, 1), a2 + hstepA, voffA);
            PG8_WAIT_V(8); PG8_WAIT_L(0); PG8_BAR; PG8_MMA(0, 0, At, B0); PG8_MMA(0, 1, At, B1); PG8_BAR; PG8_SCHED;
            PG8_LDA(At, 1, 1); PG8_STAGE(PG8_SB(1, 0), b3, voffB); PG8_STAGE(PG8_SB(1, 1), b3 + hstepB, voffB); PG8_STAGE(PG8_SA(1, 0), a3, voffA);
            PG8_WAIT_V(8); PG8_WAIT_L(0); PG8_BAR; PG8_MMA(1, 0, At, B0); PG8_MMA(1, 1, At, B1); PG8_BAR; PG8_SCHED;
        }
        if (wr == 0) PG8_BAR;
        const bool zero = E(acc, cur, wr, wc, fr, fq);
        if (!has_next) break;
        if (zero) {
#pragma unroll
            for (int a = 0; a < 2; ++a)
#pragma unroll
                for (int b = 0; b < 2; ++b)
#pragma unroll
                    for (int m = 0; m < 4; ++m)
#pragma unroll
                        for (int n = 0; n < 2; ++n) acc[a][b][m][n] = (f32x4){0.f, 0.f, 0.f, 0.f};
        }
        cur = nxt; cA = nA; cB = nB;
        if (wr == 1) PG8_BAR;
    }
    PG8_WAIT_V(0);
    PG8_BAR;
#undef PG8_SA
#undef PG8_SB
#undef PG8_STAGE
#undef PG8_LDA
#undef PG8_LDB
#undef PG8_MMA
#undef PG8_WAIT_V
#undef PG8_WAIT_L
#undef PG8_BAR
#undef PG8_SCHED
}
}
using pg8::Unit;

namespace att {
constexpr int QBLK = 32, KVBLK = 64, LD = 512;
constexpr int SHM_V = KVBLK * 128 * 2, SHM_K = KVBLK * 64 * 2;
constexpr int OFF_V = 0, OFF_K = 2 * SHM_V, OFF_WS = OFF_K + 2 * SHM_K, ATT_LDS = OFF_WS + 8 * 64 * 4;
constexpr float THRL = 8.0f;
#define KSWZ(row, colB) ((row) * 128 + ((colB) ^ ((((row) >> 1) & 7) << 4)))
#define SBAR() __builtin_amdgcn_sched_barrier(0)
__device__ __forceinline__ int crow(int r, int hi) { return (r & 3) + 8 * (r >> 2) + 4 * hi; }

__device__ __forceinline__ void partialSM(f32x16& p0, f32x16& p1, float& m_reg, float& alpha) {
    float pmax = p0[0];
#pragma unroll
    for (int r = 1; r < 16; ++r) pmax = fmaxf(pmax, p0[r]);
#pragma unroll
    for (int r = 0; r < 16; ++r) pmax = fmaxf(pmax, p1[r]);
    { auto rr = __builtin_amdgcn_permlane32_swap(__float_as_uint(pmax), __float_as_uint(pmax), false, false);
      pmax = fmaxf(__uint_as_float(rr[0]), __uint_as_float(rr[1])); }
    if (__builtin_expect(__all(pmax - m_reg <= THRL), 1)) { alpha = 1.f; }
    else { const float mn = fmaxf(m_reg, pmax); alpha = __builtin_amdgcn_exp2f(m_reg - mn); m_reg = mn; }
    const float mm = m_reg;
#pragma unroll
    for (int r = 0; r < 16; ++r) p0[r] = p0[r] - mm;
#pragma unroll
    for (int r = 0; r < 16; ++r) p1[r] = p1[r] - mm;
#pragma unroll
    for (int r = 0; r < 16; ++r) p0[r] = __builtin_amdgcn_exp2f(p0[r]);
}
__device__ __forceinline__ void finishSM(f32x16& p0, f32x16& p1, float alpha, float& l_reg, bf16x8& pa0, bf16x8& pa1, bf16x8& pa2, bf16x8& pa3) {
#pragma unroll
    for (int r = 0; r < 16; ++r) p1[r] = __builtin_amdgcn_exp2f(p1[r]);
    float ps = 0;
#pragma unroll
    for (int r = 0; r < 16; ++r) ps += p0[r];
#pragma unroll
    for (int r = 0; r < 16; ++r) ps += p1[r];
    { auto rr = __builtin_amdgcn_permlane32_swap(__float_as_uint(ps), __float_as_uint(ps), false, false);
      ps = __uint_as_float(rr[0]) + __uint_as_float(rr[1]); }
    l_reg = l_reg * alpha + ps;
#define PK4(P, BASE, OUT) do { unsigned a0 = cvt_pk_bf16(P[BASE + 0], P[BASE + 1]), a1 = cvt_pk_bf16(P[BASE + 2], P[BASE + 3]);   \
    unsigned b0 = cvt_pk_bf16(P[BASE + 4], P[BASE + 5]), b1 = cvt_pk_bf16(P[BASE + 6], P[BASE + 7]);                              \
    auto r0 = __builtin_amdgcn_permlane32_swap(a0, b0, false, false); auto r1 = __builtin_amdgcn_permlane32_swap(a1, b1, false, false); \
    u32x4 w = {r0[0], r1[0], r0[1], r1[1]}; OUT = *reinterpret_cast<bf16x8*>(&w); } while (0)
    PK4(p0, 0, pa0); PK4(p0, 8, pa1); PK4(p1, 0, pa2); PK4(p1, 8, pa3);
#undef PK4
}
__device__ __forceinline__ void qkt(f32x16& p0, f32x16& p1, const char* Ks, const bf16x8* qr, int r32, int hi) {
    p0 = f32x16{}; p1 = f32x16{};
#pragma unroll
    for (int d0 = 0; d0 < 4; ++d0) { const int cb = (d0 * 16 + hi * 8) * 2;
        const bf16x8 b0 = *reinterpret_cast<const bf16x8*>(Ks + KSWZ(r32, cb));
        const bf16x8 b1 = *reinterpret_cast<const bf16x8*>(Ks + KSWZ(32 + r32, cb));
        p0 = __builtin_amdgcn_mfma_f32_32x32x16_bf16(b0, qr[d0], p0, 0, 0, 0);
        p1 = __builtin_amdgcn_mfma_f32_32x32x16_bf16(b1, qr[d0], p1, 0, 0, 0); }
}
__device__ __forceinline__ int v_st(int k, int c) { const int kk = (k & ~0xC) | ((k & 4) << 1) | ((k & 8) >> 1); return ((kk >> 3) * 4 + (c >> 5)) * 512 + ((kk & 7) * 32 + (c & 31)) * 2; }
__device__ __forceinline__ int v_rd_base(int lane) { return ((lane & 3) << 3) | (((lane >> 2) & 3) << 6) | (((lane >> 4) & 1) << 5) | (((lane >> 5) & 1) << 8); }
constexpr int v_rd_off(int d0, int ks, int half) { return d0 * 512 + ks * 4096 + half * 2048; }
template <int OFF> __device__ __forceinline__ s16x4 tr_read(int vb) {
    s16x4 r; asm volatile("ds_read_b64_tr_b16 %0, %1 offset:%2" : "=&v"(r) : "v"(vb), "i"(OFF) : "memory"); return r;
}
template <int D0> __device__ __forceinline__ void pv_one(f32x16& od, int vb, bf16x8 pa0, bf16x8 pa1, bf16x8 pa2, bf16x8 pa3) {
    const s16x4 l0 = tr_read<v_rd_off(D0, 0, 0)>(vb), h0 = tr_read<v_rd_off(D0, 0, 1)>(vb), l1 = tr_read<v_rd_off(D0, 1, 0)>(vb), h1 = tr_read<v_rd_off(D0, 1, 1)>(vb);
    const s16x4 l2 = tr_read<v_rd_off(D0, 2, 0)>(vb), h2 = tr_read<v_rd_off(D0, 2, 1)>(vb), l3 = tr_read<v_rd_off(D0, 3, 0)>(vb), h3 = tr_read<v_rd_off(D0, 3, 1)>(vb);
    asm volatile("s_waitcnt lgkmcnt(0)" ::: "memory"); SBAR();
#define PK(L, H) (bf16x8){L[0], L[1], L[2], L[3], H[0], H[1], H[2], H[3]}
    od = __builtin_amdgcn_mfma_f32_32x32x16_bf16(pa0, PK(l0, h0), od, 0, 0, 0);
    od = __builtin_amdgcn_mfma_f32_32x32x16_bf16(pa1, PK(l1, h1), od, 0, 0, 0);
    od = __builtin_amdgcn_mfma_f32_32x32x16_bf16(pa2, PK(l2, h2), od, 0, 0, 0);
    od = __builtin_amdgcn_mfma_f32_32x32x16_bf16(pa3, PK(l3, h3), od, 0, 0, 0);
#undef PK
}
__device__ __forceinline__ void pv_d0(f32x16* o, int vb, bf16x8 pa0, bf16x8 pa1, bf16x8 pa2, bf16x8 pa3) {
    pv_one<0>(o[0], vb, pa0, pa1, pa2, pa3); pv_one<1>(o[1], vb, pa0, pa1, pa2, pa3); pv_one<2>(o[2], vb, pa0, pa1, pa2, pa3); pv_one<3>(o[3], vb, pa0, pa1, pa2, pa3);
}

__device__ __forceinline__ void attn_unit(const bf16_t* Qb, const bf16_t* Kh, const bf16_t* Vh, bf16_t* Ob, int seq, char* lds) {
    const int tid = threadIdx.x, wid = tid >> 6, lane = tid & 63, r32 = lane & 31, hi = lane >> 5;
    char* V_lds = lds + OFF_V; char* K_lds = lds + OFF_K;
    float* ws = (float*)(lds + OFF_WS) + wid * 64; float* li_l = ws; float* al_l = ws + 32;
    float m_reg = -1e30f, l_reg = 0; f32x16 o[4] = {}; bf16x8 qr[4];
    const bf16_t* Qw = Qb + (long)(wid * QBLK + r32) * LD + hi * 8;
#pragma unroll
    for (int d0 = 0; d0 < 4; ++d0) qr[d0] = *reinterpret_cast<const bf16x8*>(Qw + d0 * 16);
    const int sr = tid >> 4, sc = (tid & 15) * 8, vst0 = v_st(sr, sc), vst1 = v_st(32 + sr, sc);
    const int kr = tid >> 3, kc = (tid & 7) * 8, kst = KSWZ(kr, kc * 2);
    const int vb0 = (int)(uintptr_t)V_lds + v_rd_base(lane);
    struct { bf16x8 vs0, vs1, ks0; } sr_[2];
#define SLOAD(i, k0) do { sr_[i].vs0 = *reinterpret_cast<const bf16x8*>(&Vh[(long)((k0) + sr) * LD + sc]); sr_[i].vs1 = *reinterpret_cast<const bf16x8*>(&Vh[(long)((k0) + 32 + sr) * LD + sc]); \
    sr_[i].ks0 = *reinterpret_cast<const bf16x8*>(&Kh[(long)((k0) + kr) * LD + kc]); } while (0)
#define SWRITE(b, i) do { *(bf16x8*)(V_lds + (b) * SHM_V + vst0) = sr_[i].vs0; *(bf16x8*)(V_lds + (b) * SHM_V + vst1) = sr_[i].vs1; \
    *(bf16x8*)(K_lds + (b) * SHM_K + kst) = sr_[i].ks0; } while (0)
#define SWAIT() asm volatile("s_waitcnt vmcnt(3)" ::: "memory")
#define RESC(a) do { if (__any((a) < 1.f)) { if (hi == 0) al_l[r32] = (a); asm volatile("s_waitcnt lgkmcnt(0)" ::: "memory"); \
    _Pragma("unroll") for (int d = 0; d < 4; ++d) _Pragma("unroll") for (int r = 0; r < 16; ++r) o[d][r] *= al_l[crow(r, hi)]; } } while (0)
    f32x16 pA0, pA1, pB0, pB1; float alA, alB; bf16x8 pa0, pa1, pa2, pa3; const int NT = seq / KVBLK;
    constexpr int SE = 0, SO = 1;
    SLOAD(SE, 0); asm volatile("s_waitcnt vmcnt(0)" ::: "memory"); SWRITE(0, SE); __syncthreads();
    qkt(pA0, pA1, K_lds, qr, r32, hi); partialSM(pA0, pA1, m_reg, alA);
    SLOAD(SO, KVBLK); if (2 < NT) SLOAD(SE, 2 * KVBLK);
    SWAIT(); SWRITE(1, SO); __syncthreads();
    for (int j = 1; j + 1 < NT; j += 2) {
        SBAR(); qkt(pB0, pB1, K_lds + SHM_K, qr, r32, hi);
        finishSM(pA0, pA1, alA, l_reg, pa0, pa1, pa2, pa3); SBAR();
        SLOAD(SO, (j + 2) * KVBLK); SBAR();
        pv_d0(o, vb0, pa0, pa1, pa2, pa3); partialSM(pB0, pB1, m_reg, alB);
        __syncthreads(); SWAIT(); SWRITE(0, SE);
        RESC(alB); __syncthreads();
        SBAR(); qkt(pA0, pA1, K_lds, qr, r32, hi);
        finishSM(pB0, pB1, alB, l_reg, pa0, pa1, pa2, pa3); SBAR();
        if (j + 3 < NT) SLOAD(SE, (j + 3) * KVBLK); SBAR();
        pv_d0(o, vb0 + SHM_V, pa0, pa1, pa2, pa3); partialSM(pA0, pA1, m_reg, alA);
        __syncthreads(); SWAIT(); SWRITE(1, SO);
        RESC(alA); __syncthreads();
    }
    SBAR(); qkt(pB0, pB1, K_lds + SHM_K, qr, r32, hi);
    finishSM(pA0, pA1, alA, l_reg, pa0, pa1, pa2, pa3); SBAR();
    pv_d0(o, vb0, pa0, pa1, pa2, pa3); partialSM(pB0, pB1, m_reg, alB);
    __syncthreads(); RESC(alB);
    finishSM(pB0, pB1, alB, l_reg, pa0, pa1, pa2, pa3); SBAR();
    pv_d0(o, vb0 + SHM_V, pa0, pa1, pa2, pa3);
    if (hi == 0) li_l[r32] = l_reg; asm volatile("s_waitcnt lgkmcnt(0)" ::: "memory");
    float rli[16];
#pragma unroll
    for (int r = 0; r < 16; ++r) rli[r] = __builtin_amdgcn_rcpf(li_l[crow(r, hi)]);
    bf16_t* Ow = Ob + (long)(wid * QBLK) * LD;
#pragma unroll
    for (int r = 0; r < 16; ++r) { const int orow = crow(r, hi);
#pragma unroll
        for (int d0 = 0; d0 < 4; ++d0) Ow[(long)orow * LD + d0 * 32 + r32] = (bf16_t)(cvt_pk_bf16(o[d0][r] * rli[r], 0.f) & 0xffffu); }
    __syncthreads();
#undef SLOAD
#undef SWRITE
#undef SWAIT
#undef RESC
}
#undef KSWZ
#undef SBAR
}

struct Args { const float* in[29]; float* out; unsigned char* ws; int ph_lo, ph_hi; };
enum { I_X = 0, I_C, I_CTX, I_CCTX, I_WADA, I_BADA, I_NPREMIX, I_NPOSTMIX, I_NPREFFN, I_NPOSTFFN, I_WIN, I_LAMRE, I_LAMIM, I_LOGDT, I_BRE, I_BIM,
       I_CRE, I_CIM, I_S5D, I_WGLU, I_DALAM, I_SUBLN, I_WPA, I_WPB, I_WOUT, I_WROUTER, I_WEG, I_WEU, I_WED };

__device__ __forceinline__ unsigned pk2(float lo, float hi) { return cvt_pk_bf16(lo, hi); }
__device__ __forceinline__ void transpose_item(const float* colp, size_t ld, bf16_t* dst, int dK, LAS float* scr, int lane) {
#pragma unroll 8
    for (int kk = 0; kk < 64; ++kk) scr[kk * 65 + lane] = colp[(size_t)kk * ld];
    asm volatile("s_waitcnt lgkmcnt(0)" ::: "memory");
    const int c = lane & 7;
#pragma unroll
    for (int j = 0; j < 8; ++j) { const int n = (lane >> 3) + 8 * j; const LAS float* s = scr + (8 * c) * 65 + n;
        u32x4 o; o.x = pk2(s[0 * 65], s[1 * 65]); o.y = pk2(s[2 * 65], s[3 * 65]); o.z = pk2(s[4 * 65], s[5 * 65]); o.w = pk2(s[6 * 65], s[7 * 65]);
        *(u32x4*)(dst + (size_t)n * dK + 8 * c) = o; }
    asm volatile("s_waitcnt lgkmcnt(0)" ::: "memory");
}
__device__ __forceinline__ int permq(int n) { const int p = n & 31, a = p >> 3, b = p & 7; return (n & ~31) + ((b < 4) ? (4 * a + b) : (16 + 4 * a + (b - 4))); }

__device__ __forceinline__ void mod_task(int col0, const float* c, const float* cctx, const float* wada, const float* bada, float* MOD, LAS float* L) {
    const int tid = threadIdx.x;
    LAS float* sc = L; LAS float* red = L + 9 * 1024;
    for (int i = tid; i < 9 * 1024; i += 512) { const int row = i >> 10, k = i & 1023; const float v = row < 8 ? c[row * 1024 + k] : cctx[k]; sc[i] = v * sigmoidf_(v); }
    __syncthreads();
    const int cl = tid & 31, kg = tid >> 5, col = col0 + cl;
    float acc[9];
#pragma unroll
    for (int r = 0; r < 9; ++r) acc[r] = 0.f;
#pragma unroll 4
    for (int k = kg; k < 1024; k += 16) { const float w = wada[(size_t)k * 6144 + col];
#pragma unroll
        for (int r = 0; r < 9; ++r) acc[r] += sc[r * 1024 + k] * w; }
#pragma unroll
    for (int r = 0; r < 9; ++r) red[(kg * 9 + r) * 32 + cl] = acc[r];
    __syncthreads();
    if (tid < 288) { const int r = tid >> 5, cc = tid & 31; float s = 0.f;
#pragma unroll
        for (int g = 0; g < 16; ++g) s += red[(g * 9 + r) * 32 + cc];
        MOD[r * 6144 + col0 + cc] = s + bada[col0 + cc]; }
    __syncthreads();
}

__device__ __forceinline__ void s5_tables_task(int g, int dir, const Args& A, bf16_t* Bcat, bf16_t* Wcat, LAS float* L) {
    const int tid = threadIdx.x;
    LAS float* pw_re = L; LAS float* pw_im = L + 1088; LAS float* Bb_re = L + 2176; LAS float* Bb_im = L + 3200; LAS float* C_re = L + 4224; LAS float* C_im = L + 5248;
    LAS float* Kt = L + 6272; LAS float* K0o = L + 10368; LAS float* Bb2_re = L + 10624; LAS float* Bb2_im = L + 11648; LAS float* C2_re = L + 12672; LAS float* C2_im = L + 13696;
    const float* lam_re = A.in[I_LAMRE]; const float* lam_im = A.in[I_LAMIM]; const float* log_dt = A.in[I_LOGDT];
    const float* b_re = A.in[I_BRE]; const float* b_im = A.in[I_BIM]; const float* c_re = A.in[I_CRE]; const float* c_im = A.in[I_CIM]; const float* s5d = A.in[I_S5D];
    if (tid < 128) {
        const int which = tid >> 6, p = tid & 63, d = which ? 1 - dir : dir;
        if (which == 0 || dir == 0) {
            const int gi = d * 32 + g;
            const float lr = fminf(lam_re[gi * 64 + p], -1e-4f), li = lam_im[gi * 64 + p], dt = expf(log_dt[gi]);
            const float lrd = lr * dt, lid = li * dt;
            float sn, cs; sincos_fast(lid, &sn, &cs); const float mag = expf(lrd);
            const float lb_re = mag * cs, lb_im = mag * sn, den = lr * lr + li * li, num_re = lb_re - 1.0f;
            const float co_re = (num_re * lr + lb_im * li) / den, co_im = (lb_im * lr - num_re * li) / den;
            LAS float* dre = which ? Bb2_re : Bb_re; LAS float* dim_ = which ? Bb2_im : Bb_im;
#pragma unroll 1
            for (int h = 0; h < 16; ++h) { const float br = b_re[(gi * 64 + p) * 16 + h], bi = b_im[(gi * 64 + p) * 16 + h];
                dre[p * 16 + h] = co_re * br - co_im * bi; dim_[p * 16 + h] = co_re * bi + co_im * br; }
            if (which == 0) {
#pragma unroll 1
                for (int tau = 0; tau <= 16; ++tau) { float s2, c2; sincos_fast((float)tau * lid, &s2, &c2); const float m2 = expf((float)tau * lrd);
                    pw_re[tau * 64 + p] = m2 * c2; pw_im[tau * 64 + p] = m2 * s2; } }
        }
    }
    for (int i = tid; i < 1024; i += 512) { C_re[i] = c_re[(dir * 32 + g) * 1024 + i]; C_im[i] = c_im[(dir * 32 + g) * 1024 + i];
        if (dir == 0) { C2_re[i] = c_re[(32 + g) * 1024 + i]; C2_im[i] = c_im[(32 + g) * 1024 + i]; } }
    __syncthreads();
#pragma unroll 1
    for (int j = 0; j < 8; ++j) { const int o = tid + 512 * j, tau = o >> 8, chp = (o >> 4) & 15, ch = o & 15; float acc = 0.f;
#pragma unroll 4
        for (int p = 0; p < 64; ++p) { const float cr = C_re[chp * 64 + p], ci = C_im[chp * 64 + p], wr_ = pw_re[tau * 64 + p], wi = pw_im[tau * 64 + p];
            const float tr = cr * wr_ - ci * wi, ti = cr * wi + ci * wr_; acc += tr * Bb_re[p * 16 + ch] - ti * Bb_im[p * 16 + ch]; }
        Kt[o] = acc; }
    if (dir == 0 && tid < 256) { const int chp = tid >> 4, ch = tid & 15; float acc = 0.f;
#pragma unroll 4
        for (int p = 0; p < 64; ++p) acc += C2_re[chp * 64 + p] * Bb2_re[p * 16 + ch] - C2_im[chp * 64 + p] * Bb2_im[p * 16 + ch];
        K0o[tid] = acc + (chp == ch ? s5d[g * 16 + ch] : 0.f); }
    __syncthreads();
    bf16_t* Wg = Wcat + (size_t)g * 256 * 512;
#pragma unroll 1
    for (int j = 0; j < 16; ++j) { const int q = tid + 512 * j, n = q >> 5, kc = q & 31, s = kc >> 1, ch0 = (kc & 1) * 8, t = n >> 4, chp = n & 15;
        const bool mine = (dir == 0) ? (s <= t) : (s > t);
        if (mine) { float v[8]; const int tau = (dir == 0) ? (t - s) : (s - t);
#pragma unroll
            for (int i = 0; i < 8; ++i) { v[i] = Kt[tau * 256 + chp * 16 + ch0 + i]; if (tau == 0) v[i] += K0o[chp * 16 + ch0 + i]; }
            u32x4 o; o.x = pk2(v[0], v[1]); o.y = pk2(v[2], v[3]); o.z = pk2(v[4], v[5]); o.w = pk2(v[6], v[7]);
            *(u32x4*)(Wg + (size_t)n * 512 + kc * 8) = o; } }
#pragma unroll 1
    for (int j = 0; j < 8; ++j) { const int q = tid + 512 * j, n = q >> 4, pc = q & 15, ri = pc >> 3, p0 = (pc & 7) * 8, t = n >> 4, chp = n & 15, e = (dir == 0) ? (t + 1) : (16 - t);
        float v[8];
#pragma unroll
        for (int i = 0; i < 8; ++i) { const int p = p0 + i; const float cr = C_re[chp * 64 + p], ci = C_im[chp * 64 + p], wr_ = pw_re[e * 64 + p], wi = pw_im[e * 64 + p];
            v[i] = (ri == 0) ? (cr * wr_ - ci * wi) : -(cr * wi + ci * wr_); }
        u32x4 o; o.x = pk2(v[0], v[1]); o.y = pk2(v[2], v[3]); o.z = pk2(v[4], v[5]); o.w = pk2(v[6], v[7]);
        *(u32x4*)(Wg + (size_t)n * 512 + 256 + dir * 128 + ri * 64 + p0) = o; }
    bf16_t* Bg = Bcat + (size_t)g * 256 * 256;
#pragma unroll 1
    for (int j = 0; j < 8; ++j) { const int q = tid + 512 * j, nl = q >> 5, ri = nl >> 6, p = nl & 63, kc = q & 31, s = kc >> 1, ch0 = (kc & 1) * 8, e = (dir == 0) ? (15 - s) : s;
        const float wr_ = pw_re[e * 64 + p], wi = pw_im[e * 64 + p]; float v[8];
#pragma unroll
        for (int i = 0; i < 8; ++i) { const float br = Bb_re[p * 16 + ch0 + i], bi = Bb_im[p * 16 + ch0 + i]; v[i] = (ri == 0) ? (wr_ * br - wi * bi) : (wr_ * bi + wi * br); }
        u32x4 o; o.x = pk2(v[0], v[1]); o.y = pk2(v[2], v[3]); o.z = pk2(v[4], v[5]); o.w = pk2(v[6], v[7]);
        *(u32x4*)(Bg + (size_t)(dir * 128 + nl) * 256 + kc * 8) = o; }
    __syncthreads();
}

struct SchedWin { int i, G, c; const char* A; const char* B;
    __device__ __forceinline__ bool next(Unit& u) { const int L = i * G + c; ++i; int pn, b;
        if (L < 2048) { int pm; map_tile(L, 128, 16, pm, pn); b = pm >> 4; u.r0 = (b * 17 + 1 + (pm & 15)) * 256; }
        else if (L < 2096) { const int l = L - 2048, s = l % 6; b = l / 6; pn = s < 2 ? s : s + 2; u.r0 = b * 17 * 256; }
        else return false;
        u.c0 = pn * 256; u.aux = b; u.a = A + (size_t)u.r0 * 2048; u.b = B + (size_t)u.c0 * 2048; return true; } };
struct EpiWin { static constexpr bool PERM = true;
    bf16_t *UH, *Q, *K, *V, *G; const float* rope;
    __device__ __forceinline__ bool operator()(f32x4 (&acc)[2][2][4][2], const Unit& u, int wr, int wc, int fr, int fq) const {
        const int pn = u.c0 >> 8, b = u.aux, tt0 = u.r0 - b * LT;
#pragma unroll
        for (int ai = 0; ai < 2; ++ai)
#pragma unroll
            for (int m = 0; m < 4; ++m) { const int rloc = ai * 128 + wr * 64 + m * 16 + fr, tt = tt0 + rloc; const size_t r = (size_t)u.r0 + rloc; const int t = tt - CL;
#pragma unroll
                for (int bj = 0; bj < 2; ++bj) { const int c = u.c0 + bj * 128 + wc * 32 + 8 * fq; f32x4 v0 = acc[ai][bj][m][0], v1 = acc[ai][bj][m][1];
                    bf16_t* dst;
                    if (pn < 2) { const int g = c >> 4, half = (c >> 3) & 1; dst = UH + (((size_t)(b * 32 + g) * NCH + (tt >> 4)) * 512 + (tt & 15) * 16 + half * 8); }
                    else if (pn < 6) { const int cq = (c - 512) & 511; const bool isq = pn < 4;
                        if (tt >= CL) { const int gi = (cq >> 5) & 1, pos = gi ? (t & 63) : (t >> 6);
                            const f32x4 cs = *(const f32x4*)(rope + pos * 32 + 4 * fq), sn = *(const f32x4*)(rope + pos * 32 + 16 + 4 * fq);
                            const f32x4 o1 = v0 * cs - v1 * sn, o2 = v1 * cs + v0 * sn; const float sc = isq ? QSCALE : 1.0f; v0 = o1 * sc; v1 = o2 * sc; }
                        dst = (isq ? Q : K) + r * 512 + cq; }
                    else if (pn < 8) { dst = V + r * 512 + (c - 1536); }
                    else { const size_t lr = (size_t)b * SEQ + t; dst = G + lr * 2048 + (c - 2048);
#pragma unroll
                        for (int j = 0; j < 4; ++j) { v0[j] = sigmoidf_(v0[j]); v1[j] = sigmoidf_(v1[j]); } }
                    u32x4 w; w.x = cvt_pk_bf16(v0[0], v0[1]); w.y = cvt_pk_bf16(v0[2], v0[3]); w.z = cvt_pk_bf16(v1[0], v1[1]); w.w = cvt_pk_bf16(v1[2], v1[3]);
                    *(u32x4*)dst = w; } }
        return true; } };

struct SchedS5a { int i, G, c; const char* UH; const char* Bcat;
    __device__ __forceinline__ bool next(Unit& u) { const int L = i * G + c; ++i; if (L >= 512) return false; const int bg = L >> 1, row0 = (L & 1) * 16;
        u.r0 = bg * NCH + row0; u.c0 = 0; u.aux = 0; u.a = UH + (size_t)u.r0 * 1024; u.b = Bcat + (size_t)(bg & 31) * 256 * 256 * 2; return true; } };
struct EpiS5a { static constexpr bool PERM = false; float* S;
    __device__ __forceinline__ bool operator()(f32x4 (&acc)[2][2][4][2], const Unit& u, int wr, int wc, int fr, int fq) const {
#pragma unroll
        for (int ai = 0; ai < 2; ++ai)
#pragma unroll
            for (int m = 0; m < 4; ++m) { float* rowp = S + ((size_t)u.r0 + ai * 128 + wr * 64 + m * 16 + fr) * 256 + wc * 32 + 4 * fq;
#pragma unroll
                for (int bj = 0; bj < 2; ++bj)
#pragma unroll
                    for (int n = 0; n < 2; ++n) *(f32x4*)(rowp + bj * 128 + n * 16) = acc[ai][bj][m][n]; }
        return true; } };

struct SchedS5c { int i, G, c; const char* UH; const char* Wcat;
    __device__ __forceinline__ bool next(Unit& u) { const int L = i * G + c; ++i; if (L >= 256) return false; const int bg = L;
        u.r0 = (bg >> 5) * SEQ; u.c0 = 0; u.aux = bg & 31; u.a = UH + ((size_t)bg * NCH + 16) * 1024; u.b = Wcat + (size_t)(bg & 31) * 256 * 512 * 2; return true; } };
struct EpiS5c { static constexpr bool PERM = true; bf16_t* YA;
    __device__ __forceinline__ bool operator()(f32x4 (&acc)[2][2][4][2], const Unit& u, int wr, int wc, int fr, int fq) const {
#pragma unroll
        for (int ai = 0; ai < 2; ++ai)
#pragma unroll
            for (int m = 0; m < 4; ++m) { const int chunk = ai * 128 + wr * 64 + m * 16 + fr;
#pragma unroll
                for (int bj = 0; bj < 2; ++bj) { const int cl = bj * 128 + wc * 32 + 8 * fq, tok = cl >> 4, half = (cl >> 3) & 1; const f32x4 v0 = acc[ai][bj][m][0], v1 = acc[ai][bj][m][1];
                    u32x4 w; w.x = cvt_pk_bf16(gelu_tanh(v0[0]), gelu_tanh(v0[1])); w.y = cvt_pk_bf16(gelu_tanh(v0[2]), gelu_tanh(v0[3]));
                    w.z = cvt_pk_bf16(gelu_tanh(v1[0]), gelu_tanh(v1[1])); w.w = cvt_pk_bf16(gelu_tanh(v1[2]), gelu_tanh(v1[3]));
                    *(u32x4*)(YA + ((size_t)u.r0 + chunk * 16 + tok) * 512 + u.aux * 16 + half * 8) = w; } }
        return true; } };

struct SchedGlu { int i, G, c; const char* YA; const char* W;
    __device__ __forceinline__ bool next(Unit& u) { const int L = i * G + c; ++i; if (L >= 256) return false; int pm, pn; map_tile(L, 128, 2, pm, pn);
        u.r0 = pm * 256; u.c0 = pn * 256; u.aux = 0; u.a = YA + (size_t)u.r0 * 1024; u.b = W + (size_t)u.c0 * 1024; return true; } };
struct EpiGlu { static constexpr bool PERM = true; const bf16_t* YA; bf16_t* YY;
    __device__ __forceinline__ bool operator()(f32x4 (&acc)[2][2][4][2], const Unit& u, int wr, int wc, int fr, int fq) const {
#pragma unroll
        for (int ai = 0; ai < 2; ++ai)
#pragma unroll
            for (int m = 0; m < 4; ++m) { const size_t r = (size_t)u.r0 + ai * 128 + wr * 64 + m * 16 + fr;
#pragma unroll
                for (int bj = 0; bj < 2; ++bj) { const int c = u.c0 + bj * 128 + wc * 32 + 8 * fq; const f32x4 v0 = acc[ai][bj][m][0], v1 = acc[ai][bj][m][1];
                    const u32x4 a = *(const u32x4*)(YA + r * 512 + c); u32x4 w;
                    w.x = cvt_pk_bf16(bf_lo(a.x) * sigmoidf_(v0[0]), bf_hi(a.x) * sigmoidf_(v0[1])); w.y = cvt_pk_bf16(bf_lo(a.y) * sigmoidf_(v0[2]), bf_hi(a.y) * sigmoidf_(v0[3]));
                    w.z = cvt_pk_bf16(bf_lo(a.z) * sigmoidf_(v1[0]), bf_hi(a.z) * sigmoidf_(v1[1])); w.w = cvt_pk_bf16(bf_lo(a.w) * sigmoidf_(v1[2]), bf_hi(a.w) * sigmoidf_(v1[3]));
                    *(u32x4*)(YY + r * 1024 + c) = w; } }
        return true; } };

struct SchedProj { int i, G, c, part, pm, pn; const char* YY; const char* WA; const char* WB;
    __device__ __forceinline__ bool next(Unit& u) {
        if (part == 0) { const int L = i * G + c; if (L >= 512) return false; map_tile(L, 128, 4, pm, pn); }
        u.r0 = pm * 256; u.c0 = pn * 256; u.aux = part; u.a = YY + (size_t)u.r0 * 2048 + (part ? 1024 : 0); u.b = (part ? WB : WA) + (size_t)u.c0 * 1024;
        if (part) ++i; part ^= 1; return true; } };
struct EpiProj { static constexpr bool PERM = true; const bf16_t* G; bf16_t* M;
    __device__ __forceinline__ bool operator()(f32x4 (&acc)[2][2][4][2], const Unit& u, int wr, int wc, int fr, int fq) const {
#pragma unroll
        for (int ai = 0; ai < 2; ++ai)
#pragma unroll
            for (int m = 0; m < 4; ++m) { const size_t r = (size_t)u.r0 + ai * 128 + wr * 64 + m * 16 + fr;
#pragma unroll
                for (int bj = 0; bj < 2; ++bj) { const int c = u.c0 + bj * 128 + wc * 32 + 8 * fq; f32x4& v0 = acc[ai][bj][m][0]; f32x4& v1 = acc[ai][bj][m][1];
                    const u32x4 gb = *(const u32x4*)(G + r * 2048 + 1024 + c);
                    float sb[8] = {bf_lo(gb.x), bf_hi(gb.x), bf_lo(gb.y), bf_hi(gb.y), bf_lo(gb.z), bf_hi(gb.z), bf_lo(gb.w), bf_hi(gb.w)};
                    if (u.aux == 0) { const u32x4 ga = *(const u32x4*)(G + r * 2048 + c);
                        const float sa[8] = {bf_lo(ga.x), bf_hi(ga.x), bf_lo(ga.y), bf_hi(ga.y), bf_lo(ga.z), bf_hi(ga.z), bf_lo(ga.w), bf_hi(ga.w)};
#pragma unroll
                        for (int j = 0; j < 4; ++j) { v0[j] *= sa[j] * __builtin_amdgcn_rcpf(fmaxf(sb[j], 1e-20f)); v1[j] *= sa[4 + j] * __builtin_amdgcn_rcpf(fmaxf(sb[4 + j], 1e-20f)); } }
                    else { u32x4 w;
#pragma unroll
                        for (int j = 0; j < 8; ++j) sb[j] = fmaxf(sb[j], 1e-20f);
                        w.x = cvt_pk_bf16(v0[0] * sb[0], v0[1] * sb[1]); w.y = cvt_pk_bf16(v0[2] * sb[2], v0[3] * sb[3]);
                        w.z = cvt_pk_bf16(v1[0] * sb[4], v1[1] * sb[5]); w.w = cvt_pk_bf16(v1[2] * sb[6], v1[3] * sb[7]);
                        *(u32x4*)(M + r * 1024 + c) = w; } } }
        return u.aux != 0; } };

struct SchedOut { int i, G, c; const char* M; const char* W;
    __device__ __forceinline__ bool next(Unit& u) { const int L = i * G + c; ++i; if (L >= 512) return false; int pm, pn; map_tile(L, 128, 4, pm, pn);
        u.r0 = pm * 256; u.c0 = pn * 256; u.aux = 0; u.a = M + (size_t)u.r0 * 2048; u.b = W + (size_t)u.c0 * 2048; return true; } };
struct EpiOut { static constexpr bool PERM = false; float* O;
    __device__ __forceinline__ bool operator()(f32x4 (&acc)[2][2][4][2], const Unit& u, int wr, int wc, int fr, int fq) const {
#pragma unroll
        for (int ai = 0; ai < 2; ++ai)
#pragma unroll
            for (int m = 0; m < 4; ++m) { float* rowp = O + ((size_t)u.r0 + ai * 128 + wr * 64 + m * 16 + fr) * 1024 + u.c0 + wc * 32 + 4 * fq;
#pragma unroll
                for (int bj = 0; bj < 2; ++bj)
#pragma unroll
                    for (int n = 0; n < 2; ++n) *(f32x4*)(rowp + bj * 128 + n * 16) = acc[ai][bj][m][n]; }
        return true; } };

struct SchedUp { int i, G, c; const char* XS; const char* W;
    __device__ __forceinline__ bool next(Unit& u) { const int L = i * G + c; ++i; if (L >= 4096) return false; const int e = L >> 8; int pm, pn; map_tile(L & 255, 16, 16, pm, pn);
        u.r0 = e * 4096 + pm * 256; u.c0 = pn * 128; u.aux = e; u.a = XS + (size_t)u.r0 * 2048; u.b = W + ((size_t)e * 4096 + pn * 256) * 2048; return true; } };
struct EpiUp { static constexpr bool PERM = true; bf16_t* HID;
    __device__ __forceinline__ bool operator()(f32x4 (&acc)[2][2][4][2], const Unit& u, int wr, int wc, int fr, int fq) const {
#pragma unroll
        for (int ai = 0; ai < 2; ++ai)
#pragma unroll
            for (int m = 0; m < 4; ++m) { const size_t r = (size_t)u.r0 + ai * 128 + wr * 64 + m * 16 + fr;
#pragma unroll
                for (int bj = 0; bj < 2; ++bj) { const int c = u.c0 + bj * 64 + wc * 16 + 4 * fq; const f32x4 g = acc[ai][bj][m][0], up = acc[ai][bj][m][1];
                    u32x2 w; w.x = cvt_pk_bf16(g[0] * sigmoidf_(g[0]) * up[0], g[1] * sigmoidf_(g[1]) * up[1]); w.y = cvt_pk_bf16(g[2] * sigmoidf_(g[2]) * up[2], g[3] * sigmoidf_(g[3]) * up[3]);
                    *(u32x2*)(HID + r * 2048 + c) = w; } }
        return true; } };

struct SchedDown { int i, G, c; const char* HID; const char* W;
    __device__ __forceinline__ bool next(Unit& u) { const int L = i * G + c; ++i; if (L >= 1024) return false; const int e = L >> 6; int pm, pn; map_tile(L & 63, 16, 4, pm, pn);
        u.r0 = e * 4096 + pm * 256; u.c0 = pn * 256; u.aux = e; u.a = HID + (size_t)u.r0 * 4096; u.b = W + ((size_t)e * 1024 + pn * 256) * 4096; return true; } };
struct EpiDown { static constexpr bool PERM = true; const float* GATEV; bf16_t* YS;
    __device__ __forceinline__ bool operator()(f32x4 (&acc)[2][2][4][2], const Unit& u, int wr, int wc, int fr, int fq) const {
#pragma unroll
        for (int ai = 0; ai < 2; ++ai)
#pragma unroll
            for (int m = 0; m < 4; ++m) { const size_t r = (size_t)u.r0 + ai * 128 + wr * 64 + m * 16 + fr; const float gt = GATEV[r];
#pragma unroll
                for (int bj = 0; bj < 2; ++bj) { const int c = u.c0 + bj * 128 + wc * 32 + 8 * fq; const f32x4 v0 = acc[ai][bj][m][0] * gt, v1 = acc[ai][bj][m][1] * gt;
                    u32x4 w; w.x = cvt_pk_bf16(v0[0], v0[1]); w.y = cvt_pk_bf16(v0[2], v0[3]); w.z = cvt_pk_bf16(v1[0], v1[1]); w.w = cvt_pk_bf16(v1[2], v1[3]);
                    *(u32x4*)(YS + r * 1024 + c) = w; } }
        return true; } };

__device__ __forceinline__ void ld_row(const float* p, int lane, f32x4 (&v)[4]) {
#pragma unroll
    for (int j = 0; j < 4; ++j) v[j] = *(const f32x4*)(p + lane * 4 + 256 * j);
}
__device__ __forceinline__ float sumsq(const f32x4 (&v)[4]) { float s = 0.f;
#pragma unroll
    for (int j = 0; j < 4; ++j) s += (v[j][0] * v[j][0] + v[j][1] * v[j][1]) + (v[j][2] * v[j][2] + v[j][3] * v[j][3]);
    return wave_sum(s); }

__device__ __forceinline__ void row_pass1(const Args& A, const float* MOD, bf16_t* HN, int gw, int ngw, int lane) {
    f32x4 w[4]; ld_row(A.in[I_NPREMIX], lane, w);
    for (int r = gw; r < MR; r += ngw) { const int b = r / LT, tt = r - b * LT;
        const float* src = tt < CL ? A.in[I_CTX] + ((size_t)b * CL + tt) * DM : A.in[I_X] + ((size_t)b * SEQ + (tt - CL)) * DM;
        const float* mrow = MOD + (tt < CL ? 8 : b) * 6144;
        f32x4 v[4], sh[4], sc[4]; ld_row(src, lane, v); ld_row(mrow, lane, sh); ld_row(mrow + 1024, lane, sc);
        const float rstd = rsqrtf(sumsq(v) * (1.0f / DM) + EPS);
#pragma unroll
        for (int j = 0; j < 4; ++j) { const f32x4 h = v[j] * rstd * w[j] * (sc[j] + 1.0f) + sh[j];
            u32x2 o; o.x = cvt_pk_bf16(h[0], h[1]); o.y = cvt_pk_bf16(h[2], h[3]); *(u32x2*)(HN + (size_t)r * DM + lane * 4 + 256 * j) = o; } }
}

__device__ __forceinline__ void row_pass2(const Args& A, const float* MOD, float* OUT, bf16_t* H2, float* AFF, LAS float* WR, int gw, int ngw, int lane) {
    f32x4 wpost[4], wpre[4]; ld_row(A.in[I_NPOSTMIX], lane, wpost); ld_row(A.in[I_NPREFFN], lane, wpre);
    for (int r = gw; r < ML; r += ngw) { const int b = r >> 12, t = r & 4095; const float* mrow = MOD + b * 6144;
        f32x4 o[4], x[4], gm[4], sh[4], sc[4]; ld_row(OUT + (size_t)r * DM, lane, o); ld_row(A.in[I_X] + (size_t)r * DM, lane, x);
        ld_row(mrow + 2048, lane, gm); ld_row(mrow + 3072, lane, sh); ld_row(mrow + 4096, lane, sc);
        const float rs0 = rsqrtf(sumsq(o) * (1.0f / DM) + EPS);
#pragma unroll
        for (int j = 0; j < 4; ++j) { x[j] = x[j] + gm[j] * (o[j] * rs0 * wpost[j]); *(f32x4*)(OUT + (size_t)r * DM + lane * 4 + 256 * j) = x[j]; }
        const float rs1 = rsqrtf(sumsq(x) * (1.0f / DM) + EPS);
        float lg[16];
#pragma unroll
        for (int e = 0; e < 16; ++e) lg[e] = 0.f;
#pragma unroll
        for (int j = 0; j < 4; ++j) { const f32x4 h = x[j] * rs1 * wpre[j] * (sc[j] + 1.0f) + sh[j];
            u32x2 ob; ob.x = cvt_pk_bf16(h[0], h[1]); ob.y = cvt_pk_bf16(h[2], h[3]); *(u32x2*)(H2 + (size_t)r * DM + lane * 4 + 256 * j) = ob;
#pragma unroll
            for (int e = 0; e < 16; ++e) { const f32x4 ww = *(const LAS f32x4*)(WR + e * 1024 + lane * 4 + 256 * j);
                lg[e] += (h[0] * ww[0] + h[1] * ww[1]) + (h[2] * ww[2] + h[3] * ww[3]); } }
        float mx = -1e30f;
#pragma unroll
        for (int e = 0; e < 16; ++e) { lg[e] = wave_sum(lg[e]); mx = fmaxf(mx, lg[e]); }
        float se = 0.f;
#pragma unroll
        for (int e = 0; e < 16; ++e) { lg[e] = expf(lg[e] - mx); se += lg[e]; }
        const float inv = 1.0f / se; float mine = 0.f;
#pragma unroll
        for (int e = 0; e < 16; ++e) mine = (lane == e) ? lg[e] * inv : mine;
        if (lane < 16) AFF[((size_t)b * NE + lane) * SEQ + t] = mine; }
}

__device__ __forceinline__ void row_final(const Args& A, const float* MOD, float* OUT, const bf16_t* YS, const int* SLOT, int gw, int ngw, int lane) {
    for (int r = gw; r < ML; r += ngw) { const int b = r >> 12; const float* mrow = MOD + b * 6144;
        const int myslot = lane < 16 ? SLOT[(size_t)r * 16 + lane] : -1;
        float f[16];
#pragma unroll
        for (int i = 0; i < 16; ++i) f[i] = 0.f;
        for (int e = 0; e < 16; ++e) { const int s = __builtin_amdgcn_readlane(myslot, e);
            if (s >= 0) { const bf16_t* yr = YS + ((size_t)e * 4096 + b * CAP + s) * DM;
#pragma unroll
                for (int j = 0; j < 2; ++j) { const u32x4 y = *(const u32x4*)(yr + lane * 8 + 512 * j);
                    f[8 * j + 0] += bf_lo(y.x); f[8 * j + 1] += bf_hi(y.x); f[8 * j + 2] += bf_lo(y.y); f[8 * j + 3] += bf_hi(y.y);
                    f[8 * j + 4] += bf_lo(y.z); f[8 * j + 5] += bf_hi(y.z); f[8 * j + 6] += bf_lo(y.w); f[8 * j + 7] += bf_hi(y.w); } } }
        float ss = 0.f;
#pragma unroll
        for (int i = 0; i < 16; ++i) ss += f[i] * f[i];
        const float rstd = rsqrtf(wave_sum(ss) * (1.0f / DM) + EPS);
#pragma unroll
        for (int j = 0; j < 2; ++j)
#pragma unroll
            for (int q = 0; q < 2; ++q) { const int k = lane * 8 + 512 * j + 4 * q;
                const f32x4 x1 = *(const f32x4*)(OUT + (size_t)r * DM + k), gf = *(const f32x4*)(mrow + 5120 + k), w = *(const f32x4*)(A.in[I_NPOSTFFN] + k);
                f32x4 fv = {f[8 * j + 4 * q], f[8 * j + 4 * q + 1], f[8 * j + 4 * q + 2], f[8 * j + 4 * q + 3]};
                *(f32x4*)(OUT + (size_t)r * DM + k) = x1 + gf * (fv * rstd * w); } }
}

__device__ __forceinline__ void yb_combine(const bf16_t* OC, const float* subln, float lam, bf16_t* YY, int gw, int ngw, int lane) {
    float sw[8];
#pragma unroll
    for (int i = 0; i < 8; ++i) sw[i] = subln[(lane & 15) * 8 + i] * 0.8f;
    for (int r = gw; r < ML; r += ngw) {
        const u32x4 a = *(const u32x4*)(OC + (size_t)r * 512 + lane * 8), c = *(const u32x4*)(OC + ((size_t)ML + r) * 512 + lane * 8);
        float d[8] = {bf_lo(a.x) - lam * bf_lo(c.x), bf_hi(a.x) - lam * bf_hi(c.x), bf_lo(a.y) - lam * bf_lo(c.y), bf_hi(a.y) - lam * bf_hi(c.y),
                      bf_lo(a.z) - lam * bf_lo(c.z), bf_hi(a.z) - lam * bf_hi(c.z), bf_lo(a.w) - lam * bf_lo(c.w), bf_hi(a.w) - lam * bf_hi(c.w)};
        float ss = 0.f;
#pragma unroll
        for (int i = 0; i < 8; ++i) ss += d[i] * d[i];
        ss += __shfl_xor(ss, 1); ss += __shfl_xor(ss, 2); ss += __shfl_xor(ss, 4); ss += __shfl_xor(ss, 8);
        const float rstd = rsqrtf(ss * (1.0f / 128.0f) + EPS);
        u32x4 w; w.x = cvt_pk_bf16(d[0] * rstd * sw[0], d[1] * rstd * sw[1]); w.y = cvt_pk_bf16(d[2] * rstd * sw[2], d[3] * rstd * sw[3]);
        w.z = cvt_pk_bf16(d[4] * rstd * sw[4], d[5] * rstd * sw[5]); w.w = cvt_pk_bf16(d[6] * rstd * sw[6], d[7] * rstd * sw[7]);
        *(u32x4*)(YY + (size_t)r * 1024 + 512 + lane * 8) = w; }
}

__device__ __forceinline__ void s5_scan(const Args& A, const float* S, bf16_t* UH, int bg) {
    const int tid = threadIdx.x; if (tid >= 128) return;
    const int dir = tid >> 6, p = tid & 63, g = bg & 31, gi = dir * 32 + g;
    const float lr = fminf(A.in[I_LAMRE][gi * 64 + p], -1e-4f), li = A.in[I_LAMIM][gi * 64 + p], dt = expf(A.in[I_LOGDT][gi]);
    float sn, cs; sincos_fast(16.0f * li * dt, &sn, &cs); const float mag = expf(16.0f * lr * dt), ar = mag * cs, aim = mag * sn;
    const float* Sb = S + (size_t)bg * NCH * 256 + dir * 128 + p; bf16_t* Hb = UH + (size_t)bg * NCH * 512 + 256 + dir * 128 + p;
    float hr = 0.f, hi = 0.f;
    for (int i0 = 0; i0 < NCH; i0 += 8) { float sr[8], si[8]; int ch[8];
#pragma unroll
        for (int k = 0; k < 8; ++k) { const int i = i0 + k; ch[k] = dir == 0 ? i : (i < 16 ? 15 - i : 287 - i); sr[k] = Sb[(size_t)ch[k] * 256]; si[k] = Sb[(size_t)ch[k] * 256 + 64]; }
#pragma unroll
        for (int k = 0; k < 8; ++k) { Hb[(size_t)ch[k] * 512] = (bf16_t)(cvt_pk_bf16(hr, 0.f) & 0xffffu); Hb[(size_t)ch[k] * 512 + 64] = (bf16_t)(cvt_pk_bf16(hi, 0.f) & 0xffffu);
            const float nr = ar * hr - aim * hi + sr[k], ni = ar * hi + aim * hr + si[k]; hr = nr; hi = ni; } }
}

__device__ __forceinline__ void topk_task(int be, const float* AFF, const bf16_t* H2, int* IDX, float* GATEV, int* SLOT, bf16_t* XS, LAS unsigned* L) {
    const int tid = threadIdx.x, lane = tid & 63, wid = tid >> 6, b = be >> 4, e = be & 15;
    LAS unsigned* hist = L; LAS unsigned* wsum = L + 256; LAS unsigned* bc = L + 272; LAS int* sidx = (LAS int*)(L + 288);
    const float* ap = AFF + (size_t)be * SEQ + tid * 8;
    const f32x4 a0 = *(const f32x4*)ap, a1 = *(const f32x4*)(ap + 4);
    unsigned key[8] = {__float_as_uint(a0[0]), __float_as_uint(a0[1]), __float_as_uint(a0[2]), __float_as_uint(a0[3]), __float_as_uint(a1[0]), __float_as_uint(a1[1]), __float_as_uint(a1[2]), __float_as_uint(a1[3])};
    unsigned prefix = 0, pmask = 0; int need = CAP;
    for (int pass = 0; pass < 4; ++pass) { const int shift = 24 - 8 * pass;
        if (tid < 256) hist[tid] = 0; __syncthreads();
#pragma unroll
        for (int i = 0; i < 8; ++i) if ((key[i] & pmask) == prefix) __hip_atomic_fetch_add(&hist[(key[i] >> shift) & 255u], 1u, __ATOMIC_RELAXED, __HIP_MEMORY_SCOPE_WORKGROUP);
        __syncthreads();
        if (tid < 64) { unsigned c0 = hist[255 - 4 * tid], c1 = hist[254 - 4 * tid], c2 = hist[253 - 4 * tid], c3 = hist[252 - 4 * tid]; unsigned tot = c0 + c1 + c2 + c3, inc = tot;
#pragma unroll
            for (int o = 1; o < 64; o <<= 1) { const unsigned v = __shfl_up(inc, o); if (tid >= o) inc += v; }
            const unsigned exc = inc - tot;
            if (exc < (unsigned)need && inc >= (unsigned)need) { unsigned run = exc; int bin = 255 - 4 * tid; unsigned cs[4] = {c0, c1, c2, c3};
#pragma unroll
                for (int k = 0; k < 4; ++k) { if (run < (unsigned)need && run + cs[k] >= (unsigned)need) { bc[0] = (unsigned)(bin - k); bc[1] = run; } run += cs[k]; } } }
        __syncthreads();
        const unsigned bin = bc[0], above = bc[1];
        prefix |= bin << shift; pmask |= 255u << shift; need -= (int)above;
        __syncthreads(); }
    unsigned cnt = 0;
#pragma unroll
    for (int i = 0; i < 8; ++i) cnt += (key[i] > prefix ? 1u : 0u) + (key[i] == prefix ? 0x10000u : 0u);
    unsigned inc = cnt;
#pragma unroll
    for (int o = 1; o < 64; o <<= 1) { const unsigned v = __shfl_up(inc, o); if (lane >= o) inc += v; }
    if (lane == 63) wsum[wid] = inc; __syncthreads();
    unsigned base = 0;
    for (int w = 0; w < wid; ++w) base += wsum[w];
    unsigned tot = 0;
    for (int w = 0; w < 8; ++w) tot += wsum[w];
    const int ngt = (int)(tot & 0xffffu);
    unsigned run = base + inc - cnt; int rgt = (int)(run & 0xffffu), req = (int)(run >> 16);
#pragma unroll
    for (int i = 0; i < 8; ++i) { const int t = tid * 8 + i; int slot = -1;
        if (key[i] > prefix) { slot = rgt; ++rgt; } else if (key[i] == prefix) { if (req < need) slot = ngt + req; ++req; }
        SLOT[((size_t)b * SEQ + t) * NE + e] = slot;
        if (slot >= 0) { sidx[slot] = t; IDX[be * CAP + slot] = t; GATEV[(size_t)e * 4096 + b * CAP + slot] = __uint_as_float(key[i]); } }
    __syncthreads();
    for (int s0 = wid * 64; s0 < wid * 64 + 64; s0 += 4) { u32x4 v[4][2];
#pragma unroll
        for (int k = 0; k < 4; ++k) { const bf16_t* src = H2 + ((size_t)b * SEQ + sidx[s0 + k]) * DM;
            v[k][0] = *(const u32x4*)(src + lane * 8); v[k][1] = *(const u32x4*)(src + 512 + lane * 8); }
#pragma unroll
        for (int k = 0; k < 4; ++k) { bf16_t* dst = XS + ((size_t)e * 4096 + b * CAP + s0 + k) * DM;
            *(u32x4*)(dst + lane * 8) = v[k][0]; *(u32x4*)(dst + 512 + lane * 8) = v[k][1]; } }
    __syncthreads();
}

constexpr int N_PHASES = 15;
__global__ void __launch_bounds__(512) fwd_kernel(Args args) {
    extern __shared__ __attribute__((aligned(16))) unsigned char lds_raw[];
    LAS unsigned char* lds = (LAS unsigned char*)lds_raw;
    cg::grid_group grid = cg::this_grid();
    const int tid = threadIdx.x, lane = tid & 63, wid = __builtin_amdgcn_readfirstlane(tid >> 6);
    const int G = gridDim.x, blk = blockIdx.x, gw = blk * 8 + wid, ngw = G * 8;
    unsigned char* ws = args.ws;
    float* MOD = (float*)(ws + WS_MOD); float* MISC = (float*)(ws + WS_MISC); float* ROPE = MISC + 256;
    bf16_t* BCAT = (bf16_t*)(ws + WS_BCAT); bf16_t* WCAT = (bf16_t*)(ws + WS_WCAT);
    bf16_t* WINT = (bf16_t*)(ws + WS_WIN); bf16_t* WGLUT = (bf16_t*)(ws + WS_WGLU); bf16_t* WAT = (bf16_t*)(ws + WS_WA); bf16_t* WBT = (bf16_t*)(ws + WS_WB); bf16_t* WOUTT = (bf16_t*)(ws + WS_WOUT);
    float* AFF = (float*)(ws + WS_AFF); int* IDX = (int*)(ws + WS_IDX); float* GATEV = (float*)(ws + WS_GATEV); int* SLOT = (int*)(ws + WS_SLOT);
    bf16_t* HN = (bf16_t*)(ws + WS_HN); bf16_t* UH = (bf16_t*)(ws + WS_UH); bf16_t* QB = (bf16_t*)(ws + WS_Q); bf16_t* KB = (bf16_t*)(ws + WS_K); bf16_t* VB = (bf16_t*)(ws + WS_V);
    bf16_t* GATES = (bf16_t*)(ws + WS_GATES); float* SB = (float*)(ws + WS_S); bf16_t* OC = (bf16_t*)(ws + WS_OC); bf16_t* YA = (bf16_t*)(ws + WS_YA); bf16_t* YY = (bf16_t*)(ws + WS_YY);
    bf16_t* MB = (bf16_t*)(ws + WS_M); bf16_t* H2 = (bf16_t*)(ws + WS_H2); bf16_t* XS = (bf16_t*)(ws + WS_XS); bf16_t* WGU = (bf16_t*)(ws + WS_WGU); bf16_t* HID = (bf16_t*)(ws + WS_HID);
    bf16_t* WD = (bf16_t*)(ws + WS_WD); bf16_t* YS = (bf16_t*)(ws + WS_YS);
    const int lo = args.ph_lo, hi = args.ph_hi;
#ifdef ONLY_PHASE
#define IN(k) ((k) == ONLY_PHASE && lo <= (k) && (k) < hi)
#else
#define IN(k) (lo <= (k) && (k) < hi)
#endif
#define SEAM(k) do { if (IN(k) && IN((k) + 1)) grid.sync(); } while (0)
    LAS float* Lf = (LAS float*)lds;
    LAS float* scr = Lf + wid * 4160;

    if (IN(0)) {
        for (int task = blk; task < 257; task += G) {
#ifndef P0_NO_S5
            if (task < 64) s5_tables_task(task >> 1, task & 1, args, BCAT, WCAT, Lf);
            else
#endif
#ifndef P0_NO_MOD
            if (task < 256) mod_task((task - 64) * 32, args.in[I_C], args.in[I_CCTX], args.in[I_WADA], args.in[I_BADA], MOD, Lf);
            else
#endif
            {
                for (int i = tid; i < 1024; i += 512) { const int pos = i >> 4, fi = i & 15; const float inv = exp2f(-(float)fi * (13.287712379549449f / 16.0f));
                    float sn, cs; sincos_fast((float)pos * inv, &sn, &cs); ROPE[pos * 32 + fi] = cs; ROPE[pos * 32 + 16 + fi] = sn; }
                if (tid < 64) { const float* l = args.in[I_DALAM]; const float s1 = wave_sum(l[tid] * l[64 + tid]), s2 = wave_sum(l[128 + tid] * l[192 + tid]);
                    if (tid == 0) MISC[0] = expf(s1) - expf(s2) + 0.2f; }
            }
        }
        __syncthreads();
#ifndef P0_NO_TR
        for (int it = gw; it < 1600; it += ngw) {
            if (it < 1024) { const int kb = it >> 6, nb = it & 63, n = nb * 64 + lane, orig = (n >= 512 && n < 1536) ? permq(n) : n;
                transpose_item(args.in[I_WIN] + (size_t)kb * 64 * 4096 + orig, 4096, WINT + (size_t)nb * 64 * 1024 + kb * 64, 1024, scr, lane); }
            else if (it < 1088) { const int r = it - 1024, kb = r >> 3, nb = r & 7;
                transpose_item(args.in[I_WGLU] + (size_t)kb * 64 * 512 + nb * 64 + lane, 512, WGLUT + (size_t)nb * 64 * 512 + kb * 64, 512, scr, lane); }
            else if (it < 1344) { const int r = (it - 1088) & 127, kb = r >> 4, nb = r & 15; const bool isb = it >= 1216;
                transpose_item(args.in[isb ? I_WPB : I_WPA] + (size_t)kb * 64 * 1024 + nb * 64 + lane, 1024, (isb ? WBT : WAT) + (size_t)nb * 64 * 512 + kb * 64, 512, scr, lane); }
            else { const int r = it - 1344, kb = r >> 4, nb = r & 15;
                transpose_item(args.in[I_WOUT] + (size_t)kb * 64 * 1024 + nb * 64 + lane, 1024, WOUTT + (size_t)nb * 64 * 1024 + kb * 64, 1024, scr, lane); }
        }
#endif
    }
    SEAM(0);
    if (IN(1)) row_pass1(args, MOD, HN, gw, ngw, lane);
    SEAM(1);
    if (IN(2)) { SchedWin S{0, G, blk, (const char*)HN, (const char*)WINT}; EpiWin E{UH, QB, KB, VB, GATES, ROPE};
        pg8::gemm_phase(lds, 1024, 1024, 1024, S, E); }
    SEAM(2);
    if (IN(3)) { SchedS5a S{0, G, blk, (const char*)UH, (const char*)BCAT}; EpiS5a E{SB};
        pg8::gemm_phase(lds, 512, 256, 256, S, E); }
    SEAM(3);
    if (IN(4)) {
        for (int bg = blk; bg < 256; bg += G) s5_scan(args, SB, UH, bg);
        const int vcu = (G % 8 == 0) ? (blk % 8) * (G / 8) + blk / 8 : blk;
        for (int i = 0;; ++i) { const int U = i * G + vcu; if (U >= 1024) break;
            const int bh = U >> 5, rem = U & 31, c = rem >> 4, qb = rem & 15, b = bh >> 2, h = bh & 3;
            att::attn_unit(QB + ((size_t)b * LT + CL + qb * 256) * 512 + h * 128 + c * 64, KB + (size_t)b * LT * 512 + h * 128 + c * 64, VB + (size_t)b * LT * 512 + h * 128,
                           OC + ((size_t)c * ML + (size_t)b * SEQ + qb * 256) * 512 + h * 128, LT, (char*)lds_raw); }
    }
    SEAM(4);
    if (IN(5)) { SchedS5c S{0, G, blk, (const char*)UH, (const char*)WCAT}; EpiS5c E{YA};
        pg8::gemm_phase(lds, 512, 512, 512, S, E);
        yb_combine(OC, args.in[I_SUBLN], MISC[0], YY, gw, ngw, lane); }
    SEAM(5);
    if (IN(6)) { SchedGlu S{0, G, blk, (const char*)YA, (const char*)WGLUT}; EpiGlu E{YA, YY};
        pg8::gemm_phase(lds, 512, 512, 512, S, E); }
    SEAM(6);
    if (IN(7)) { SchedProj S{0, G, blk, 0, 0, 0, (const char*)YY, (const char*)WAT, (const char*)WBT}; EpiProj E{GATES, MB};
        pg8::gemm_phase(lds, 1024, 512, 512, S, E); }
    SEAM(7);
    if (IN(8)) { SchedOut S{0, G, blk, (const char*)MB, (const char*)WOUTT}; EpiOut E{args.out};
        pg8::gemm_phase(lds, 1024, 1024, 1024, S, E); }
    SEAM(8);
    if (IN(9)) {
        for (int i = tid; i < 16384; i += 512) Lf[(i & 15) * 1024 + (i >> 4)] = args.in[I_WROUTER][i];
        __syncthreads();
        row_pass2(args, MOD, args.out, H2, AFF, Lf, gw, ngw, lane);
    }
    SEAM(9);
    if (IN(10)) {
        for (int be = blk; be < 128; be += G) topk_task(be, AFF, H2, IDX, GATEV, SLOT, XS, (LAS unsigned*)lds);
        __syncthreads();
        for (int it = gw; it < 16384; it += ngw) { const int e = it >> 10, r = it & 1023, kb = r >> 6, nb = r & 63, n = nb * 64 + lane, f = (n >> 3) * 4 + (n & 3), isup = (n >> 2) & 1;
            transpose_item(args.in[isup ? I_WEU : I_WEG] + (size_t)e * 1024 * 2048 + (size_t)kb * 64 * 2048 + f, 2048, WGU + ((size_t)e * 4096 + nb * 64) * 1024 + kb * 64, 1024, scr, lane); }
    }
    SEAM(10);
    if (IN(11)) { SchedUp S{0, G, blk, (const char*)XS, (const char*)WGU}; EpiUp E{HID};
        pg8::gemm_phase(lds, 1024, 1024, 1024, S, E); }
    SEAM(11);
    if (IN(12)) {
        for (int it = gw; it < 8192; it += ngw) { const int e = it >> 9, r = it & 511, kb = r >> 4, nb = r & 15;
            transpose_item(args.in[I_WED] + (size_t)e * 2048 * 1024 + (size_t)kb * 64 * 1024 + nb * 64 + lane, 1024, WD + ((size_t)e * 1024 + nb * 64) * 2048 + kb * 64, 2048, scr, lane); }
    }
    SEAM(12);
    if (IN(13)) { SchedDown S{0, G, blk, (const char*)HID, (const char*)WD}; EpiDown E{GATEV, YS};
        pg8::gemm_phase(lds, 2048, 2048, 2048, S, E); }
    SEAM(13);
    if (IN(14)) row_final(args, MOD, args.out, YS, SLOT, gw, ngw, lane);
#undef IN
#undef SEAM
}

extern "C" void kernel_launch(void* const* d_in, const int* in_sizes, int n_in, void* d_out, int out_size, void* d_ws, size_t ws_size, hipStream_t stream) {
    static int grid = 0;
    if (grid == 0) {
        if (n_in != 29 || in_sizes[0] != ML * DM || out_size != ML * DM || ws_size < WS_END) {
            fprintf(stderr, "kernel_launch: unexpected shapes: n_in %d in0 %d out %d ws %zu (need %zu)\n", n_in, n_in > 0 ? in_sizes[0] : -1, out_size, ws_size, (size_t)WS_END); grid = -1; return; }
        int dev = 0, cus = 0, per_cu = 0;
        if (hipGetDevice(&dev) != hipSuccess || hipDeviceGetAttribute(&cus, hipDeviceAttributeMultiprocessorCount, dev) != hipSuccess) { grid = -1; return; }
        if (hipFuncSetAttribute((const void*)fwd_kernel, hipFuncAttributeMaxDynamicSharedMemorySize, LDS_BYTES) != hipSuccess) { fprintf(stderr, "kernel_launch: hipFuncSetAttribute failed\n"); grid = -1; return; }
        if (hipOccupancyMaxActiveBlocksPerMultiprocessor(&per_cu, (const void*)fwd_kernel, 512, LDS_BYTES) != hipSuccess || per_cu < 1) { fprintf(stderr, "kernel_launch: occupancy query gave %d\n", per_cu); per_cu = 1; }
        (void)hipGetLastError();
        grid = cus * 1;
        if (grid > 256) grid = 256;
    }
    if (grid < 0) return;
    Args a{};
    for (int i = 0; i < 29; ++i) a.in[i] = (const float*)d_in[i];
    a.out = (float*)d_out; a.ws = (unsigned char*)d_ws;
#if MK_PER_PHASE
    for (int p = 0; p < N_PHASES; ++p) { a.ph_lo = p; a.ph_hi = p + 1;
        hipLaunchKernelGGL(fwd_kernel, dim3(grid), dim3(512), LDS_BYTES, stream, a);
        const hipError_t le = hipPeekAtLastError();
        if (le != hipSuccess) { fprintf(stderr, "kernel_launch: launch %d failed: %s\n", p, hipGetErrorName(le)); break; } }
#else
    a.ph_lo = 0; a.ph_hi = N_PHASES;
    void* kargs[] = {&a};
    const hipError_t le = hipLaunchCooperativeKernel((const void*)fwd_kernel, dim3(grid), dim3(512), kargs, LDS_BYTES, stream);
    if (le != hipSuccess) fprintf(stderr, "kernel_launch: cooperative launch failed: %s (grid %d)\n", hipGetErrorString(le), grid);
#endif
}
```

```cpp
#include <hip/hip_runtime.h>
#include <hip/hip_cooperative_groups.h>
#include <cstdio>
#include <cstdint>
namespace cg = cooperative_groups;

#ifndef MK_PER_PHASE
#define MK_PER_PHASE 0
#endif

#ifndef REPEAT_MASK
#define REPEAT_MASK 0
#endif

#define CLOCK_PROBE 0
#define EPI_PROBE 0
#define SIDE_PROBE 0
#define TIME_WITH_SEAM 0
#define TIME_PHASE -1

#define LAS __attribute__((address_space(3)))
typedef unsigned short bf16_t;
typedef short bf16x8 __attribute__((ext_vector_type(8)));
typedef short s16x4 __attribute__((ext_vector_type(4)));
typedef float f32x4 __attribute__((ext_vector_type(4)));
typedef float f32x2 __attribute__((ext_vector_type(2)));
typedef float f32x16 __attribute__((ext_vector_type(16)));
typedef unsigned u32x4 __attribute__((ext_vector_type(4)));
typedef unsigned u32x2 __attribute__((ext_vector_type(2)));

constexpr int NB = 8, SEQ = 4096, CL = 256, LT = SEQ + CL  , DM = 1024;
constexpr int MR = NB * LT  , ML = NB * SEQ  ;
constexpr int NCH = LT / 16;
constexpr int NE = 16, CAP = 512, DE = 2048;
constexpr float EPS = 1e-6f;
constexpr float QSCALE = 0.125f * 1.4426950408889634f;

constexpr size_t MiB = 1u << 20;
constexpr size_t WS_BAR = 0;
constexpr size_t WS_MOD = 64 * 1024;
constexpr size_t WS_MISC = 512 * 1024;
constexpr size_t WS_BCAT = 1 * MiB;
constexpr size_t WS_WCAT = 5 * MiB;
constexpr size_t WS_WIN = 13 * MiB;
constexpr size_t WS_WGLU = 21 * MiB;
constexpr size_t WS_WA = 22 * MiB, WS_WB = 23 * MiB;
constexpr size_t WS_WOUT = 24 * MiB;
constexpr size_t WS_AFF = 26 * MiB;
constexpr size_t WS_IDX = 28 * MiB;
constexpr size_t WS_GATEV = 28 * MiB + 512 * 1024;
constexpr size_t WS_SLOT = 29 * MiB;
constexpr size_t WS_HN = 32 * MiB;
constexpr size_t WS_UH = 100 * MiB;
constexpr size_t WS_Q = 168 * MiB, WS_K = 202 * MiB, WS_V = 236 * MiB;
constexpr size_t WS_GATES = 270 * MiB;
constexpr size_t WS_S = 32 * MiB;
constexpr size_t WS_OC = 430 * MiB;
constexpr size_t WS_YA = 398 * MiB;
constexpr size_t WS_YY = 100 * MiB;
constexpr size_t WS_M = 168 * MiB;
constexpr size_t WS_H2 = 32 * MiB;
constexpr size_t WS_XS = 64 * MiB;
constexpr size_t WS_WGU = 494 * MiB;
constexpr size_t WS_HID = 224 * MiB;
constexpr size_t WS_WD = 192 * MiB;
constexpr size_t WS_YS = 352 * MiB;
constexpr size_t WS_OB = 270 * MiB;
constexpr size_t WS_X1 = 128 * MiB;
constexpr size_t WS_END = 558 * MiB;

constexpr int LDS_BYTES = 147456;

__device__ __forceinline__ unsigned cvt_pk_bf16(float lo, float hi) { unsigned r; asm volatile("v_cvt_pk_bf16_f32 %0, %1, %2" : "=v"(r) : "v"(lo), "v"(hi)); return r; }
__device__ __forceinline__ float bf_lo(unsigned u) { return __uint_as_float(u << 16); }
__device__ __forceinline__ float bf_hi(unsigned u) { return __uint_as_float(u & 0xffff0000u); }
__device__ __forceinline__ float bf2f(bf16_t b) { return __uint_as_float(((unsigned)b) << 16); }
__device__ __forceinline__ unsigned pk_fp8x4(float a, float b, float c, float d) {
    a = __builtin_amdgcn_fmed3f(a, -448.f, 448.f); b = __builtin_amdgcn_fmed3f(b, -448.f, 448.f); c = __builtin_amdgcn_fmed3f(c, -448.f, 448.f); d = __builtin_amdgcn_fmed3f(d, -448.f, 448.f);
    int w = __builtin_amdgcn_cvt_pk_fp8_f32(a, b, 0, false); w = __builtin_amdgcn_cvt_pk_fp8_f32(c, d, w, true); return (unsigned)w; }
__device__ __forceinline__ float sigmoidf_(float x) { return __builtin_amdgcn_rcpf(1.0f + __expf(-x)); }
template <int CTRL> __device__ __forceinline__ float dpp_f(float v) { return __builtin_bit_cast(float, __builtin_amdgcn_update_dpp(0, __builtin_bit_cast(int, v), CTRL, 0xF, 0xF, true)); }
constexpr int DPP_XOR1 = 0xB1, DPP_XOR2 = 0x4E, DPP_HMIRROR = 0x141, DPP_MIRROR = 0x140, DPP_ROR8 = 0x128;
__device__ __forceinline__ float swap16_sum(float a, float b) { auto r = __builtin_amdgcn_permlane16_swap(__float_as_uint(a), __float_as_uint(b), false, false); return __uint_as_float(r[0]) + __uint_as_float(r[1]); }
__device__ __forceinline__ float swap32_sum(float a, float b) { auto r = __builtin_amdgcn_permlane32_swap(__float_as_uint(a), __float_as_uint(b), false, false); return __uint_as_float(r[0]) + __uint_as_float(r[1]); }
__device__ __forceinline__ float wave_sum(float v) {
    v += dpp_f<DPP_XOR1>(v); v += dpp_f<DPP_XOR2>(v); v += dpp_f<DPP_HMIRROR>(v); v += dpp_f<DPP_MIRROR>(v);
    v = swap16_sum(v, v); return swap32_sum(v, v);
}
__device__ __forceinline__ void sincos_fast(float x, float* sn, float* cs) {
    const float k = rintf(x * 0.15915494309189535f); float r = fmaf(-k, 6.28318548202514648f, x); r = fmaf(-k, -1.74845553e-07f, r);
    *sn = __sinf(r); *cs = __cosf(r); }
__device__ __forceinline__ float gelu_tanh(float x) { const float u = 0.7978845608028654f * (x + 0.044715f * x * x * x); return x * sigmoidf_(2.0f * u); }

__device__ __forceinline__ void map_tile(int wgid, int nM, int nN, int& pm, int& pn) {
    const int nwg = nM * nN, q = nwg / 8, r = nwg % 8, xcd = wgid % 8, off = wgid / 8;
    wgid = (xcd < r ? xcd * (q + 1) : r * (q + 1) + (xcd - r) * q) + off;
    const int nig = 8 * nN, gid = wgid / nig, fm = gid * 8, gsz = (nM - fm) < 8 ? (nM - fm) : 8;
    pm = fm + ((wgid % nig) % gsz); pn = (wgid % nig) / gsz;
}

namespace pg8 {
constexpr int BM = 256, BK = 64, HALF = 128, HTB = HALF * BK * 2, STAGE_BYTES = 8 * HTB;
__device__ __forceinline__ int lds_byte(int r, int c) { const int st = (r >> 4) * 2 + (c >> 5), rr = r & 15, cc = c & 31, ob = rr * 64 + cc * 2; return st * 1024 + (ob ^ (((ob >> 9) & 1) << 5)); }
__device__ __forceinline__ int lds_byte8(int r, int q) { return r * 128 + ((q ^ ((r >> 1) & 3)) << 5); }
__device__ __forceinline__ void stage_rc8(int b, int& R, int& Cb) { R = b >> 7; const int u = (b & 127) >> 4; Cb = (((u >> 1) ^ ((R >> 1) & 3)) << 5) + ((u & 1) << 4); }
__device__ __forceinline__ void stage_rc(int b, int& R, int& C) { const int st = b / 1024, sb = b % 1024, swz = sb ^ (((sb >> 9) & 1) << 5); R = (st >> 1) * 16 + swz / 64; C = (st & 1) * 32 + (swz % 64) / 2; }
__device__ __forceinline__ int perm32(int rho) { const int n = rho >> 4, i = rho & 15; return 8 * (i >> 2) + 4 * n + (i & 3); }

typedef int i32x8 __attribute__((ext_vector_type(8)));
__device__ __forceinline__ i32x8 ld32(const LAS unsigned char* p, int sw) { typedef int i32x4 __attribute__((ext_vector_type(4))); const i32x4 a = *(const LAS i32x4*)(p + sw), b = *(const LAS i32x4*)(p + (sw ^ 16)); return (i32x8){a[0], a[1], a[2], a[3], b[0], b[1], b[2], b[3]}; }
__device__ __forceinline__ i32x8 cat8(bf16x8 lo, bf16x8 hi) { typedef int i32x4 __attribute__((ext_vector_type(4))); const i32x4 a = __builtin_bit_cast(i32x4, lo), b = __builtin_bit_cast(i32x4, hi); return (i32x8){a[0], a[1], a[2], a[3], b[0], b[1], b[2], b[3]}; }
struct Unit { const char* a; const char* b; int r0, c0, aux; };

template <class Epi, class Sched, bool FP8 = false>
__device__ __forceinline__ void gemm_phase(LAS unsigned char* lds, const int ldaB, const int ldbB, const int KB, Sched& S, const Epi& E, unsigned long long* eacc = nullptr) {
    const int tid = threadIdx.x, wid = __builtin_amdgcn_readfirstlane(tid >> 6), lane = tid & 63, wr = wid >> 2, wc = wid & 3, fr = lane & 15, fq = lane >> 4;
    const int nt = KB / 128;
    unsigned voffA, voffB;
    { int R, C; if constexpr (FP8) stage_rc8(tid * 16, R, C); else { stage_rc(tid * 16, R, C); C *= 2; }
      const int Rb = Epi::PERM ? ((R & ~31) + perm32(R & 31)) : R; voffA = (unsigned)(R * ldaB + C); voffB = (unsigned)(Rb * ldbB + C); }
    const int sw8 = (fq & 1) * 16;
    const size_t qvoffA = (size_t)64 * ldaB, qvoffB = (size_t)64 * ldbB;
    const size_t kstep = (size_t)(BK * 2);
    const size_t hstepA = (size_t)HALF * ldaB, hstepB = (size_t)HALF * ldbB;
    const unsigned ldsw = (unsigned)wid * 1024u;
    const int aoff = FP8 ? lds_byte8(wr * 64 + fr, fq) : lds_byte(wr * 64 + fr, fq * 8), boff = FP8 ? lds_byte8(wc * 32 + fr, fq) : lds_byte(wc * 32 + fr, fq * 8);
#define PG8_SA(b, h) (((b) * 2 + (h)) * HTB)
#define PG8_SB(b, h) ((4 + (b) * 2 + (h)) * HTB)
#define PG8_STAGE(bufoff, gbase, voff) do { _Pragma("unroll") for (int _i = 0; _i < 2; ++_i) \
        __builtin_amdgcn_global_load_lds((const unsigned*)((const char*)(gbase) + (_i ? q##voff : (size_t)0) + voff), (LAS unsigned*)(lds + (bufoff) + ldsw + _i * 8192), 16, 0, 0); } while (0)
#define PG8_LDA(dst, b, h) do { _Pragma("unroll") for (int m = 0; m < 4; ++m) { if constexpr (FP8) dst##8[m] = ld32(lds + PG8_SA(b, h) + aoff + m * 2048, sw8); else { _Pragma("unroll") for (int k = 0; k < 2; ++k) dst[m][k] = *(const LAS bf16x8*)(lds + PG8_SA(b, h) + aoff + m * 2048 + k * 1024); } } } while (0)
#define PG8_LDB(dst, b, h) do { _Pragma("unroll") for (int n = 0; n < 2; ++n) { if constexpr (FP8) dst##8[n] = ld32(lds + PG8_SB(b, h) + boff + n * 2048, sw8); else { _Pragma("unroll") for (int k = 0; k < 2; ++k) dst[n][k] = *(const LAS bf16x8*)(lds + PG8_SB(b, h) + boff + n * 2048 + k * 1024); } } } while (0)
#define PG8_MMA(ai, bj, At, Bt) do { __builtin_amdgcn_s_setprio(1); _Pragma("unroll") for (int m = 0; m < 4; ++m) _Pragma("unroll") for (int n = 0; n < 2; ++n) { \
        if constexpr (FP8) { asm volatile("v_mfma_f32_16x16x128_f8f6f4 %0, %1, %2, %0" : "+v"(acc[ai][bj][m][n]) : "v"(Bt##8[n]), "v"(At##8[m])); } \
        else { _Pragma("unroll") for (int k = 0; k < 2; ++k) acc[ai][bj][m][n] = __builtin_amdgcn_mfma_f32_16x16x32_bf16(Bt[n][k], At[m][k], acc[ai][bj][m][n], 0, 0, 0); } } \
        __builtin_amdgcn_s_setprio(0); } while (0)
#define PG8_WAIT_V(n) asm volatile("s_waitcnt vmcnt(" #n ")" ::: "memory")
#define PG8_WAIT_L(n) asm volatile("s_waitcnt lgkmcnt(" #n ")" ::: "memory")
#define PG8_BAR __builtin_amdgcn_s_barrier()
#define PG8_SCHED __builtin_amdgcn_sched_barrier(0)
    Unit cur, nxt;
    if (!S.next(cur)) return;
    f32x4 acc[2][2][4][2];
#pragma unroll
    for (int a = 0; a < 2; ++a)
#pragma unroll
        for (int b = 0; b < 2; ++b)
#pragma unroll
            for (int m = 0; m < 4; ++m)
#pragma unroll
                for (int n = 0; n < 2; ++n) { acc[a][b][m][n] = (f32x4){0.f, 0.f, 0.f, 0.f}; if constexpr (FP8) asm volatile("" : "+v"(acc[a][b][m][n])); }
    bf16x8 At[4][2], B0[2][2], B1[2][2]; i32x8 At8[4], B08[2], B18[2];
    const char* cA = cur.a; const char* cB = cur.b;
    PG8_STAGE(PG8_SB(0, 0), cB, voffB); PG8_STAGE(PG8_SB(0, 1), cB + hstepB, voffB); PG8_STAGE(PG8_SA(0, 0), cA, voffA); PG8_STAGE(PG8_SA(0, 1), cA + hstepA, voffA);
    if (wr == 1) PG8_BAR;
    PG8_WAIT_V(2); PG8_BAR;
    PG8_STAGE(PG8_SB(1, 0), cB + kstep, voffB); PG8_STAGE(PG8_SA(1, 0), cA + kstep, voffA); PG8_STAGE(PG8_SB(1, 1), cB + hstepB + kstep, voffB);
    PG8_WAIT_V(6); PG8_BAR;
    for (;;) {
        const bool has_next = S.next(nxt);
        const char* nA = has_next ? nxt.a : cA; const char* nB = has_next ? nxt.b : cB;
#pragma unroll 1
        for (int t = 0; t < nt; t += 2) {
            const bool last = (t == nt - 2);
            const char* a1 = cA + (size_t)(t + 1) * kstep;
            const char* a2 = last ? nA : cA + (size_t)(t + 2) * kstep; const char* b2 = last ? nB : cB + (size_t)(t + 2) * kstep;
            const char* a3 = a2 + kstep; const char* b3 = b2 + kstep;
            PG8_LDB(B0, 0, 0); PG8_LDB(B1, 0, 1); PG8_SCHED; PG8_LDA(At, 0, 0); PG8_STAGE(PG8_SA(1, 1), a1 + hstepA, voffA);
            PG8_WAIT_V(8); PG8_WAIT_L(0); PG8_BAR; PG8_MMA(0, 0, At, B0); PG8_MMA(0, 1, At, B1); PG8_BAR; PG8_SCHED;
            PG8_LDA(At, 0, 1); PG8_STAGE(PG8_SB(0, 0), b2, voffB); PG8_STAGE(PG8_SB(0, 1), b2 + hstepB, voffB); PG8_STAGE(PG8_SA(0, 0), a2, voffA);
            PG8_WAIT_V(8); PG8_WAIT_L(0); PG8_BAR; PG8_MMA(1, 0, At, B0); PG8_MMA(1, 1, At, B1); PG8_BAR; PG8_SCHED;
            PG8_LDB(B0, 1, 0); PG8_LDB(B1, 1, 1); PG8_SCHED; PG8_LDA(At, 1, 0); PG8_STAGE(PG8_SA(0, 1), a2 + hstepA, voffA);
            PG8_WAIT_V(8); PG8_WAIT_L(0); PG8_BAR; PG8_MMA(0, 0, At, B0); PG8_MMA(0, 1, At, B1); PG8_BAR; PG8_SCHED;
            PG8_LDA(At, 1, 1); PG8_STAGE(PG8_SB(1, 0), b3, voffB); PG8_STAGE(PG8_SB(1, 1), b3 + hstepB, voffB); PG8_STAGE(PG8_SA(1, 0), a3, voffA);
            PG8_WAIT_V(8); PG8_WAIT_L(0); PG8_BAR; PG8_MMA(1, 0, At, B0); PG8_MMA(1, 1, At, B1); PG8_BAR; PG8_SCHED;
        }
        if (wr == 0) PG8_BAR;
        if constexpr (FP8) { asm volatile("s_nop 15\n\ts_nop 15" ::: "memory"); PG8_SCHED; }
        const unsigned long long e0_ = eacc ? __builtin_amdgcn_s_memtime() : 0ull;
        const bool zero = E(acc, cur, wr, wc, fr, fq);
        if (eacc) { asm volatile("s_waitcnt vmcnt(0)" ::: "memory"); *eacc += __builtin_amdgcn_s_memtime() - e0_; }
        if (!has_next) break;
        if (zero) {
#pragma unroll
            for (int a = 0; a < 2; ++a)
#pragma unroll
                for (int b = 0; b < 2; ++b)
#pragma unroll
                    for (int m = 0; m < 4; ++m)
#pragma unroll
                        for (int n = 0; n < 2; ++n) { acc[a][b][m][n] = (f32x4){0.f, 0.f, 0.f, 0.f}; if constexpr (FP8) asm volatile("" : "+v"(acc[a][b][m][n])); }
        }
        cur = nxt; cA = nA; cB = nB;
        if (wr == 1) PG8_BAR;
    }
    PG8_WAIT_V(0);
    PG8_BAR;
#undef PG8_SA
#undef PG8_SB
#undef PG8_STAGE
#undef PG8_LDA
#undef PG8_LDB
#undef PG8_MMA
#undef PG8_WAIT_V
#undef PG8_WAIT_L
#undef PG8_BAR
#undef PG8_SCHED
}
}
using pg8::Unit;

namespace att {
constexpr int QBLK = 32, KVBLK = 64, LD = 512;
constexpr int SHM_V = KVBLK * 128 * 2, SHM_K = KVBLK * 64 * 2;
constexpr int OFF_V = 0, OFF_K = 3 * SHM_V, OFF_WS = OFF_K + 3 * SHM_K, ATT_LDS = OFF_WS + 8 * 64 * 4;
constexpr float THRL = 8.0f;
#define KSWZ(row, colB) ((row) * 128 + ((colB) ^ ((((row) >> 1) & 7) << 4)))
#define SBAR() __builtin_amdgcn_sched_barrier(0)
__device__ __forceinline__ int crow(int r, int hi) { return (r & 3) + 8 * (r >> 2) + 4 * hi; }

__device__ __forceinline__ void partialSM(f32x16& p0, f32x16& p1, float& m_reg, float& alpha) {
    float pmax = p0[0];
#pragma unroll
    for (int r = 1; r < 16; ++r) pmax = fmaxf(pmax, p0[r]);
#pragma unroll
    for (int r = 0; r < 16; ++r) pmax = fmaxf(pmax, p1[r]);
    { auto rr = __builtin_amdgcn_permlane32_swap(__float_as_uint(pmax), __float_as_uint(pmax), false, false);
      pmax = fmaxf(__uint_as_float(rr[0]), __uint_as_float(rr[1])); }
    if (__builtin_expect(__all(pmax - m_reg <= THRL), 1)) { alpha = 1.f; }
    else { const float mn = fmaxf(m_reg, pmax); alpha = __builtin_amdgcn_exp2f(m_reg - mn); m_reg = mn; }
    const float mm = m_reg;
#pragma unroll
    for (int r = 0; r < 16; ++r) p0[r] = p0[r] - mm;
#pragma unroll
    for (int r = 0; r < 16; ++r) p1[r] = p1[r] - mm;
#pragma unroll
    for (int r = 0; r < 16; ++r) p0[r] = __builtin_amdgcn_exp2f(p0[r]);
}
__device__ __forceinline__ void finishSM(f32x16& p0, f32x16& p1, float alpha, float& l_reg, bf16x8& pa0, bf16x8& pa1, bf16x8& pa2, bf16x8& pa3) {
#pragma unroll
    for (int r = 0; r < 16; ++r) p1[r] = __builtin_amdgcn_exp2f(p1[r]);
    float ps = 0;
#pragma unroll
    for (int r = 0; r < 16; ++r) ps += p0[r];
#pragma unroll
    for (int r = 0; r < 16; ++r) ps += p1[r];
    { auto rr = __builtin_amdgcn_permlane32_swap(__float_as_uint(ps), __float_as_uint(ps), false, false);
      ps = __uint_as_float(rr[0]) + __uint_as_float(rr[1]); }
    l_reg = l_reg * alpha + ps;
#define PK4(P, BASE, OUT) do { unsigned a0 = cvt_pk_bf16(P[BASE + 0], P[BASE + 1]), a1 = cvt_pk_bf16(P[BASE + 2], P[BASE + 3]);   \
    unsigned b0 = cvt_pk_bf16(P[BASE + 4], P[BASE + 5]), b1 = cvt_pk_bf16(P[BASE + 6], P[BASE + 7]);                              \
    auto r0 = __builtin_amdgcn_permlane32_swap(a0, b0, false, false); auto r1 = __builtin_amdgcn_permlane32_swap(a1, b1, false, false); \
    u32x4 w = {r0[0], r1[0], r0[1], r1[1]}; OUT = *reinterpret_cast<bf16x8*>(&w); } while (0)
    PK4(p0, 0, pa0); PK4(p0, 8, pa1); PK4(p1, 0, pa2); PK4(p1, 8, pa3);
#undef PK4
}
__device__ __forceinline__ void qkt(f32x16& p0, f32x16& p1, const char* Ks, const bf16x8* qr, int r32, int hi) {
    p0 = f32x16{}; p1 = f32x16{};
#pragma unroll
    for (int d0 = 0; d0 < 4; ++d0) { const int cb = (d0 * 16 + hi * 8) * 2;
        const bf16x8 b0 = *reinterpret_cast<const bf16x8*>(Ks + KSWZ(r32, cb));
        const bf16x8 b1 = *reinterpret_cast<const bf16x8*>(Ks + KSWZ(32 + r32, cb));
        p0 = __builtin_amdgcn_mfma_f32_32x32x16_bf16(b0, qr[d0], p0, 0, 0, 0);
        p1 = __builtin_amdgcn_mfma_f32_32x32x16_bf16(b1, qr[d0], p1, 0, 0, 0);
 }
}
__device__ __forceinline__ int v_st(int k, int c) { const int kk = (k & ~0xC) | ((k & 4) << 1) | ((k & 8) >> 1); return ((kk >> 3) * 4 + (c >> 5)) * 512 + ((kk & 7) * 32 + (c & 31)) * 2; }
__device__ __forceinline__ int v_rd_base(int lane) { return ((lane & 3) << 3) | (((lane >> 2) & 3) << 6) | (((lane >> 4) & 1) << 5) | (((lane >> 5) & 1) << 8); }
constexpr int v_rd_off(int d0, int ks, int half) { return d0 * 512 + ks * 4096 + half * 2048; }
template <int OFF> __device__ __forceinline__ s16x4 tr_read(int vb) {
    s16x4 r; asm volatile("ds_read_b64_tr_b16 %0, %1 offset:%2" : "=&v"(r) : "v"(vb), "i"(OFF) : "memory"); return r;
}
template <int D0> __device__ __forceinline__ void pv_one(f32x16& od, int vb, bf16x8 pa0, bf16x8 pa1, bf16x8 pa2, bf16x8 pa3) {
    const s16x4 l0 = tr_read<v_rd_off(D0, 0, 0)>(vb), h0 = tr_read<v_rd_off(D0, 0, 1)>(vb), l1 = tr_read<v_rd_off(D0, 1, 0)>(vb), h1 = tr_read<v_rd_off(D0, 1, 1)>(vb);
    const s16x4 l2 = tr_read<v_rd_off(D0, 2, 0)>(vb), h2 = tr_read<v_rd_off(D0, 2, 1)>(vb), l3 = tr_read<v_rd_off(D0, 3, 0)>(vb), h3 = tr_read<v_rd_off(D0, 3, 1)>(vb);
    asm volatile("s_waitcnt lgkmcnt(0)" ::: "memory"); SBAR();
#define PK(L, H) (bf16x8){L[0], L[1], L[2], L[3], H[0], H[1], H[2], H[3]}
    od = __builtin_amdgcn_mfma_f32_32x32x16_bf16(pa0, PK(l0, h0), od, 0, 0, 0);
    od = __builtin_amdgcn_mfma_f32_32x32x16_bf16(pa1, PK(l1, h1), od, 0, 0, 0);
    od = __builtin_amdgcn_mfma_f32_32x32x16_bf16(pa2, PK(l2, h2), od, 0, 0, 0);
    od = __builtin_amdgcn_mfma_f32_32x32x16_bf16(pa3, PK(l3, h3), od, 0, 0, 0);
#undef PK
}
__device__ __forceinline__ void pv_d0(f32x16* o, int vb, bf16x8 pa0, bf16x8 pa1, bf16x8 pa2, bf16x8 pa3) {
    pv_one<0>(o[0], vb, pa0, pa1, pa2, pa3); pv_one<1>(o[1], vb, pa0, pa1, pa2, pa3); pv_one<2>(o[2], vb, pa0, pa1, pa2, pa3); pv_one<3>(o[3], vb, pa0, pa1, pa2, pa3);
}

constexpr int OFF_CVT = 80 * 1024;
struct CvtSide { const float* const* in; unsigned char* ws; LAS unsigned char* buf; int gw, t, tlim; bool pend; };
__device__ __forceinline__ void cvt_side_store(CvtSide& c, int lane) {
    const int t = c.t - 1, mat = t >> 4, i = t & 15, n = lane & 31, kh = lane >> 5, e = c.gw >> 7, w = c.gw & 127, f = (w >> 1) * 32 + n;
    unsigned char* d = c.ws + WS_WGU + (size_t)(e * 4096 + (f >> 2) * 8 + (f & 3) + mat * 4) * 1024 + (512 * (w & 1) + i * 32 + kh * 16);
    const LAS float* b = (const LAS float*)c.buf + kh * 512 + n; float x[16];
#pragma unroll
    for (int k = 0; k < 16; ++k) x[k] = b[k * 32] * 32.0f;
    u32x4 o; o.x = pk_fp8x4(x[0], x[1], x[2], x[3]); o.y = pk_fp8x4(x[4], x[5], x[6], x[7]); o.z = pk_fp8x4(x[8], x[9], x[10], x[11]); o.w = pk_fp8x4(x[12], x[13], x[14], x[15]);
    *(u32x4*)d = o;
    c.pend = false;
}
__device__ __forceinline__ void cvt_side_load(CvtSide& c, int lane) {
    const int t = c.t, mat = t >> 4, i = t & 15, row = lane >> 3, seg = lane & 7, e = c.gw >> 7, w = c.gw & 127;
    const float* s = c.in[26 + mat] + (size_t)e * 1024 * 2048 + (size_t)(512 * (w & 1) + i * 32 + row) * 2048 + (w >> 1) * 32 + seg * 4;
#pragma unroll
    for (int r = 0; r < 4; ++r) __builtin_amdgcn_global_load_lds((const unsigned*)(s + (size_t)(r * 8) * 2048), (LAS unsigned*)(c.buf + r * 1024), 16, 0, 0);
    ++c.t; c.pend = true;
}

__device__ __forceinline__ void attn_unit(const bf16_t* Qb, const bf16_t* Kh, const bf16_t* Vh, bf16_t* Ob, int seq, char* lds, CvtSide& cs, unsigned long long* bacc = nullptr) {
    const int tid = threadIdx.x, wid = tid >> 6, lane = tid & 63, r32 = lane & 31, hi = lane >> 5;
    char* V_lds = lds + OFF_V; char* K_lds = lds + OFF_K;
    float* ws = (float*)(lds + OFF_WS) + wid * 64; float* li_l = ws; float* al_l = ws + 32;
    float m_reg = -1e30f, l_reg = 0; f32x16 o[4] = {}; bf16x8 qr[4];
    const bf16_t* Qw = Qb + (long)(wid * QBLK + r32) * LD + hi * 8;
#pragma unroll
    for (int d0 = 0; d0 < 4; ++d0) qr[d0] = *reinterpret_cast<const bf16x8*>(Qw + d0 * 16);
    const int sr = tid >> 4, sc = (tid & 15) * 8, vst0 = v_st(sr, sc), vst1 = v_st(32 + sr, sc);
    const int kr = tid >> 3, kc = (tid & 7) * 8, kst = KSWZ(kr, kc * 2);
    const int vb0 = (int)(uintptr_t)V_lds + v_rd_base(lane);
    struct { bf16x8 vs0, vs1, ks0; } sr_[1];
#define SLOAD(i, k0) do { sr_[i].vs0 = *reinterpret_cast<const bf16x8*>(&Vh[(long)((k0) + sr) * LD + sc]); sr_[i].vs1 = *reinterpret_cast<const bf16x8*>(&Vh[(long)((k0) + 32 + sr) * LD + sc]); \
    sr_[i].ks0 = *reinterpret_cast<const bf16x8*>(&Kh[(long)((k0) + kr) * LD + kc]); } while (0)
#define SWRITE(b, i) do { *(bf16x8*)(V_lds + (b) * SHM_V + vst0) = sr_[i].vs0; *(bf16x8*)(V_lds + (b) * SHM_V + vst1) = sr_[i].vs1; \
    *(bf16x8*)(K_lds + (b) * SHM_K + kst) = sr_[i].ks0; } while (0)
#define SWAIT() asm volatile("s_waitcnt vmcnt(3)" ::: "memory")
#define RESC(a) do { if (__any((a) < 1.f)) { if (hi == 0) al_l[r32] = (a); asm volatile("s_waitcnt lgkmcnt(0)" ::: "memory"); \
    _Pragma("unroll") for (int d = 0; d < 4; ++d) _Pragma("unroll") for (int r = 0; r < 16; ++r) o[d][r] *= al_l[crow(r, hi)]; } } while (0)
    f32x16 pA0, pA1, pB0, pB1; float alA, alB; bf16x8 pa0, pa1, pa2, pa3; const int NT = seq / KVBLK;
    SLOAD(0, 0); asm volatile("s_waitcnt vmcnt(0)" ::: "memory"); SWRITE(0, 0); SLOAD(0, KVBLK); __syncthreads();
    qkt(pA0, pA1, K_lds, qr, r32, hi); partialSM(pA0, pA1, m_reg, alA);
    SWRITE(1, 0); if (2 < NT) SLOAD(0, 2 * KVBLK); __syncthreads();
    int bp = 0, bc = 1, bn = 2;
    for (int j = 1; j + 1 < NT; j += 2) {
        SWRITE(bn, 0);
        if (cs.pend) { if (SIDE_PROBE != 1) cvt_side_store(cs, lane); else cs.pend = false; }
        SLOAD(0, (j + 2) * KVBLK);
        if ((j & 2) && cs.t < cs.tlim) { if (SIDE_PROBE != 2) cvt_side_load(cs, lane); else { ++cs.t; cs.pend = true; } }
        SBAR(); qkt(pB0, pB1, K_lds + bc * SHM_K, qr, r32, hi);
        finishSM(pA0, pA1, alA, l_reg, pa0, pa1, pa2, pa3); SBAR();
        pv_d0(o, vb0 + bp * SHM_V, pa0, pa1, pa2, pa3); partialSM(pB0, pB1, m_reg, alB);
        RESC(alB); { const unsigned long long b0_ = bacc ? __builtin_amdgcn_s_memtime() : 0ull; __syncthreads(); if (bacc) *bacc += __builtin_amdgcn_s_memtime() - b0_; }
        { const int t_ = bp; bp = bc; bc = bn; bn = t_; }
        SWRITE(bn, 0); if (j + 3 < NT) SLOAD(0, (j + 3) * KVBLK);
        SBAR(); qkt(pA0, pA1, K_lds + bc * SHM_K, qr, r32, hi);
        finishSM(pB0, pB1, alB, l_reg, pa0, pa1, pa2, pa3); SBAR();
        pv_d0(o, vb0 + bp * SHM_V, pa0, pa1, pa2, pa3); partialSM(pA0, pA1, m_reg, alA);
        RESC(alA); { const unsigned long long b0_ = bacc ? __builtin_amdgcn_s_memtime() : 0ull; __syncthreads(); if (bacc) *bacc += __builtin_amdgcn_s_memtime() - b0_; }
        { const int t_ = bp; bp = bc; bc = bn; bn = t_; }
    }
    SBAR(); qkt(pB0, pB1, K_lds + bc * SHM_K, qr, r32, hi);
    finishSM(pA0, pA1, alA, l_reg, pa0, pa1, pa2, pa3); SBAR();
    pv_d0(o, vb0 + bp * SHM_V, pa0, pa1, pa2, pa3); partialSM(pB0, pB1, m_reg, alB);
    RESC(alB);
    finishSM(pB0, pB1, alB, l_reg, pa0, pa1, pa2, pa3); SBAR();
    pv_d0(o, vb0 + bc * SHM_V, pa0, pa1, pa2, pa3);
    if (hi == 0) li_l[r32] = l_reg; asm volatile("s_waitcnt lgkmcnt(0)" ::: "memory");
    float rli[16];
#pragma unroll
    for (int r = 0; r < 16; ++r) rli[r] = __builtin_amdgcn_rcpf(li_l[crow(r, hi)]);
    bf16_t* Ow = Ob + (long)(wid * QBLK) * LD;
#pragma unroll
    for (int r = 0; r < 16; ++r) { const int orow = crow(r, hi);
#pragma unroll
        for (int d0 = 0; d0 < 4; ++d0) Ow[(long)orow * LD + d0 * 32 + r32] = (bf16_t)(cvt_pk_bf16(o[d0][r] * rli[r], 0.f) & 0xffffu); }
    __syncthreads();
#undef SLOAD
#undef SWRITE
#undef SWAIT
#undef RESC
}
#undef KSWZ
#undef SBAR
}


#define XB_TMO      128
#define XB_XCNT(j)  (256  + 64 * (j))
#define XB_XSUB(j)  (1280 + 64 * (j))
#define XB_XGEN(j)  (2304 + 64 * (j))
#define XB_TOP      3328
#define XB_TOPGEN   3392
#define XCD_BAR_WORDS 3456
#define XB_SPIN_CAP (1u << 18)

__device__ __forceinline__ unsigned xb_ld(unsigned* p)              { return __hip_atomic_load(p, __ATOMIC_RELAXED, __HIP_MEMORY_SCOPE_AGENT); }
__device__ __forceinline__ unsigned xb_add(unsigned* p, unsigned v) { return __hip_atomic_fetch_add(p, v, __ATOMIC_RELAXED, __HIP_MEMORY_SCOPE_AGENT); }
__device__ __forceinline__ unsigned xb_xcc_id() { return (unsigned)__builtin_amdgcn_s_getreg((3 << 11) | 20) & 0xFu; }
#define XB_SPIN(cond, bar) do { unsigned _sp = 0; while (cond) { __builtin_amdgcn_s_sleep(1); \
    if ((++_sp & 255u) == 0u) { if (xb_ld(&(bar)[XB_TMO])) break; if (_sp > XB_SPIN_CAP) { atomicAdd(&(bar)[XB_TMO], 1u); break; } } } } while (0)

struct XcdBarrier {
    unsigned* bar; unsigned x;
    volatile LAS unsigned* st;
};

__device__ __forceinline__ XcdBarrier xcd_barrier_post(unsigned* bar, volatile LAS unsigned* st) {
    XcdBarrier b; b.bar = bar; b.x = xb_xcc_id(); b.st = st;
    if (threadIdx.x == 0) (void)xb_add(&bar[XB_XCNT(b.x)], 1u);
    return b;
}
__device__ __forceinline__ void xcd_barrier_complete(unsigned* bar, unsigned x, unsigned& nloc, unsigned& nx) {
    const unsigned G = gridDim.x * gridDim.y * gridDim.z;
    unsigned sum, cnt, mine, sp = 0u;
    for (;;) {
        sum = 0u; cnt = 0u; mine = 0u;
#pragma unroll
        for (unsigned j = 0; j < 16; ++j) { const unsigned c = xb_ld(&bar[XB_XCNT(j)]); sum += c; cnt += (c > 0u) ? 1u : 0u; mine = (j == x) ? c : mine; }
        if (sum == G) break;
        __builtin_amdgcn_s_sleep(1);
        if ((++sp & 255u) == 0u) { if (xb_ld(&bar[XB_TMO])) break; if (sp > XB_SPIN_CAP) { atomicAdd(&bar[XB_TMO], 1u); break; } }
    }
    nloc = mine > 0u ? mine : 1u; nx = cnt > 0u ? cnt : 1u;
}

__device__ __forceinline__ void xcd_barrier(const XcdBarrier& b) {
    asm volatile("s_waitcnt vmcnt(0)" ::: "memory");
    __syncthreads();
    if (threadIdx.x == 0) {
        unsigned* bar = b.bar;
        __builtin_amdgcn_s_waitcnt(0);
        unsigned nloc = b.st[0], nx = b.st[1];
        if (nloc == 0u) { xcd_barrier_complete(bar, b.x, nloc, nx); b.st[0] = nloc; b.st[1] = nx; }
        const unsigned old = xb_add(&bar[XB_XSUB(b.x)], 1u);
        const unsigned gen = old / nloc;
        if (old + 1u == (gen + 1u) * nloc) {
            __builtin_amdgcn_fence(__ATOMIC_RELEASE, "agent");
            asm volatile("s_waitcnt vmcnt(0)" ::: "memory");
            const unsigned og = xb_add(&bar[XB_TOP], 1u);
            const unsigned tg = og / nx;
            if (og + 1u == (tg + 1u) * nx) xb_add(&bar[XB_TOPGEN], 1u);
            else XB_SPIN(xb_ld(&bar[XB_TOPGEN]) == tg, bar);
            __builtin_amdgcn_fence(__ATOMIC_ACQUIRE, "agent");
            xb_add(&bar[XB_XGEN(b.x)], 1u);
            asm volatile("s_waitcnt vmcnt(0)" ::: "memory");
        } else {
            XB_SPIN(xb_ld(&bar[XB_XGEN(b.x)]) == gen, bar);
            __builtin_amdgcn_fence(__ATOMIC_ACQUIRE, "agent");
            asm volatile("s_waitcnt vmcnt(0)" ::: "memory");
        }
    }
    __syncthreads();
}


struct Args { const float* in[29]; float* out; unsigned char* ws; int ph_lo, ph_hi; };
enum { I_X = 0, I_C, I_CTX, I_CCTX, I_WADA, I_BADA, I_NPREMIX, I_NPOSTMIX, I_NPREFFN, I_NPOSTFFN, I_WIN, I_LAMRE, I_LAMIM, I_LOGDT, I_BRE, I_BIM,
       I_CRE, I_CIM, I_S5D, I_WGLU, I_DALAM, I_SUBLN, I_WPA, I_WPB, I_WOUT, I_WROUTER, I_WEG, I_WEU, I_WED };

__device__ __forceinline__ unsigned pk2(float lo, float hi) { return cvt_pk_bf16(lo, hi); }
__device__ __forceinline__ void transpose_item(const float* colp, size_t ld, bf16_t* dst, int dK, LAS float* scr, int lane) {
#pragma unroll 8
    for (int kk = 0; kk < 64; ++kk) scr[kk * 65 + lane] = colp[(size_t)kk * ld];
    asm volatile("s_waitcnt lgkmcnt(0)" ::: "memory");
    const int c = lane & 7;
#pragma unroll
    for (int j = 0; j < 8; ++j) { const int n = (lane >> 3) + 8 * j; const LAS float* s = scr + (8 * c) * 65 + n;
        u32x4 o; o.x = pk2(s[0 * 65], s[1 * 65]); o.y = pk2(s[2 * 65], s[3 * 65]); o.z = pk2(s[4 * 65], s[5 * 65]); o.w = pk2(s[6 * 65], s[7 * 65]);
        *(u32x4*)(dst + (size_t)n * dK + 8 * c) = o; }
    asm volatile("s_waitcnt lgkmcnt(0)" ::: "memory");
}
__device__ __forceinline__ void cvt_item(const float* src, size_t ld, bf16_t* dst, size_t dK, int rstep, int lane) {
    const int ng = lane & 15, kg = lane >> 4;
    f32x4 v[2][8];
#pragma unroll
    for (int h = 0; h < 2; ++h)
#pragma unroll
        for (int i = 0; i < 8; ++i) v[h][i] = *(const f32x4*)(src + (size_t)(h * 32 + kg * 8 + i) * ld + ng * 4);
#pragma unroll
    for (int h = 0; h < 2; ++h)
#pragma unroll
        for (int j = 0; j < 4; ++j) { u32x4 o; o.x = cvt_pk_bf16(v[h][0][j], v[h][1][j]); o.y = cvt_pk_bf16(v[h][2][j], v[h][3][j]); o.z = cvt_pk_bf16(v[h][4][j], v[h][5][j]); o.w = cvt_pk_bf16(v[h][6][j], v[h][7][j]);
            *(u32x4*)(dst + (size_t)(ng * rstep + j) * dK + h * 32 + kg * 8) = o; }
}
__device__ __forceinline__ void cvt_item8(const float* src, size_t ld, unsigned char* dst, size_t dK, int rstep, float scale, int lane) {
    const int ng = lane & 15, kg = lane >> 4;
    f32x4 v[16];
#pragma unroll
    for (int i = 0; i < 16; ++i) v[i] = *(const f32x4*)(src + (size_t)(kg * 16 + i) * ld + ng * 4);
#pragma unroll
    for (int j = 0; j < 4; ++j) { u32x4 o; o.x = pk_fp8x4(v[0][j] * scale, v[1][j] * scale, v[2][j] * scale, v[3][j] * scale); o.y = pk_fp8x4(v[4][j] * scale, v[5][j] * scale, v[6][j] * scale, v[7][j] * scale);
        o.z = pk_fp8x4(v[8][j] * scale, v[9][j] * scale, v[10][j] * scale, v[11][j] * scale); o.w = pk_fp8x4(v[12][j] * scale, v[13][j] * scale, v[14][j] * scale, v[15][j] * scale);
        *(u32x4*)(dst + (size_t)(ng * rstep + j) * dK + kg * 16) = o; }
}
__device__ __forceinline__ int permq(int n) { const int p = n & 31, a = p >> 3, b = p & 7; return (n & ~31) + ((b < 4) ? (4 * a + b) : (16 + 4 * a + (b - 4))); }

__device__ __forceinline__ void mod_task(int col0, const float* c, const float* cctx, const float* wada, const float* bada, float* MOD, LAS float* L) {
    const int tid = threadIdx.x;
    LAS float* sc = L; LAS float* red = L + 9 * 1024;
    for (int i = tid; i < 9 * 1024; i += 512) { const int row = i >> 10, k = i & 1023; const float v = row < 8 ? c[row * 1024 + k] : cctx[k]; sc[i] = v * sigmoidf_(v); }
    __syncthreads();
    const int cl = tid & 31, kg = tid >> 5, col = col0 + cl;
    float acc[9];
#pragma unroll
    for (int r = 0; r < 9; ++r) acc[r] = 0.f;
#pragma unroll 16
    for (int k = kg; k < 1024; k += 16) { const float w = wada[(size_t)k * 6144 + col];
#pragma unroll
        for (int r = 0; r < 9; ++r) acc[r] += sc[r * 1024 + k] * w; }
#pragma unroll
    for (int r = 0; r < 9; ++r) red[(kg * 9 + r) * 32 + cl] = acc[r];
    __syncthreads();
    if (tid < 288) { const int r = tid >> 5, cc = tid & 31; float s = 0.f;
#pragma unroll
        for (int g = 0; g < 16; ++g) s += red[(g * 9 + r) * 32 + cc];
        MOD[r * 6144 + col0 + cc] = s + bada[col0 + cc]; }
    __syncthreads();
}

__device__ __forceinline__ void s5_tables_task(int g, int dir, const Args& A, bf16_t* Bcat, bf16_t* Wcat, LAS float* L) {
    const int tid = threadIdx.x;
    constexpr int CP = 68;
    LAS float* pw_re = L; LAS float* pw_im = L + 1088; LAS float* Bb_re = L + 2176; LAS float* Bb_im = L + 3200; LAS float* C_re = L + 4224; LAS float* C_im = L + 5312;
    LAS float* Kt = L + 6400; LAS float* K0o = L + 10496; LAS float* Bb2_re = L + 10752; LAS float* Bb2_im = L + 11776; LAS float* C2_re = L + 12800; LAS float* C2_im = L + 13824;
    const float* lam_re = A.in[I_LAMRE]; const float* lam_im = A.in[I_LAMIM]; const float* log_dt = A.in[I_LOGDT];
    const float* b_re = A.in[I_BRE]; const float* b_im = A.in[I_BIM]; const float* c_re = A.in[I_CRE]; const float* c_im = A.in[I_CIM]; const float* s5d = A.in[I_S5D];
    { const int which = tid >> 8, p = (tid >> 2) & 63, hq = tid & 3, d = which ? 1 - dir : dir;
      if (which == 0 || dir == 0) { const int gi = d * 32 + g;
        const float lr = fminf(lam_re[gi * 64 + p], -1e-4f), li = lam_im[gi * 64 + p], dt = expf(log_dt[gi]);
        const f32x4 br = *(const f32x4*)(b_re + (size_t)(gi * 64 + p) * 16 + hq * 4), bi = *(const f32x4*)(b_im + (size_t)(gi * 64 + p) * 16 + hq * 4);
        const float lrd = lr * dt, lid = li * dt;
        float sn, cs; sincos_fast(lid, &sn, &cs); const float mag = expf(lrd);
        const float lb_re = mag * cs, lb_im = mag * sn, den = lr * lr + li * li, num_re = lb_re - 1.0f;
        const float co_re = (num_re * lr + lb_im * li) / den, co_im = (lb_im * lr - num_re * li) / den;
        LAS float* dre = which ? Bb2_re : Bb_re; LAS float* dim_ = which ? Bb2_im : Bb_im;
        *(LAS f32x4*)(dre + p * 16 + hq * 4) = co_re * br - co_im * bi; *(LAS f32x4*)(dim_ + p * 16 + hq * 4) = co_re * bi + co_im * br; } }
    for (int i = tid; i < 1088; i += 512) { const int tau = i >> 6, p = i & 63, gi = dir * 32 + g;
        const float lr = fminf(lam_re[gi * 64 + p], -1e-4f), li = lam_im[gi * 64 + p], dt = expf(log_dt[gi]), lrd = lr * dt, lid = li * dt;
        float s2, c2; sincos_fast((float)tau * lid, &s2, &c2); const float m2 = expf((float)tau * lrd);
        pw_re[i] = m2 * c2; pw_im[i] = m2 * s2; }
    for (int i = tid; i < 1024; i += 512) { const int ci_ = (i >> 6) * CP + (i & 63); C_re[ci_] = c_re[(dir * 32 + g) * 1024 + i]; C_im[ci_] = c_im[(dir * 32 + g) * 1024 + i];
        if (dir == 0) { C2_re[i] = c_re[(32 + g) * 1024 + i]; C2_im[i] = c_im[(32 + g) * 1024 + i]; } }
    __syncthreads();
    { const int tau = tid >> 5, chp = (tid >> 1) & 15, ch0 = (tid & 1) * 8; f32x4 a0 = {0.f, 0.f, 0.f, 0.f}, a1 = {0.f, 0.f, 0.f, 0.f};
#pragma unroll 2
      for (int p = 0; p < 64; p += 4) { const f32x4 cr = *(const LAS f32x4*)(C_re + chp * CP + p), ci = *(const LAS f32x4*)(C_im + chp * CP + p), wr_ = *(const LAS f32x4*)(pw_re + tau * 64 + p), wi = *(const LAS f32x4*)(pw_im + tau * 64 + p);
          const f32x4 tr = cr * wr_ - ci * wi, ti = cr * wi + ci * wr_;
#pragma unroll
          for (int q = 0; q < 4; ++q) { const LAS float* br = Bb_re + (p + q) * 16 + ch0; const LAS float* bi = Bb_im + (p + q) * 16 + ch0;
              a0 += tr[q] * *(const LAS f32x4*)br - ti[q] * *(const LAS f32x4*)bi; a1 += tr[q] * *(const LAS f32x4*)(br + 4) - ti[q] * *(const LAS f32x4*)(bi + 4); } }
      *(LAS f32x4*)(Kt + tau * 256 + chp * 16 + ch0) = a0; *(LAS f32x4*)(Kt + tau * 256 + chp * 16 + ch0 + 4) = a1; }
    if (dir == 0 && tid < 256) { const int chp = tid >> 4, ch = tid & 15; float acc = 0.f;
#pragma unroll 4
        for (int p = 0; p < 64; ++p) acc += C2_re[chp * 64 + p] * Bb2_re[p * 16 + ch] - C2_im[chp * 64 + p] * Bb2_im[p * 16 + ch];
        K0o[tid] = acc + (chp == ch ? s5d[g * 16 + ch] : 0.f); }
    __syncthreads();
    bf16_t* Wg = Wcat + (size_t)g * 256 * 512;
#pragma unroll 1
    for (int j = 0; j < 16; ++j) { const int q = tid + 512 * j, n = q >> 5, kc = q & 31, s = kc >> 1, ch0 = (kc & 1) * 8, t = n >> 4, chp = n & 15;
        const bool mine = (dir == 0) ? (s <= t) : (s > t);
        if (mine) { float v[8]; const int tau = (dir == 0) ? (t - s) : (s - t);
#pragma unroll
            for (int i = 0; i < 8; ++i) { v[i] = Kt[tau * 256 + chp * 16 + ch0 + i]; if (tau == 0) v[i] += K0o[chp * 16 + ch0 + i]; }
            u32x4 o; o.x = pk2(v[0], v[1]); o.y = pk2(v[2], v[3]); o.z = pk2(v[4], v[5]); o.w = pk2(v[6], v[7]);
            *(u32x4*)(Wg + (size_t)n * 512 + kc * 8) = o; } }
#pragma unroll 1
    for (int j = 0; j < 8; ++j) { const int q = tid + 512 * j, n = q >> 4, pc = q & 15, ri = pc >> 3, p0 = (pc & 7) * 8, t = n >> 4, chp = n & 15, e = (dir == 0) ? (t + 1) : (16 - t);
        float v[8];
#pragma unroll
        for (int i = 0; i < 8; ++i) { const int p = p0 + i; const float cr = C_re[chp * CP + p], ci = C_im[chp * CP + p], wr_ = pw_re[e * 64 + p], wi = pw_im[e * 64 + p];
            v[i] = (ri == 0) ? (cr * wr_ - ci * wi) : -(cr * wi + ci * wr_); }
        u32x4 o; o.x = pk2(v[0], v[1]); o.y = pk2(v[2], v[3]); o.z = pk2(v[4], v[5]); o.w = pk2(v[6], v[7]);
        *(u32x4*)(Wg + (size_t)n * 512 + 256 + dir * 128 + ri * 64 + p0) = o; }
    bf16_t* Bg = Bcat + (size_t)g * 256 * 256;
#pragma unroll 1
    for (int j = 0; j < 8; ++j) { const int q = tid + 512 * j, nl = q >> 5, ri = nl >> 6, p = nl & 63, kc = q & 31, s = kc >> 1, ch0 = (kc & 1) * 8, e = (dir == 0) ? (15 - s) : s;
        const float wr_ = pw_re[e * 64 + p], wi = pw_im[e * 64 + p]; float v[8];
#pragma unroll
        for (int i = 0; i < 8; ++i) { const float br = Bb_re[p * 16 + ch0 + i], bi = Bb_im[p * 16 + ch0 + i]; v[i] = (ri == 0) ? (wr_ * br - wi * bi) : (wr_ * bi + wi * br); }
        u32x4 o; o.x = pk2(v[0], v[1]); o.y = pk2(v[2], v[3]); o.z = pk2(v[4], v[5]); o.w = pk2(v[6], v[7]);
        *(u32x4*)(Bg + (size_t)(dir * 128 + nl) * 256 + kc * 8) = o; }
    __syncthreads();
}

struct SchedWin { int i, G, c; const char* A; const char* B;
    __device__ __forceinline__ bool next(Unit& u) { const int L = i * G + c; ++i; int pn, b;
        if (L < 2048) { int pm; map_tile(L, 128, 16, pm, pn); b = pm >> 4; u.r0 = (b * 17 + 1 + (pm & 15)) * 256; }
        else if (L < 2096) { const int l = L - 2048, s = l % 6; b = l / 6; pn = s < 2 ? s : s + 2; u.r0 = b * 17 * 256; }
        else return false;
        u.c0 = pn * 256; u.aux = b; u.a = A + (size_t)u.r0 * 2048; u.b = B + (size_t)u.c0 * 2048; return true; } };
struct EpiWin { static constexpr bool PERM = true;
    bf16_t *UH, *Q, *K, *V, *G; const float* rope;
    __device__ __forceinline__ static u32x4 pk8(const f32x4& v0, const f32x4& v1) { u32x4 w; w.x = cvt_pk_bf16(v0[0], v0[1]); w.y = cvt_pk_bf16(v0[2], v0[3]); w.z = cvt_pk_bf16(v1[0], v1[1]); w.w = cvt_pk_bf16(v1[2], v1[3]); return w; }
    __device__ __forceinline__ bool operator()(f32x4 (&acc)[2][2][4][2], const Unit& u, int wr, int wc, int fr, int fq) const {
        const int pn = u.c0 >> 8, b = u.aux, tt0 = u.r0 - b * LT;
        if (pn < 2) {
#pragma unroll
            for (int ai = 0; ai < 2; ++ai)
#pragma unroll
                for (int m = 0; m < 4; ++m) { const int tt = tt0 + ai * 128 + wr * 64 + m * 16 + fr;
#pragma unroll
                    for (int bj = 0; bj < 2; ++bj) { const int c = u.c0 + bj * 128 + wc * 32 + 8 * fq, g = c >> 4, half = (c >> 3) & 1;
                        *(u32x4*)(UH + (((size_t)(b * 32 + g) * NCH + (tt >> 4)) * 512 + (tt & 15) * 16 + half * 8)) = pk8(acc[ai][bj][m][0], acc[ai][bj][m][1]); } }
        } else if (pn < 6) { const bool isq = pn < 4; bf16_t* dst0 = (isq ? Q : K); const float sc = isq ? QSCALE : 1.0f;
            if (tt0 >= CL) {
#pragma unroll
                for (int ai = 0; ai < 2; ++ai) { f32x4 cs[4], sn[4]; const bool gi = (wc & 1) != 0;
#pragma unroll
                    for (int m = 0; m < 4; ++m) { const int t = tt0 + ai * 128 + wr * 64 + m * 16 + fr - CL; const float* rp = rope + (gi ? (t & 63) : (t >> 6)) * 32 + 4 * fq;
                        cs[m] = *(const f32x4*)rp; sn[m] = *(const f32x4*)(rp + 16); }
                    __builtin_amdgcn_sched_barrier(0);
#pragma unroll
                    for (int m = 0; m < 4; ++m) { const size_t r = (size_t)u.r0 + ai * 128 + wr * 64 + m * 16 + fr;
#pragma unroll
                        for (int bj = 0; bj < 2; ++bj) { const int c = u.c0 + bj * 128 + wc * 32 + 8 * fq, cq = (c - 512) & 511; const f32x4 v0 = acc[ai][bj][m][0], v1 = acc[ai][bj][m][1];
                            *(u32x4*)(dst0 + r * 512 + cq) = pk8((v0 * cs[m] - v1 * sn[m]) * sc, (v1 * cs[m] + v0 * sn[m]) * sc); } } }
            } else {
#pragma unroll
                for (int ai = 0; ai < 2; ++ai)
#pragma unroll
                    for (int m = 0; m < 4; ++m) { const size_t r = (size_t)u.r0 + ai * 128 + wr * 64 + m * 16 + fr;
#pragma unroll
                        for (int bj = 0; bj < 2; ++bj) { const int c = u.c0 + bj * 128 + wc * 32 + 8 * fq, cq = (c - 512) & 511;
                            *(u32x4*)(dst0 + r * 512 + cq) = pk8(acc[ai][bj][m][0], acc[ai][bj][m][1]); } } }
        } else if (pn < 8) {
#pragma unroll
            for (int ai = 0; ai < 2; ++ai)
#pragma unroll
                for (int m = 0; m < 4; ++m) { const size_t r = (size_t)u.r0 + ai * 128 + wr * 64 + m * 16 + fr;
#pragma unroll
                    for (int bj = 0; bj < 2; ++bj) { const int c = u.c0 + bj * 128 + wc * 32 + 8 * fq; *(u32x4*)(V + r * 512 + (c - 1536)) = pk8(acc[ai][bj][m][0], acc[ai][bj][m][1]); } }
        } else { const int lt = b * 16 + (tt0 >> 8) - 1;
#pragma unroll
            for (int ai = 0; ai < 2; ++ai)
#pragma unroll
                for (int m = 0; m < 4; ++m)
#pragma unroll
                    for (int bj = 0; bj < 2; ++bj) { f32x4 v0 = acc[ai][bj][m][0], v1 = acc[ai][bj][m][1];
#pragma unroll
                        for (int j = 0; j < 4; ++j) { v0[j] = sigmoidf_(v0[j]); v1[j] = sigmoidf_(v1[j]); }
                        *(u32x4*)(G + (((((((size_t)(lt * 8 + (pn - 8)) * 2 + ai) * 4 + m) * 2 + bj) * 8 + (wr * 4 + wc)) * 64 + (fq * 16 + fr)) * 8)) = pk8(v0, v1); } }
        return true; } };

struct SchedS5a { int i, G, c; const char* UH; const char* Bcat;
    __device__ __forceinline__ bool next(Unit& u) { const int L = i * G + c; ++i; if (L >= 512) return false; const int bg = L >> 1, row0 = (L & 1) * 16;
        u.r0 = bg * NCH + row0; u.c0 = 0; u.aux = 0; u.a = UH + (size_t)u.r0 * 1024; u.b = Bcat + (size_t)(bg & 31) * 256 * 256 * 2; return true; } };
struct EpiS5a { static constexpr bool PERM = false; float* S;
    __device__ __forceinline__ bool operator()(f32x4 (&acc)[2][2][4][2], const Unit& u, int wr, int wc, int fr, int fq) const {
#pragma unroll
        for (int ai = 0; ai < 2; ++ai)
#pragma unroll
            for (int m = 0; m < 4; ++m) { float* rowp = S + ((size_t)u.r0 + ai * 128 + wr * 64 + m * 16 + fr) * 256 + wc * 32 + 4 * fq;
#pragma unroll
                for (int bj = 0; bj < 2; ++bj)
#pragma unroll
                    for (int n = 0; n < 2; ++n) *(f32x4*)(rowp + bj * 128 + n * 16) = acc[ai][bj][m][n]; }
        return true; } };

struct SchedS5aB { int i, bg; const char* UH; const char* Bcat;
    __device__ __forceinline__ bool next(Unit& u) { if (i >= 2) return false; const int row0 = i * 16; ++i;
        u.r0 = bg * NCH + row0; u.c0 = 0; u.aux = 0; u.a = UH + (size_t)u.r0 * 1024; u.b = Bcat + (size_t)(bg & 31) * 256 * 256 * 2; return true; } };
struct SchedS5cB { int i, bg; const char* UH; const char* Wcat;
    __device__ __forceinline__ bool next(Unit& u) { if (i >= 1) return false; ++i;
        u.r0 = (bg >> 5) * SEQ; u.c0 = 0; u.aux = bg & 31; u.a = UH + ((size_t)bg * NCH + 16) * 1024; u.b = Wcat + (size_t)(bg & 31) * 256 * 512 * 2; return true; } };
struct SchedS5c { int i, G, c; const char* UH; const char* Wcat;
    __device__ __forceinline__ bool next(Unit& u) { const int L = i * G + c; ++i; if (L >= 256) return false; const int bg = L;
        u.r0 = (bg >> 5) * SEQ; u.c0 = 0; u.aux = bg & 31; u.a = UH + ((size_t)bg * NCH + 16) * 1024; u.b = Wcat + (size_t)(bg & 31) * 256 * 512 * 2; return true; } };
struct EpiS5c { static constexpr bool PERM = true; bf16_t* YA;
    __device__ __forceinline__ bool operator()(f32x4 (&acc)[2][2][4][2], const Unit& u, int wr, int wc, int fr, int fq) const {
#pragma unroll
        for (int ai = 0; ai < 2; ++ai)
#pragma unroll
            for (int m = 0; m < 4; ++m) { const int chunk = ai * 128 + wr * 64 + m * 16 + fr;
#pragma unroll
                for (int bj = 0; bj < 2; ++bj) { const int cl = bj * 128 + wc * 32 + 8 * fq, tok = cl >> 4, half = (cl >> 3) & 1; const f32x4 v0 = acc[ai][bj][m][0], v1 = acc[ai][bj][m][1];
                    u32x4 w; w.x = cvt_pk_bf16(gelu_tanh(v0[0]), gelu_tanh(v0[1])); w.y = cvt_pk_bf16(gelu_tanh(v0[2]), gelu_tanh(v0[3]));
                    w.z = cvt_pk_bf16(gelu_tanh(v1[0]), gelu_tanh(v1[1])); w.w = cvt_pk_bf16(gelu_tanh(v1[2]), gelu_tanh(v1[3]));
                    *(u32x4*)(YA + ((size_t)u.r0 + chunk * 16 + tok) * 512 + u.aux * 16 + half * 8) = w; } }
        return true; } };

struct SchedGlu { int i, G, c; const char* YA; const char* W;
    __device__ __forceinline__ bool next(Unit& u) { const int L = i * G + c; ++i; if (L >= 256) return false; int pm, pn; map_tile(L, 128, 2, pm, pn);
        u.r0 = pm * 256; u.c0 = pn * 256; u.aux = 0; u.a = YA + (size_t)u.r0 * 1024; u.b = W + (size_t)u.c0 * 1024; return true; } };
struct EpiGlu { static constexpr bool PERM = true; const bf16_t* YA; bf16_t* YY;
    __device__ __forceinline__ bool operator()(f32x4 (&acc)[2][2][4][2], const Unit& u, int wr, int wc, int fr, int fq) const {
#pragma unroll
        for (int ai = 0; ai < 2; ++ai)
#pragma unroll
            for (int m = 0; m < 4; ++m) { const size_t r = (size_t)u.r0 + ai * 128 + wr * 64 + m * 16 + fr;
#pragma unroll
                for (int bj = 0; bj < 2; ++bj) { const int c = u.c0 + bj * 128 + wc * 32 + 8 * fq; const f32x4 v0 = acc[ai][bj][m][0], v1 = acc[ai][bj][m][1];
                    const u32x4 a = *(const u32x4*)(YA + r * 512 + c); u32x4 w;
                    w.x = cvt_pk_bf16(bf_lo(a.x) * sigmoidf_(v0[0]), bf_hi(a.x) * sigmoidf_(v0[1])); w.y = cvt_pk_bf16(bf_lo(a.y) * sigmoidf_(v0[2]), bf_hi(a.y) * sigmoidf_(v0[3]));
                    w.z = cvt_pk_bf16(bf_lo(a.z) * sigmoidf_(v1[0]), bf_hi(a.z) * sigmoidf_(v1[1])); w.w = cvt_pk_bf16(bf_lo(a.w) * sigmoidf_(v1[2]), bf_hi(a.w) * sigmoidf_(v1[3]));
                    *(u32x4*)(YY + r * 1024 + c) = w; } }
        return true; } };

struct SchedProj { int i, G, c, part, pm, pn; const char* YY; const char* WA; const char* WB;
    __device__ __forceinline__ bool next(Unit& u) {
        if (part == 0) { const int L = i * G + c; if (L >= 512) return false; map_tile(L, 128, 4, pm, pn); }
        u.r0 = pm * 256; u.c0 = pn * 256; u.aux = part; u.a = YY + (size_t)u.r0 * 2048 + (part ? 1024 : 0); u.b = (part ? WB : WA) + (size_t)u.c0 * 1024;
        if (part) ++i; part ^= 1; return true; } };
struct EpiProj { static constexpr bool PERM = true; const bf16_t* G; bf16_t* M;
    __device__ __forceinline__ bool operator()(f32x4 (&acc)[2][2][4][2], const Unit& u, int wr, int wc, int fr, int fq) const {
        const bf16_t* gt = G + (unsigned)(((u.r0 >> 8) * 8 + (u.c0 >> 8)) * 65536 + (wr * 4 + wc) * 512 + (fq * 16 + fr) * 8);
        if (u.aux == 0) {
#pragma unroll
            for (int ai = 0; ai < 2; ++ai) { u32x4 ga[4][2], gb[4][2];
#pragma unroll
                for (int m = 0; m < 4; ++m)
#pragma unroll
                    for (int bj = 0; bj < 2; ++bj) { const unsigned go = (unsigned)((((ai * 4 + m) * 2 + bj) * 8) * 512); ga[m][bj] = *(const u32x4*)(gt + go); gb[m][bj] = *(const u32x4*)(gt + go + 4 * 65536); }
                __builtin_amdgcn_sched_barrier(0);
#pragma unroll
                for (int m = 0; m < 4; ++m)
#pragma unroll
                    for (int bj = 0; bj < 2; ++bj) { f32x4& v0 = acc[ai][bj][m][0]; f32x4& v1 = acc[ai][bj][m][1]; const u32x4 a = ga[m][bj], b = gb[m][bj];
                        const float sa[8] = {bf_lo(a.x), bf_hi(a.x), bf_lo(a.y), bf_hi(a.y), bf_lo(a.z), bf_hi(a.z), bf_lo(a.w), bf_hi(a.w)};
                        const float sb[8] = {bf_lo(b.x), bf_hi(b.x), bf_lo(b.y), bf_hi(b.y), bf_lo(b.z), bf_hi(b.z), bf_lo(b.w), bf_hi(b.w)};
#pragma unroll
                        for (int j = 0; j < 4; ++j) { v0[j] *= sa[j] * __builtin_amdgcn_rcpf(fmaxf(sb[j], 1e-20f)); v1[j] *= sa[4 + j] * __builtin_amdgcn_rcpf(fmaxf(sb[4 + j], 1e-20f)); } }
                asm volatile("" ::: "memory"); }
            return false; }
#pragma unroll
        for (int ai = 0; ai < 2; ++ai) { u32x4 gb[4][2];
#pragma unroll
            for (int m = 0; m < 4; ++m)
#pragma unroll
                for (int bj = 0; bj < 2; ++bj) gb[m][bj] = *(const u32x4*)(gt + (unsigned)((((ai * 4 + m) * 2 + bj) * 8) * 512) + 4 * 65536);
            __builtin_amdgcn_sched_barrier(0);
#pragma unroll
            for (int m = 0; m < 4; ++m) { const size_t r = (size_t)u.r0 + ai * 128 + wr * 64 + m * 16 + fr;
#pragma unroll
                for (int bj = 0; bj < 2; ++bj) { const int c = u.c0 + bj * 128 + wc * 32 + 8 * fq; const f32x4 v0 = acc[ai][bj][m][0], v1 = acc[ai][bj][m][1]; const u32x4 b = gb[m][bj];
                    const float sb[8] = {fmaxf(bf_lo(b.x), 1e-20f), fmaxf(bf_hi(b.x), 1e-20f), fmaxf(bf_lo(b.y), 1e-20f), fmaxf(bf_hi(b.y), 1e-20f), fmaxf(bf_lo(b.z), 1e-20f), fmaxf(bf_hi(b.z), 1e-20f), fmaxf(bf_lo(b.w), 1e-20f), fmaxf(bf_hi(b.w), 1e-20f)};
                    u32x4 w; w.x = cvt_pk_bf16(v0[0] * sb[0], v0[1] * sb[1]); w.y = cvt_pk_bf16(v0[2] * sb[2], v0[3] * sb[3]);
                    w.z = cvt_pk_bf16(v1[0] * sb[4], v1[1] * sb[5]); w.w = cvt_pk_bf16(v1[2] * sb[6], v1[3] * sb[7]);
                    *(u32x4*)(M + r * 1024 + c) = w; } }
            asm volatile("" ::: "memory"); }
        return true; } };

struct SchedOut { int i, G, c; const char* M; const char* W;
    __device__ __forceinline__ bool next(Unit& u) { const int L = i * G + c; ++i; if (L >= 512) return false; int pm, pn; map_tile(L, 128, 4, pm, pn);
        u.r0 = pm * 256; u.c0 = pn * 256; u.aux = 0; u.a = M + (size_t)u.r0 * 2048; u.b = W + (size_t)u.c0 * 2048; return true; } };
struct EpiOut { static constexpr bool PERM = true; bf16_t* O;
    __device__ __forceinline__ bool operator()(f32x4 (&acc)[2][2][4][2], const Unit& u, int wr, int wc, int fr, int fq) const {
#pragma unroll
        for (int ai = 0; ai < 2; ++ai)
#pragma unroll
            for (int m = 0; m < 4; ++m) { const size_t r = (size_t)u.r0 + ai * 128 + wr * 64 + m * 16 + fr;
#pragma unroll
                for (int bj = 0; bj < 2; ++bj) { const int c = u.c0 + bj * 128 + wc * 32 + 8 * fq; const f32x4 v0 = acc[ai][bj][m][0], v1 = acc[ai][bj][m][1];
                    u32x4 w; w.x = cvt_pk_bf16(v0[0], v0[1]); w.y = cvt_pk_bf16(v0[2], v0[3]); w.z = cvt_pk_bf16(v1[0], v1[1]); w.w = cvt_pk_bf16(v1[2], v1[3]);
                    *(u32x4*)(O + r * 1024 + c) = w; } }
        return true; } };

constexpr float WSCALE = 32.0f, HSCALE = 4.0f;
struct SchedUp { int i, G, c; const char* XS; const char* W;
    __device__ __forceinline__ bool next(Unit& u) { const int L = i * G + c; ++i; if (L >= 4096) return false; const int e = L >> 8; int pm, pn; map_tile(L & 255, 16, 16, pm, pn);
        u.r0 = e * 4096 + pm * 256; u.c0 = pn * 128; u.aux = e; u.a = XS + (size_t)u.r0 * 1024; u.b = W + ((size_t)e * 4096 + pn * 256) * 1024; return true; } };
struct EpiUp { static constexpr bool PERM = true; unsigned char* HID;
    __device__ __forceinline__ bool operator()(f32x4 (&acc)[2][2][4][2], const Unit& u, int wr, int wc, int fr, int fq) const {
        const float s = 1.0f / WSCALE;
#pragma unroll
        for (int ai = 0; ai < 2; ++ai)
#pragma unroll
            for (int m = 0; m < 4; ++m) { const size_t r = (size_t)u.r0 + ai * 128 + wr * 64 + m * 16 + fr;
#pragma unroll
                for (int bj = 0; bj < 2; ++bj) { const int c = u.c0 + bj * 64 + wc * 16 + 4 * fq; const f32x4 g = acc[ai][bj][m][0] * s, up = acc[ai][bj][m][1] * (s * HSCALE);
                    *(unsigned*)(HID + r * 2048 + c) = pk_fp8x4(g[0] * sigmoidf_(g[0]) * up[0], g[1] * sigmoidf_(g[1]) * up[1], g[2] * sigmoidf_(g[2]) * up[2], g[3] * sigmoidf_(g[3]) * up[3]); } }
        return true; } };

struct SchedDown { int i, G, c; const char* HID; const char* W;
    __device__ __forceinline__ bool next(Unit& u) { const int L = i * G + c; ++i; if (L >= 1024) return false; const int e = L >> 6; int pm, pn; map_tile(L & 63, 16, 4, pm, pn);
        u.r0 = e * 4096 + pm * 256; u.c0 = pn * 256; u.aux = e; u.a = HID + (size_t)u.r0 * 2048; u.b = W + ((size_t)e * 1024 + pn * 256) * 2048; return true; } };
constexpr float YSCALE = 64.0f;
struct EpiDown { static constexpr bool PERM = true; const float* GATEV; unsigned char* YS;
    __device__ __forceinline__ bool operator()(f32x4 (&acc)[2][2][4][2], const Unit& u, int wr, int wc, int fr, int fq) const {
#pragma unroll
        for (int ai = 0; ai < 2; ++ai)
#pragma unroll
            for (int m = 0; m < 4; ++m) { const size_t r = (size_t)u.r0 + ai * 128 + wr * 64 + m * 16 + fr; const float gt = GATEV[r] * (YSCALE / (WSCALE * HSCALE));
#pragma unroll
                for (int bj = 0; bj < 2; ++bj) { const int c = u.c0 + bj * 128 + wc * 32 + 8 * fq; const f32x4 v0 = acc[ai][bj][m][0] * gt, v1 = acc[ai][bj][m][1] * gt;
                    u32x2 w; w.x = pk_fp8x4(v0[0], v0[1], v0[2], v0[3]); w.y = pk_fp8x4(v1[0], v1[1], v1[2], v1[3]);
                    *(u32x2*)(YS + r * 1024 + c) = w; } }
        return true; } };

__device__ __forceinline__ void ld_row(const float* p, int lane, f32x4 (&v)[4]) {
#pragma unroll
    for (int j = 0; j < 4; ++j) v[j] = *(const f32x4*)(p + lane * 4 + 256 * j);
}
__device__ __forceinline__ float sumsq(const f32x4 (&v)[4]) { float s = 0.f;
#pragma unroll
    for (int j = 0; j < 4; ++j) s += (v[j][0] * v[j][0] + v[j][1] * v[j][1]) + (v[j][2] * v[j][2] + v[j][3] * v[j][3]);
    return wave_sum(s); }

template <int NR> __device__ __forceinline__ void rp1_rows(const Args& A, const float* MOD, bf16_t* HN, int r0, int lane, const f32x4 (&w)[4]) {
    f32x4 v[NR][4], sh[NR][4], sc[NR][4];
#pragma unroll
    for (int q = 0; q < NR; ++q) { const int r = r0 + q, b = r / LT, tt = r - b * LT;
        const float* src = tt < CL ? A.in[I_CTX] + ((size_t)b * CL + tt) * DM : A.in[I_X] + ((size_t)b * SEQ + (tt - CL)) * DM;
        const float* mrow = MOD + (tt < CL ? 8 : b) * 6144;
        ld_row(src, lane, v[q]); ld_row(mrow, lane, sh[q]); ld_row(mrow + 1024, lane, sc[q]); }
#pragma unroll
    for (int q = 0; q < NR; ++q) { const float rstd = rsqrtf(sumsq(v[q]) * (1.0f / DM) + EPS);
#pragma unroll
        for (int j = 0; j < 4; ++j) { const f32x4 h = v[q][j] * rstd * w[j] * (sc[q][j] + 1.0f) + sh[q][j];
            u32x2 o; o.x = cvt_pk_bf16(h[0], h[1]); o.y = cvt_pk_bf16(h[2], h[3]); *(u32x2*)(HN + (size_t)(r0 + q) * DM + lane * 4 + 256 * j) = o; } }
}
template <int NR> __device__ __forceinline__ void rp1_lat(const float* X, bf16_t* HN, size_t xrow0, size_t hrow0, int lane, const f32x4 (&c)[4], const f32x4 (&sh)[4]) {
    f32x4 v[NR][4];
#pragma unroll
    for (int q = 0; q < NR; ++q) ld_row(X + (xrow0 + q) * DM, lane, v[q]);
#pragma unroll
    for (int q = 0; q < NR; ++q) { const float rstd = rsqrtf(sumsq(v[q]) * (1.0f / DM) + EPS);
#pragma unroll
        for (int j = 0; j < 4; ++j) { const f32x4 h = v[q][j] * rstd * c[j] + sh[j];
            u32x2 o; o.x = cvt_pk_bf16(h[0], h[1]); o.y = cvt_pk_bf16(h[2], h[3]); *(u32x2*)(HN + (hrow0 + q) * DM + lane * 4 + 256 * j) = o; } }
}
template <int NR> __device__ __forceinline__ void rp1_load(const float* X, size_t xrow0, int lane, f32x4 (&v)[4][4]) {
#pragma unroll
    for (int q = 0; q < NR; ++q) ld_row(X + (xrow0 + q) * DM, lane, v[q]);
}
template <int NR> __device__ __forceinline__ void rp1_proc(f32x4 (&v)[4][4], bf16_t* HN, size_t hrow0, int lane, const f32x4 (&c)[4], const f32x4 (&sh)[4]) {
#pragma unroll
    for (int q = 0; q < NR; ++q) { const float rstd = rsqrtf(sumsq(v[q]) * (1.0f / DM) + EPS);
#pragma unroll
        for (int j = 0; j < 4; ++j) { const f32x4 h = v[q][j] * rstd * c[j] + sh[j];
            u32x2 o; o.x = cvt_pk_bf16(h[0], h[1]); o.y = cvt_pk_bf16(h[2], h[3]); *(u32x2*)(HN + (hrow0 + q) * DM + lane * 4 + 256 * j) = o; } }
}
__device__ __forceinline__ void row_pass1(const Args& A, const float* MOD, bf16_t* HN, int gw, int ngw, int lane) {
    f32x4 w[4]; ld_row(A.in[I_NPREMIX], lane, w);
    const int per = (MR + ngw - 1) / ngw, r0 = gw * per, r1 = min(MR, r0 + per);
    const int b0 = r0 / LT, tt0 = r0 - b0 * LT, b1 = (r1 - 1) / LT;
    if (r0 < r1 && tt0 >= CL && b0 == b1) {
        f32x4 c[4], sh[4]; { f32x4 sc[4]; ld_row(MOD + b0 * 6144, lane, sh); ld_row(MOD + b0 * 6144 + 1024, lane, sc);
#pragma unroll
            for (int j = 0; j < 4; ++j) c[j] = w[j] * (sc[j] + 1.0f); }
        int r = r0;
        if (r1 - r0 == 17) {
            const float* X = A.in[I_X]; const size_t x0 = (size_t)b0 * SEQ + (r0 - b0 * LT - CL); f32x4 va[4][4], vb[4][4];
            rp1_load<4>(X, x0, lane, va); rp1_load<4>(X, x0 + 4, lane, vb);
            rp1_proc<4>(va, HN, (size_t)r0, lane, c, sh); rp1_load<4>(X, x0 + 8, lane, va);
            rp1_proc<4>(vb, HN, (size_t)r0 + 4, lane, c, sh); rp1_load<4>(X, x0 + 12, lane, vb);
            rp1_proc<4>(va, HN, (size_t)r0 + 8, lane, c, sh); rp1_load<1>(X, x0 + 16, lane, va);
            rp1_proc<4>(vb, HN, (size_t)r0 + 12, lane, c, sh);
            rp1_proc<1>(va, HN, (size_t)r0 + 16, lane, c, sh);
            r = r1; }
        for (; r + 4 <= r1; r += 4) rp1_lat<4>(A.in[I_X], HN, (size_t)b0 * SEQ + (r - b0 * LT - CL), (size_t)r, lane, c, sh);
        for (; r < r1; ++r) rp1_lat<1>(A.in[I_X], HN, (size_t)b0 * SEQ + (r - b0 * LT - CL), (size_t)r, lane, c, sh);
    } else {
        int r = r0;
        for (; r + 2 <= r1; r += 2) rp1_rows<2>(A, MOD, HN, r, lane, w);
        if (r < r1) rp1_rows<1>(A, MOD, HN, r, lane, w);
    }
}

__device__ __forceinline__ float reduce16(const float (&v)[16], int lane) {
    float a[8], b4[4], c[2];
    const bool h3 = (lane & 8) != 0, h2 = (lane & 4) != 0;
#pragma unroll
    for (int i = 0; i < 8; ++i) a[i] = swap32_sum(v[i], v[8 + i]);
#pragma unroll
    for (int i = 0; i < 4; ++i) b4[i] = swap16_sum(a[i], a[4 + i]);
#pragma unroll
    for (int i = 0; i < 2; ++i) { const float keep = h3 ? b4[2 + i] : b4[i], send = h3 ? b4[i] : b4[2 + i]; c[i] = keep + dpp_f<DPP_ROR8>(send); }
    const float keep = h2 ? c[1] : c[0], send = h2 ? c[0] : c[1]; float d = keep + dpp_f<DPP_HMIRROR>(send);
    d += dpp_f<DPP_XOR2>(d); d += dpp_f<DPP_XOR1>(d); return d;
}

__device__ __forceinline__ void ld_row_bf(const bf16_t* p, int lane, f32x4 (&v)[4]) {
#pragma unroll
    for (int j = 0; j < 4; ++j) { const u32x2 w = *(const u32x2*)(p + lane * 4 + 256 * j); v[j] = (f32x4){bf_lo(w.x), bf_hi(w.x), bf_lo(w.y), bf_hi(w.y)}; }
}
__device__ __forceinline__ void row_pass2(const Args& A, const float* MOD, const bf16_t* OB, bf16_t* X1, unsigned char* H2, float* AFF, LAS float* WR, int gw, int ngw, int lane) {
    const int per = (ML + ngw - 1) / ngw;
    const int b = (gw * per) >> 12; const float* mrow = MOD + b * 6144;
    const int rbeg = gw * per, rend = min(ML, (gw + 1) * per);
    f32x4 o[4], x[4];
    if (rbeg < rend) { ld_row_bf(OB + (size_t)rbeg * DM, lane, o); ld_row(A.in[I_X] + (size_t)rbeg * DM, lane, x); }
#pragma unroll 1
    for (int r = rbeg; r < rend; ++r) { const int t = r & 4095;
        f32x4 on[4], xn[4];
        { const int rn = (r + 1 < rend) ? r + 1 : r; ld_row_bf(OB + (size_t)rn * DM, lane, on); ld_row(A.in[I_X] + (size_t)rn * DM, lane, xn); }
        const float rs0 = rsqrtf(sumsq(o) * (1.0f / DM) + EPS);
#pragma unroll
        for (int j = 0; j < 4; ++j) { const f32x4 wpost = *(const f32x4*)(A.in[I_NPOSTMIX] + lane * 4 + 256 * j), gm = *(const f32x4*)(mrow + 2048 + lane * 4 + 256 * j);
            x[j] = x[j] + gm * wpost * (o[j] * rs0); u32x2 xb; xb.x = cvt_pk_bf16(x[j][0], x[j][1]); xb.y = cvt_pk_bf16(x[j][2], x[j][3]); *(u32x2*)(X1 + (size_t)r * DM + lane * 4 + 256 * j) = xb; }
        const float rs1 = rsqrtf(sumsq(x) * (1.0f / DM) + EPS);
        int woff = lane * 4; asm volatile("" : "+v"(woff) : "v"(rs1));
        f32x2 lg2[16];
#pragma unroll
        for (int e = 0; e < 16; ++e) lg2[e] = (f32x2){0.f, 0.f};
#pragma unroll
        for (int j = 0; j < 4; ++j) {
            const f32x4 wpre = *(const f32x4*)(A.in[I_NPREFFN] + lane * 4 + 256 * j), sc = *(const f32x4*)(mrow + 4096 + lane * 4 + 256 * j), sh = *(const f32x4*)(mrow + 3072 + lane * 4 + 256 * j);
            const f32x4 h = x[j] * rs1 * wpre * (sc + 1.0f) + sh;
            *(unsigned*)(H2 + (size_t)r * DM + lane * 4 + 256 * j) = pk_fp8x4(h[0], h[1], h[2], h[3]);
#pragma unroll
            for (int e = 0; e < 16; ++e) { const f32x4 ww = *(const LAS f32x4*)(WR + e * 1024 + woff + 256 * j);
                lg2[e] = __builtin_elementwise_fma((f32x2){h[0], h[1]}, (f32x2){ww[0], ww[1]}, lg2[e]); lg2[e] = __builtin_elementwise_fma((f32x2){h[2], h[3]}, (f32x2){ww[2], ww[3]}, lg2[e]); }
            asm volatile("" : "+v"(woff), "+v"(lg2[15]));
        }
        float lg[16];
#pragma unroll
        for (int e = 0; e < 16; ++e) lg[e] = lg2[e][0] + lg2[e][1];
        const float lgt = reduce16(lg, lane);
        float mx = lgt; mx = fmaxf(mx, dpp_f<DPP_HMIRROR>(mx)); mx = fmaxf(mx, dpp_f<DPP_MIRROR>(mx));
        { auto r = __builtin_amdgcn_permlane16_swap(__float_as_uint(mx), __float_as_uint(mx), false, false); mx = fmaxf(__uint_as_float(r[0]), __uint_as_float(r[1])); }
        { auto r = __builtin_amdgcn_permlane32_swap(__float_as_uint(mx), __float_as_uint(mx), false, false); mx = fmaxf(__uint_as_float(r[0]), __uint_as_float(r[1])); }
        const float ex = expf(lgt - mx); float se = ex; se += dpp_f<DPP_HMIRROR>(se); se += dpp_f<DPP_MIRROR>(se); se = swap16_sum(se, se); se = swap32_sum(se, se);
        const int e = ((lane >> 5) & 1) * 8 + ((lane >> 4) & 1) * 4 + ((lane >> 3) & 1) * 2 + ((lane >> 2) & 1);
        if ((lane & 3) == 0) AFF[((size_t)b * NE + e) * SEQ + t] = ex / se;
#pragma unroll
        for (int j = 0; j < 4; ++j) { o[j] = on[j]; x[j] = xn[j]; }
    }
}

__device__ __forceinline__ void fp8x4_add(unsigned w, float s, float* f) {
    typedef float f32x2_ __attribute__((ext_vector_type(2)));
    const f32x2_ lo = __builtin_amdgcn_cvt_pk_f32_fp8((int)w, false), hi = __builtin_amdgcn_cvt_pk_f32_fp8((int)w, true);
    f[0] += s * lo[0]; f[1] += s * lo[1]; f[2] += s * hi[0]; f[3] += s * hi[1]; }
__device__ __forceinline__ void row_final(const Args& A, const float* MOD, const bf16_t* X1, float* OUT, const unsigned char* YS, const int* SLOT, int gw, int ngw, int lane) {
    const int per = (ML + ngw - 1) / ngw;
    for (int r = gw * per; r < min(ML, (gw + 1) * per); ++r) { const int b = r >> 12; const float* mrow = MOD + b * 6144;
        const int myslot = lane < 16 ? SLOT[(size_t)r * 16 + lane] : -1;
        f32x4 x1[4], gf[4], w[4];
#pragma unroll
        for (int j = 0; j < 2; ++j)
#pragma unroll
            for (int q = 0; q < 2; ++q) { const int k = lane * 8 + 512 * j + 4 * q; { const u32x2 w_ = *(const u32x2*)(X1 + (size_t)r * DM + k); x1[2 * j + q] = (f32x4){bf_lo(w_.x), bf_hi(w_.x), bf_lo(w_.y), bf_hi(w_.y)}; } gf[2 * j + q] = *(const f32x4*)(mrow + 5120 + k); w[2 * j + q] = *(const f32x4*)(A.in[I_NPOSTFFN] + k); }
        float f[16];
#pragma unroll
        for (int i = 0; i < 16; ++i) f[i] = 0.f;
        unsigned long long msk = __ballot(myslot >= 0);
        while (msk) { const int e0 = __builtin_ctzll(msk); msk &= msk - 1; const bool two = msk != 0; const int e1 = two ? __builtin_ctzll(msk) : e0; if (two) msk &= msk - 1;
            const int s0 = __builtin_amdgcn_readlane(myslot, e0), s1 = __builtin_amdgcn_readlane(myslot, e1);
            const unsigned char* y0 = YS + ((size_t)e0 * 4096 + b * CAP + s0) * DM; const unsigned char* y1 = YS + ((size_t)e1 * 4096 + b * CAP + s1) * DM;
            u32x2 ya[2], yb[2];
#pragma unroll
            for (int j = 0; j < 2; ++j) { ya[j] = *(const u32x2*)(y0 + lane * 8 + 512 * j); yb[j] = *(const u32x2*)(y1 + lane * 8 + 512 * j); }
            const float m1 = two ? 1.0f : 0.0f;
#pragma unroll
            for (int j = 0; j < 2; ++j) { fp8x4_add(ya[j].x, 1.0f, f + 8 * j); fp8x4_add(ya[j].y, 1.0f, f + 8 * j + 4); fp8x4_add(yb[j].x, m1, f + 8 * j); fp8x4_add(yb[j].y, m1, f + 8 * j + 4); } }
#pragma unroll
        for (int i = 0; i < 16; ++i) f[i] *= (1.0f / YSCALE);
        float ss = 0.f;
#pragma unroll
        for (int i = 0; i < 16; ++i) ss += f[i] * f[i];
        const float rstd = rsqrtf(wave_sum(ss) * (1.0f / DM) + EPS);
#pragma unroll
        for (int j = 0; j < 2; ++j)
#pragma unroll
            for (int q = 0; q < 2; ++q) { const int k = lane * 8 + 512 * j + 4 * q;
                f32x4 fv = {f[8 * j + 4 * q], f[8 * j + 4 * q + 1], f[8 * j + 4 * q + 2], f[8 * j + 4 * q + 3]};
                *(f32x4*)(OUT + (size_t)r * DM + k) = x1[2 * j + q] + gf[2 * j + q] * (fv * rstd * w[2 * j + q]); } }
}

__device__ __forceinline__ void yb_combine(const bf16_t* OC, const float* subln, float lam, bf16_t* YY, int gw, int ngw, int lane) {
    float sw[8];
#pragma unroll
    for (int i = 0; i < 8; ++i) sw[i] = subln[(lane & 15) * 8 + i] * 0.8f;
    for (int r = gw; r < ML; r += ngw) {
        const u32x4 a = *(const u32x4*)(OC + (size_t)r * 512 + lane * 8), c = *(const u32x4*)(OC + ((size_t)ML + r) * 512 + lane * 8);
        float d[8] = {bf_lo(a.x) - lam * bf_lo(c.x), bf_hi(a.x) - lam * bf_hi(c.x), bf_lo(a.y) - lam * bf_lo(c.y), bf_hi(a.y) - lam * bf_hi(c.y),
                      bf_lo(a.z) - lam * bf_lo(c.z), bf_hi(a.z) - lam * bf_hi(c.z), bf_lo(a.w) - lam * bf_lo(c.w), bf_hi(a.w) - lam * bf_hi(c.w)};
        float ss = 0.f;
#pragma unroll
        for (int i = 0; i < 8; ++i) ss += d[i] * d[i];
        ss += dpp_f<DPP_XOR1>(ss); ss += dpp_f<DPP_XOR2>(ss); ss += dpp_f<DPP_HMIRROR>(ss); ss += dpp_f<DPP_MIRROR>(ss);
        const float rstd = rsqrtf(ss * (1.0f / 128.0f) + EPS);
        u32x4 w; w.x = cvt_pk_bf16(d[0] * rstd * sw[0], d[1] * rstd * sw[1]); w.y = cvt_pk_bf16(d[2] * rstd * sw[2], d[3] * rstd * sw[3]);
        w.z = cvt_pk_bf16(d[4] * rstd * sw[4], d[5] * rstd * sw[5]); w.w = cvt_pk_bf16(d[6] * rstd * sw[6], d[7] * rstd * sw[7]);
        *(u32x4*)(YY + (size_t)r * 1024 + 512 + lane * 8) = w; }
}

__device__ __forceinline__ void s5_scan(const Args& A, const float* S, bf16_t* UH, int bg, LAS float* L) {
    const int tid = threadIdx.x, sgm = tid >> 7, dir = (tid >> 6) & 1, p = tid & 63, g = bg & 31, gi = dir * 32 + g;
    const float lr = fminf(A.in[I_LAMRE][gi * 64 + p], -1e-4f), li = A.in[I_LAMIM][gi * 64 + p], dt = expf(A.in[I_LOGDT][gi]);
    float sn, cs; sincos_fast(16.0f * li * dt, &sn, &cs); const float mag = expf(16.0f * lr * dt), ar = mag * cs, aim = mag * sn;
    sincos_fast(68.0f * 16.0f * li * dt, &sn, &cs); const float mag68 = expf(68.0f * 16.0f * lr * dt), br = mag68 * cs, bim = mag68 * sn;
    const float* Sb = S + (size_t)bg * NCH * 256 + dir * 128 + p; bf16_t* Hb = UH + (size_t)bg * NCH * 512 + 256 + dir * 128 + p;
    float hr = 0.f, hi = 0.f;
#define S5_SEG(I0, STORE) do { float sr[17], si[17];                                                                                   \
    _Pragma("unroll") for (int k = 0; k < 17; ++k) { const int i = (I0) + k, ch = dir == 0 ? i : (i < 16 ? 15 - i : 287 - i); sr[k] = Sb[(size_t)ch * 256]; si[k] = Sb[(size_t)ch * 256 + 64]; } \
    _Pragma("unroll") for (int k = 0; k < 17; ++k) { const int i = (I0) + k, ch = dir == 0 ? i : (i < 16 ? 15 - i : 287 - i);          \
        if (STORE) { Hb[(size_t)ch * 512] = (bf16_t)(cvt_pk_bf16(hr, 0.f) & 0xffffu); Hb[(size_t)ch * 512 + 64] = (bf16_t)(cvt_pk_bf16(hi, 0.f) & 0xffffu); } \
        const float nr = ar * hr - aim * hi + sr[k], ni = ar * hi + aim * hr + si[k]; hr = nr; hi = ni; }                               \
    asm volatile("" ::: "memory"); } while (0)
    for (int q = 0; q < 4; ++q) S5_SEG(sgm * 68 + q * 17, false);
    L[tid * 2] = hr; L[tid * 2 + 1] = hi;
    __syncthreads();
    hr = 0.f; hi = 0.f;
    for (int k2 = 0; k2 < sgm; ++k2) { const float e0 = L[(k2 * 128 + (tid & 127)) * 2], e1 = L[(k2 * 128 + (tid & 127)) * 2 + 1]; const float nr = br * hr - bim * hi + e0, ni = br * hi + bim * hr + e1; hr = nr; hi = ni; }
    for (int q = 0; q < 4; ++q) S5_SEG(sgm * 68 + q * 17, true);
#undef S5_SEG
}

__device__ __forceinline__ void topk_task(int be, const float* AFF, const unsigned char* H2, int* IDX, float* GATEV, int* SLOT, unsigned char* XS, LAS unsigned* L) {
    const int tid = threadIdx.x, lane = tid & 63, wid = tid >> 6, b = be >> 4, e = be & 15;
    LAS unsigned* hist = L; LAS unsigned* wsum = L + 256; LAS unsigned* bc = L + 272; LAS int* sidx = (LAS int*)(L + 288);
    const float* ap = AFF + (size_t)be * SEQ + tid * 8;
    const f32x4 a0 = *(const f32x4*)ap, a1 = *(const f32x4*)(ap + 4);
    unsigned key[8] = {__float_as_uint(a0[0]), __float_as_uint(a0[1]), __float_as_uint(a0[2]), __float_as_uint(a0[3]), __float_as_uint(a1[0]), __float_as_uint(a1[1]), __float_as_uint(a1[2]), __float_as_uint(a1[3])};
    unsigned prefix = 0, pmask = 0; int need = CAP;
    for (int pass = 0; pass < 4; ++pass) { const int shift = 24 - 8 * pass;
        if (tid < 256) hist[tid] = 0; __syncthreads();
#pragma unroll
        for (int i = 0; i < 8; ++i) if ((key[i] & pmask) == prefix) __hip_atomic_fetch_add(&hist[(key[i] >> shift) & 255u], 1u, __ATOMIC_RELAXED, __HIP_MEMORY_SCOPE_WORKGROUP);
        __syncthreads();
        if (tid < 64) { unsigned c0 = hist[255 - 4 * tid], c1 = hist[254 - 4 * tid], c2 = hist[253 - 4 * tid], c3 = hist[252 - 4 * tid]; unsigned tot = c0 + c1 + c2 + c3, inc = tot;
#pragma unroll
            for (int o = 1; o < 64; o <<= 1) { const unsigned v = __shfl_up(inc, o); if (tid >= o) inc += v; }
            const unsigned exc = inc - tot;
            if (exc < (unsigned)need && inc >= (unsigned)need) { unsigned run = exc; int bin = 255 - 4 * tid; unsigned cs[4] = {c0, c1, c2, c3};
#pragma unroll
                for (int k = 0; k < 4; ++k) { if (run < (unsigned)need && run + cs[k] >= (unsigned)need) { bc[0] = (unsigned)(bin - k); bc[1] = run; } run += cs[k]; } } }
        __syncthreads();
        const unsigned bin = bc[0], above = bc[1];
        prefix |= bin << shift; pmask |= 255u << shift; need -= (int)above;
        __syncthreads(); }
    unsigned cnt = 0;
#pragma unroll
    for (int i = 0; i < 8; ++i) cnt += (key[i] > prefix ? 1u : 0u) + (key[i] == prefix ? 0x10000u : 0u);
    unsigned inc = cnt;
#pragma unroll
    for (int o = 1; o < 64; o <<= 1) { const unsigned v = __shfl_up(inc, o); if (lane >= o) inc += v; }
    if (lane == 63) wsum[wid] = inc; __syncthreads();
    unsigned base = 0;
    for (int w = 0; w < wid; ++w) base += wsum[w];
    unsigned tot = 0;
    for (int w = 0; w < 8; ++w) tot += wsum[w];
    const int ngt = (int)(tot & 0xffffu);
    unsigned run = base + inc - cnt; int rgt = (int)(run & 0xffffu), req = (int)(run >> 16);
#pragma unroll
    for (int i = 0; i < 8; ++i) { const int t = tid * 8 + i; int slot = -1;
        if (key[i] > prefix) { slot = rgt; ++rgt; } else if (key[i] == prefix) { if (req < need) slot = ngt + req; ++req; }
        SLOT[((size_t)b * SEQ + t) * NE + e] = slot;
        if (slot >= 0) { sidx[slot] = t; IDX[be * CAP + slot] = t; GATEV[(size_t)e * 4096 + b * CAP + slot] = __uint_as_float(key[i]); } }
    __syncthreads();
    for (int s0 = wid * 64; s0 < wid * 64 + 64; s0 += 8) { u32x4 v[8];
#pragma unroll
        for (int k = 0; k < 8; ++k) v[k] = *(const u32x4*)(H2 + ((size_t)b * SEQ + sidx[s0 + k]) * DM + lane * 16);
#pragma unroll
        for (int k = 0; k < 8; ++k) *(u32x4*)(XS + ((size_t)e * 4096 + b * CAP + s0 + k) * DM + lane * 16) = v[k]; }
    __syncthreads();
}

constexpr int N_PHASES = 14;
__global__ void __launch_bounds__(512) fwd_kernel(Args args) {
    extern __shared__ __attribute__((aligned(16))) unsigned char lds_raw[];
    LAS unsigned char* lds = (LAS unsigned char*)lds_raw;
    cg::grid_group grid = cg::this_grid();
    const int tid = threadIdx.x, lane = tid & 63, wid = __builtin_amdgcn_readfirstlane(tid >> 6);
    const int G = gridDim.x, blk = blockIdx.x, gw = blk * 8 + wid, ngw = G * 8;
    unsigned char* ws = args.ws;
    float* MOD = (float*)(ws + WS_MOD); float* MISC = (float*)(ws + WS_MISC); float* ROPE = MISC + 256;
    bf16_t* BCAT = (bf16_t*)(ws + WS_BCAT); bf16_t* WCAT = (bf16_t*)(ws + WS_WCAT);
    bf16_t* WINT = (bf16_t*)(ws + WS_WIN); bf16_t* WGLUT = (bf16_t*)(ws + WS_WGLU); bf16_t* WAT = (bf16_t*)(ws + WS_WA); bf16_t* WBT = (bf16_t*)(ws + WS_WB); bf16_t* WOUTT = (bf16_t*)(ws + WS_WOUT);
    float* AFF = (float*)(ws + WS_AFF); int* IDX = (int*)(ws + WS_IDX); float* GATEV = (float*)(ws + WS_GATEV); int* SLOT = (int*)(ws + WS_SLOT);
    bf16_t* HN = (bf16_t*)(ws + WS_HN); bf16_t* UH = (bf16_t*)(ws + WS_UH); bf16_t* QB = (bf16_t*)(ws + WS_Q); bf16_t* KB = (bf16_t*)(ws + WS_K); bf16_t* VB = (bf16_t*)(ws + WS_V);
    bf16_t* GATES = (bf16_t*)(ws + WS_GATES); float* SB = (float*)(ws + WS_S); bf16_t* OC = (bf16_t*)(ws + WS_OC); bf16_t* YA = (bf16_t*)(ws + WS_YA); bf16_t* YY = (bf16_t*)(ws + WS_YY);
    bf16_t* MB = (bf16_t*)(ws + WS_M); unsigned char* H2 = ws + WS_H2; unsigned char* XS = ws + WS_XS; unsigned char* WGU = ws + WS_WGU; unsigned char* HID = ws + WS_HID;
    bf16_t* OB = (bf16_t*)(ws + WS_OB); bf16_t* X1 = (bf16_t*)(ws + WS_X1);
    unsigned char* WD = ws + WS_WD; unsigned char* YS = ws + WS_YS;
    const int lo = args.ph_lo, hi = args.ph_hi;
#ifdef ONLY_PHASE
#define IN(k) ((k) == ONLY_PHASE && lo <= (k) && (k) < hi)
#else
#define IN(k) (lo <= (k) && (k) < hi)
#endif
#define SEAM(k) do { if ((k) != 3 && (k) != 5 && IN(k) && IN((k) + 1)) xcd_barrier(xb); } while (0)
#define PH_BEGIN(k) if ((k) == TIME_PHASE) { t0_ = __builtin_amdgcn_s_memrealtime(); c0_ = __builtin_amdgcn_s_memtime(); } if (IN(k)) { for (int rep_ = 0; rep_ <= ((REPEAT_MASK >> (k)) & 1); ++rep_) { if (rep_) xcd_barrier(xb);
#define PH_END(k) } } if ((k) == TIME_PHASE && !TIME_WITH_SEAM) { t1_ = __builtin_amdgcn_s_memrealtime(); c1_ = __builtin_amdgcn_s_memtime(); } SEAM(k); if ((k) == TIME_PHASE && TIME_WITH_SEAM) { t1_ = __builtin_amdgcn_s_memrealtime(); c1_ = __builtin_amdgcn_s_memtime(); }
    LAS float* Lf = (LAS float*)lds;
    unsigned long long t0_ = 0, t1_ = 0, c0_ = 0, c1_ = 0, eacc_ = 0;
    volatile LAS unsigned* xst = (volatile LAS unsigned*)(lds + 131072 + 256);
    if (tid < 2) xst[tid] = 0u;
    __syncthreads();
    XcdBarrier xb = xcd_barrier_post((unsigned*)(ws + WS_BAR), xst);
    if (args.ph_lo < 0) grid.sync();
    LAS float* scr = Lf + wid * 4160;

    PH_BEGIN(0) {
        for (int task = blk; task < 257; task += G) {
#ifndef P0_NO_S5
            if (task < 64) s5_tables_task(task >> 1, task & 1, args, BCAT, WCAT, Lf);
            else
#endif
#ifndef P0_NO_MOD
            if (task < 256) mod_task((task - 64) * 32, args.in[I_C], args.in[I_CCTX], args.in[I_WADA], args.in[I_BADA], MOD, Lf);
            else
#endif
            {
                for (int i = tid; i < 1024; i += 512) { const int pos = i >> 4, fi = i & 15; const float inv = exp2f(-(float)fi * (13.287712379549449f / 16.0f));
                    float sn, cs; sincos_fast((float)pos * inv, &sn, &cs); ROPE[pos * 32 + fi] = cs; ROPE[pos * 32 + 16 + fi] = sn; }
                if (tid < 64) { const float* l = args.in[I_DALAM]; const float s1 = wave_sum(l[tid] * l[64 + tid]), s2 = wave_sum(l[128 + tid] * l[192 + tid]);
                    if (tid == 0) MISC[0] = expf(s1) - expf(s2) + 0.2f; }
            }
        }
        __syncthreads();
#ifndef P0_NO_TR
        for (int it = gw; it < 1600; it += ngw) {
            if (it < 1024) { const int kb = it >> 6, nb = it & 63, n0 = nb * 64;
                if (n0 >= 512 && n0 < 1536) { const int ng = lane & 15, kg = lane >> 4, cb = n0 + ng * 4, p = cb & 31, row = (cb & ~31) + (p < 16 ? 8 * (p >> 2) : 8 * ((p - 16) >> 2) + 4);
                    const float* src = args.in[I_WIN] + (size_t)kb * 64 * 4096 + cb; f32x4 v[2][8];
#pragma unroll
                    for (int h = 0; h < 2; ++h)
#pragma unroll
                        for (int i = 0; i < 8; ++i) v[h][i] = *(const f32x4*)(src + (size_t)(h * 32 + kg * 8 + i) * 4096);
#pragma unroll
                    for (int h = 0; h < 2; ++h)
#pragma unroll
                        for (int j = 0; j < 4; ++j) { u32x4 o; o.x = cvt_pk_bf16(v[h][0][j], v[h][1][j]); o.y = cvt_pk_bf16(v[h][2][j], v[h][3][j]); o.z = cvt_pk_bf16(v[h][4][j], v[h][5][j]); o.w = cvt_pk_bf16(v[h][6][j], v[h][7][j]);
                            *(u32x4*)(WINT + (size_t)(row + j) * 1024 + kb * 64 + h * 32 + kg * 8) = o; } }
                else cvt_item(args.in[I_WIN] + (size_t)kb * 64 * 4096 + n0, 4096, WINT + (size_t)n0 * 1024 + kb * 64, 1024, 4, lane); }
            else if (it < 1088) { const int r = it - 1024, kb = r >> 3, nb = r & 7;
                cvt_item(args.in[I_WGLU] + (size_t)kb * 64 * 512 + nb * 64, 512, WGLUT + (size_t)nb * 64 * 512 + kb * 64, 512, 4, lane); }
            else if (it < 1344) { const int r = (it - 1088) & 127, kb = r >> 4, nb = r & 15; const bool isb = it >= 1216;
                cvt_item(args.in[isb ? I_WPB : I_WPA] + (size_t)kb * 64 * 1024 + nb * 64, 1024, (isb ? WBT : WAT) + (size_t)nb * 64 * 512 + kb * 64, 512, 4, lane); }
            else { const int r = it - 1344, kb = r >> 4, nb = r & 15;
                cvt_item(args.in[I_WOUT] + (size_t)kb * 64 * 1024 + nb * 64, 1024, WOUTT + (size_t)nb * 64 * 1024 + kb * 64, 1024, 4, lane); }
        }
#endif
    }
    PH_END(0)
    PH_BEGIN(1) { row_pass1(args, MOD, HN, gw, ngw, lane); }
    PH_END(1)
    PH_BEGIN(2) { SchedWin S{0, G, blk, (const char*)HN, (const char*)WINT}; EpiWin E{UH, QB, KB, VB, GATES, ROPE};
        pg8::gemm_phase(lds, 2048, 2048, 2048, S, E); }
    PH_END(2)
    PH_BEGIN(3) { }
    PH_END(3)
    PH_BEGIN(4) {
        for (int bg = blk; bg < 256; bg += G) {
            { SchedS5aB S{0, bg, (const char*)UH, (const char*)BCAT}; EpiS5a E{SB}; pg8::gemm_phase(lds, 1024, 512, 512, S, E); }
            if (tid == 0) __builtin_amdgcn_fence(__ATOMIC_ACQUIRE, "agent");
            asm volatile("s_waitcnt vmcnt(0)" ::: "memory"); __syncthreads();
            s5_scan(args, SB, UH, bg, Lf);
            asm volatile("s_waitcnt vmcnt(0)" ::: "memory"); __syncthreads();
            if (tid == 0) __builtin_amdgcn_fence(__ATOMIC_ACQUIRE, "agent");
            asm volatile("s_waitcnt vmcnt(0)" ::: "memory"); __syncthreads();
            { SchedS5cB S{0, bg, (const char*)UH, (const char*)WCAT}; EpiS5c E{YA}; pg8::gemm_phase(lds, 1024, 1024, 1024, S, E); }
        }
        const int vcu = (G % 8 == 0) ? (blk % 8) * (G / 8) + blk / 8 : blk;
        static_assert(I_WEG == 26 && I_WEU == 27, "CvtSide indexes the expert weights by position");
        att::CvtSide cs; { const int gwv = __builtin_amdgcn_readfirstlane(gw); cs.in = args.in; cs.ws = ws; cs.buf = lds + att::OFF_CVT + (gwv & 7) * 4096; cs.gw = gwv; cs.t = 0; cs.tlim = 0; cs.pend = false; }
        for (int i = 0;; ++i) { const int U = i * G + vcu; if (U >= 1024) break; cs.tlim = G == 256 ? 8 * (i + 1) : 0;
            const int bh = U >> 5, rem = U & 31, c = rem >> 4, qb = rem & 15, b = bh >> 2, h = bh & 3;
            att::attn_unit(QB + ((size_t)b * LT + CL + qb * 256) * 512 + h * 128 + c * 64, KB + (size_t)b * LT * 512 + h * 128 + c * 64, VB + (size_t)b * LT * 512 + h * 128,
                           OC + ((size_t)c * ML + (size_t)b * SEQ + qb * 256) * 512 + h * 128, LT, (char*)lds_raw, cs, EPI_PROBE == 4 ? &eacc_ : nullptr); }
        if (cs.pend) att::cvt_side_store(cs, lane);
    }
    PH_END(4)
    PH_BEGIN(5) { }
    PH_END(5)
    PH_BEGIN(6) { SchedGlu S{0, G, blk, (const char*)YA, (const char*)WGLUT}; EpiGlu E{YA, YY};
        pg8::gemm_phase(lds, 1024, 1024, 1024, S, E);
        yb_combine(OC, args.in[I_SUBLN], MISC[0], YY, gw, ngw, lane); }
    PH_END(6)
    PH_BEGIN(7) { SchedProj S{0, G, blk, 0, 0, 0, (const char*)YY, (const char*)WAT, (const char*)WBT}; EpiProj E{GATES, MB};
        pg8::gemm_phase(lds, 2048, 1024, 1024, S, E, EPI_PROBE == 7 ? &eacc_ : nullptr); }
    PH_END(7)
    PH_BEGIN(8) { SchedOut S{0, G, blk, (const char*)MB, (const char*)WOUTT}; EpiOut E{OB};
        pg8::gemm_phase(lds, 2048, 2048, 2048, S, E, EPI_PROBE == 8 ? &eacc_ : nullptr); }
    PH_END(8)
    PH_BEGIN(9) {
        for (int i = tid; i < 16384; i += 512) Lf[(i & 15) * 1024 + (i >> 4)] = args.in[I_WROUTER][i];
        __syncthreads();
        row_pass2(args, MOD, OB, X1, H2, AFF, Lf, gw, ngw, lane);
    }
    PH_END(9)
    PH_BEGIN(10) {
        for (int be = blk; be < 128; be += G) topk_task(be, AFF, H2, IDX, GATEV, SLOT, XS, (LAS unsigned*)lds);
        if (G == 256 && !SIDE_PROBE) { if (blk >= 128) for (int it = (gw - 1024) * 8; it < (gw - 1024) * 8 + 8; ++it) { const int e = it >> 9, r = it & 511, kb = r >> 4, nb = r & 15;
                cvt_item8(args.in[I_WED] + (size_t)e * 2048 * 1024 + (size_t)kb * 64 * 1024 + nb * 64, 1024, WD + ((size_t)e * 1024 + nb * 64) * 2048 + kb * 64, 2048, 4, WSCALE, lane); } }
        else
            for (int it = gw; it < 24576; it += ngw) {
                if (it < 16384) { const int e = it >> 10, r = it & 1023, kb = r >> 6, fb = (r >> 1) & 31, isup = r & 1;
                    cvt_item8(args.in[isup ? I_WEU : I_WEG] + (size_t)e * 1024 * 2048 + (size_t)kb * 64 * 2048 + fb * 64, 2048, WGU + ((size_t)e * 4096 + fb * 128 + isup * 4) * 1024 + kb * 64, 1024, 8, WSCALE, lane); }
                else { const int i2 = it - 16384, e = i2 >> 9, r = i2 & 511, kb = r >> 4, nb = r & 15;
                    cvt_item8(args.in[I_WED] + (size_t)e * 2048 * 1024 + (size_t)kb * 64 * 1024 + nb * 64, 1024, WD + ((size_t)e * 1024 + nb * 64) * 2048 + kb * 64, 2048, 4, WSCALE, lane); } }
    }
    PH_END(10)
    PH_BEGIN(11) { SchedUp S{0, G, blk, (const char*)XS, (const char*)WGU}; EpiUp E{HID};
        pg8::gemm_phase<EpiUp, SchedUp, true>(lds, 1024, 1024, 1024, S, E); }
    PH_END(11)
    PH_BEGIN(12) { SchedDown S{0, G, blk, (const char*)HID, (const char*)WD}; EpiDown E{GATEV, YS};
        pg8::gemm_phase<EpiDown, SchedDown, true>(lds, 2048, 2048, 2048, S, E); }
    PH_END(12)
    PH_BEGIN(13) { row_final(args, MOD, X1, args.out, YS, SLOT, gw, ngw, lane); }
    PH_END(13)
    if (TIME_PHASE >= 0 && blk == 0 && tid == 0) { const unsigned long long d = EPI_PROBE ? eacc_ * 40000ull / (c1_ - c0_ + 1ull) : CLOCK_PROBE ? (c1_ - c0_) * 2000ull / (t1_ - t0_ + 1ull) : (t1_ - t0_) * 4ull, e0 = __builtin_amdgcn_s_memrealtime(); while (__builtin_amdgcn_s_memrealtime() - e0 < d) __builtin_amdgcn_s_sleep(10); }
#undef IN
#undef SEAM
}

extern "C" void kernel_launch(void* const* d_in, const int* in_sizes, int n_in, void* d_out, int out_size, void* d_ws, size_t ws_size, hipStream_t stream) {
    static int grid = 0;
    if (grid == 0) {
        if (n_in != 29 || in_sizes[0] != ML * DM || out_size != ML * DM || ws_size < WS_END) {
            fprintf(stderr, "kernel_launch: unexpected shapes: n_in %d in0 %d out %d ws %zu (need %zu)\n", n_in, n_in > 0 ? in_sizes[0] : -1, out_size, ws_size, (size_t)WS_END); grid = -1; return; }
        int dev = 0, cus = 0, per_cu = 0;
        if (hipGetDevice(&dev) != hipSuccess || hipDeviceGetAttribute(&cus, hipDeviceAttributeMultiprocessorCount, dev) != hipSuccess) { grid = -1; return; }
        if (hipFuncSetAttribute((const void*)fwd_kernel, hipFuncAttributeMaxDynamicSharedMemorySize, LDS_BYTES) != hipSuccess) { fprintf(stderr, "kernel_launch: hipFuncSetAttribute failed\n"); grid = -1; return; }
        if (hipOccupancyMaxActiveBlocksPerMultiprocessor(&per_cu, (const void*)fwd_kernel, 512, LDS_BYTES) != hipSuccess || per_cu < 1) { fprintf(stderr, "kernel_launch: occupancy query gave %d\n", per_cu); per_cu = 1; }
        (void)hipGetLastError();
        grid = cus * 1;
        if (grid > 256) grid = 256;
    }
    if (grid < 0) return;
    if (hipMemsetAsync((char*)d_ws + WS_BAR, 0, XCD_BAR_WORDS * 4, stream) != hipSuccess) { fprintf(stderr, "kernel_launch: memset of the barrier words failed\n"); return; }
    Args a{};
    for (int i = 0; i < 29; ++i) a.in[i] = (const float*)d_in[i];
    a.out = (float*)d_out; a.ws = (unsigned char*)d_ws;
#if MK_PER_PHASE
    for (int p = 0; p < N_PHASES; ++p) { a.ph_lo = p; a.ph_hi = p + 1;
        hipLaunchKernelGGL(fwd_kernel, dim3(grid), dim3(512), LDS_BYTES, stream, a);
        const hipError_t le = hipPeekAtLastError();
        if (le != hipSuccess) { fprintf(stderr, "kernel_launch: launch %d failed: %s\n", p, hipGetErrorName(le)); break; } }
#else
    a.ph_lo = 0; a.ph_hi = N_PHASES;
    void* kargs[] = {&a};
    const hipError_t le = hipLaunchCooperativeKernel((const void*)fwd_kernel, dim3(grid), dim3(512), kargs, LDS_BYTES, stream);
    if (le != hipSuccess) fprintf(stderr, "kernel_launch: cooperative launch failed: %s (grid %d)\n", hipGetErrorString(le), grid);
#endif
}
```

```cpp
#include <hip/hip_runtime.h>
#include <hip/hip_cooperative_groups.h>
#include <cstdio>
#include <cstdint>
namespace cg = cooperative_groups;

#ifndef MK_PER_PHASE
#define MK_PER_PHASE 0
#endif

#ifndef REPEAT_MASK
#define REPEAT_MASK 0
#endif

#define CLOCK_PROBE 0
#define EPI_PROBE 0
#define SIDE_PROBE 0
#define TIME_WITH_SEAM 0
#define TIME_PHASE -1

#define LAS __attribute__((address_space(3)))
typedef unsigned short bf16_t;
typedef short bf16x8 __attribute__((ext_vector_type(8)));
typedef short s16x4 __attribute__((ext_vector_type(4)));
typedef float f32x4 __attribute__((ext_vector_type(4)));
typedef float f32x2 __attribute__((ext_vector_type(2)));
typedef float f32x16 __attribute__((ext_vector_type(16)));
typedef unsigned u32x4 __attribute__((ext_vector_type(4)));
typedef unsigned u32x2 __attribute__((ext_vector_type(2)));

constexpr int NB = 8, SEQ = 4096, CL = 256, LT = SEQ + CL  , DM = 1024;
constexpr int MR = NB * LT  , ML = NB * SEQ  ;
constexpr int NCH = LT / 16;
constexpr int NE = 16, CAP = 512, DE = 2048;
constexpr float EPS = 1e-6f;
constexpr float QSCALE = 0.125f * 1.4426950408889634f;

constexpr size_t MiB = 1u << 20;
constexpr size_t WS_BAR = 0;
constexpr size_t WS_MOD = 64 * 1024;
constexpr size_t WS_MISC = 512 * 1024;
constexpr size_t WS_BCAT = 1 * MiB;
constexpr size_t WS_WCAT = 5 * MiB;
constexpr size_t WS_WIN = 13 * MiB;
constexpr size_t WS_WGLU = 21 * MiB;
constexpr size_t WS_WA = 22 * MiB, WS_WB = 23 * MiB;
constexpr size_t WS_WOUT = 24 * MiB;
constexpr size_t WS_AFF = 26 * MiB;
constexpr size_t WS_IDX = 28 * MiB;
constexpr size_t WS_GATEV = 28 * MiB + 512 * 1024;
constexpr size_t WS_SLOT = 29 * MiB;
constexpr size_t WS_HN = 32 * MiB;
constexpr size_t WS_UH = 100 * MiB;
constexpr size_t WS_Q = 168 * MiB, WS_K = 202 * MiB, WS_V = 236 * MiB;
constexpr size_t WS_GATES = 270 * MiB;
constexpr size_t WS_S = 32 * MiB;
constexpr size_t WS_OC = 430 * MiB;
constexpr size_t WS_YA = 398 * MiB;
constexpr size_t WS_YY = 100 * MiB;
constexpr size_t WS_M = 168 * MiB;
constexpr size_t WS_H2 = 32 * MiB;
constexpr size_t WS_XS = 64 * MiB;
constexpr size_t WS_WGU = 494 * MiB;
constexpr size_t WS_HID = 224 * MiB;
constexpr size_t WS_WD = 192 * MiB;
constexpr size_t WS_YS = 352 * MiB;
constexpr size_t WS_OB = 270 * MiB;
constexpr size_t WS_X1 = 128 * MiB;
constexpr size_t WS_END = 558 * MiB;

constexpr int LDS_BYTES = 147456;

__device__ __forceinline__ unsigned cvt_pk_bf16(float lo, float hi) { unsigned r; asm volatile("v_cvt_pk_bf16_f32 %0, %1, %2" : "=v"(r) : "v"(lo), "v"(hi)); return r; }
__device__ __forceinline__ float bf_lo(unsigned u) { return __uint_as_float(u << 16); }
__device__ __forceinline__ float bf_hi(unsigned u) { return __uint_as_float(u & 0xffff0000u); }
__device__ __forceinline__ float bf2f(bf16_t b) { return __uint_as_float(((unsigned)b) << 16); }
__device__ __forceinline__ unsigned pk_fp8x4(float a, float b, float c, float d) {
    a = __builtin_amdgcn_fmed3f(a, -448.f, 448.f); b = __builtin_amdgcn_fmed3f(b, -448.f, 448.f); c = __builtin_amdgcn_fmed3f(c, -448.f, 448.f); d = __builtin_amdgcn_fmed3f(d, -448.f, 448.f);
    int w = __builtin_amdgcn_cvt_pk_fp8_f32(a, b, 0, false); w = __builtin_amdgcn_cvt_pk_fp8_f32(c, d, w, true); return (unsigned)w; }
__device__ __forceinline__ float sigmoidf_(float x) { return __builtin_amdgcn_rcpf(1.0f + __expf(-x)); }
template <int CTRL> __device__ __forceinline__ float dpp_f(float v) { return __builtin_bit_cast(float, __builtin_amdgcn_update_dpp(0, __builtin_bit_cast(int, v), CTRL, 0xF, 0xF, true)); }
constexpr int DPP_XOR1 = 0xB1, DPP_XOR2 = 0x4E, DPP_HMIRROR = 0x141, DPP_MIRROR = 0x140, DPP_ROR8 = 0x128;
__device__ __forceinline__ float swap16_sum(float a, float b) { auto r = __builtin_amdgcn_permlane16_swap(__float_as_uint(a), __float_as_uint(b), false, false); return __uint_as_float(r[0]) + __uint_as_float(r[1]); }
__device__ __forceinline__ float swap32_sum(float a, float b) { auto r = __builtin_amdgcn_permlane32_swap(__float_as_uint(a), __float_as_uint(b), false, false); return __uint_as_float(r[0]) + __uint_as_float(r[1]); }
__device__ __forceinline__ float wave_sum(float v) {
    v += dpp_f<DPP_XOR1>(v); v += dpp_f<DPP_XOR2>(v); v += dpp_f<DPP_HMIRROR>(v); v += dpp_f<DPP_MIRROR>(v);
    v = swap16_sum(v, v); return swap32_sum(v, v);
}
__device__ __forceinline__ void sincos_fast(float x, float* sn, float* cs) {
    const float k = rintf(x * 0.15915494309189535f); float r = fmaf(-k, 6.28318548202514648f, x); r = fmaf(-k, -1.74845553e-07f, r);
    *sn = __sinf(r); *cs = __cosf(r); }
__device__ __forceinline__ float gelu_tanh(float x) { const float u = 0.7978845608028654f * (x + 0.044715f * x * x * x); return x * sigmoidf_(2.0f * u); }

__device__ __forceinline__ void map_tile(int wgid, int nM, int nN, int& pm, int& pn) {
    const int nwg = nM * nN, q = nwg / 8, r = nwg % 8, xcd = wgid % 8, off = wgid / 8;
    wgid = (xcd < r ? xcd * (q + 1) : r * (q + 1) + (xcd - r) * q) + off;
    const int nig = 8 * nN, gid = wgid / nig, fm = gid * 8, gsz = (nM - fm) < 8 ? (nM - fm) : 8;
    pm = fm + ((wgid % nig) % gsz); pn = (wgid % nig) / gsz;
}

namespace pg8 {
constexpr int BM = 256, BK = 64, HALF = 128, HTB = HALF * BK * 2, STAGE_BYTES = 8 * HTB;
__device__ __forceinline__ int lds_byte(int r, int c) { const int st = (r >> 4) * 2 + (c >> 5), rr = r & 15, cc = c & 31, ob = rr * 64 + cc * 2; return st * 1024 + (ob ^ (((ob >> 9) & 1) << 5)); }
__device__ __forceinline__ int lds_byte8(int r, int q) { return r * 128 + ((q ^ ((r >> 1) & 3)) << 5); }
__device__ __forceinline__ void stage_rc8(int b, int& R, int& Cb) { R = b >> 7; const int u = (b & 127) >> 4; Cb = (((u >> 1) ^ ((R >> 1) & 3)) << 5) + ((u & 1) << 4); }
__device__ __forceinline__ void stage_rc(int b, int& R, int& C) { const int st = b / 1024, sb = b % 1024, swz = sb ^ (((sb >> 9) & 1) << 5); R = (st >> 1) * 16 + swz / 64; C = (st & 1) * 32 + (swz % 64) / 2; }
__device__ __forceinline__ int perm32(int rho) { const int n = rho >> 4, i = rho & 15; return 8 * (i >> 2) + 4 * n + (i & 3); }

typedef int i32x8 __attribute__((ext_vector_type(8)));
__device__ __forceinline__ i32x8 ld32(const LAS unsigned char* p, int sw) { typedef int i32x4 __attribute__((ext_vector_type(4))); const i32x4 a = *(const LAS i32x4*)(p + sw), b = *(const LAS i32x4*)(p + (sw ^ 16)); return (i32x8){a[0], a[1], a[2], a[3], b[0], b[1], b[2], b[3]}; }
__device__ __forceinline__ i32x8 cat8(bf16x8 lo, bf16x8 hi) { typedef int i32x4 __attribute__((ext_vector_type(4))); const i32x4 a = __builtin_bit_cast(i32x4, lo), b = __builtin_bit_cast(i32x4, hi); return (i32x8){a[0], a[1], a[2], a[3], b[0], b[1], b[2], b[3]}; }
struct Unit { const char* a; const char* b; int r0, c0, aux; };

template <class Epi, class Sched, bool FP8 = false>
__device__ __forceinline__ void gemm_phase(LAS unsigned char* lds, const int ldaB, const int ldbB, const int KB, Sched& S, const Epi& E, unsigned long long* eacc = nullptr) {
    const int tid = threadIdx.x, wid = __builtin_amdgcn_readfirstlane(tid >> 6), lane = tid & 63, wr = wid >> 2, wc = wid & 3, fr = lane & 15, fq = lane >> 4;
    const int nt = KB / 128;
    unsigned voffA, voffB;
    { int R, C; if constexpr (FP8) stage_rc8(tid * 16, R, C); else { stage_rc(tid * 16, R, C); C *= 2; }
      const int Rb = Epi::PERM ? ((R & ~31) + perm32(R & 31)) : R; voffA = (unsigned)(R * ldaB + C); voffB = (unsigned)(Rb * ldbB + C); }
    const int sw8 = (fq & 1) * 16;
    const size_t qvoffA = (size_t)64 * ldaB, qvoffB = (size_t)64 * ldbB;
    const size_t kstep = (size_t)(BK * 2);
    const size_t hstepA = (size_t)HALF * ldaB, hstepB = (size_t)HALF * ldbB;
    const unsigned ldsw = (unsigned)wid * 1024u;
    const int aoff = FP8 ? lds_byte8(wr * 64 + fr, fq) : lds_byte(wr * 64 + fr, fq * 8), boff = FP8 ? lds_byte8(wc * 32 + fr, fq) : lds_byte(wc * 32 + fr, fq * 8);
#define PG8_SA(b, h) (((b) * 2 + (h)) * HTB)
#define PG8_SB(b, h) ((4 + (b) * 2 + (h)) * HTB)
#define PG8_STAGE(bufoff, gbase, voff) do { _Pragma("unroll") for (int _i = 0; _i < 2; ++_i) \
        __builtin_amdgcn_global_load_lds((const unsigned*)((const char*)(gbase) + (_i ? q##voff : (size_t)0) + voff), (LAS unsigned*)(lds + (bufoff) + ldsw + _i * 8192), 16, 0, 0); } while (0)
#define PG8_LDA(dst, b, h) do { _Pragma("unroll") for (int m = 0; m < 4; ++m) { if constexpr (FP8) dst##8[m] = ld32(lds + PG8_SA(b, h) + aoff + m * 2048, sw8); else { _Pragma("unroll") for (int k = 0; k < 2; ++k) dst[m][k] = *(const LAS bf16x8*)(lds + PG8_SA(b, h) + aoff + m * 2048 + k * 1024); } } } while (0)
#define PG8_LDB(dst, b, h) do { _Pragma("unroll") for (int n = 0; n < 2; ++n) { if constexpr (FP8) dst##8[n] = ld32(lds + PG8_SB(b, h) + boff + n * 2048, sw8); else { _Pragma("unroll") for (int k = 0; k < 2; ++k) dst[n][k] = *(const LAS bf16x8*)(lds + PG8_SB(b, h) + boff + n * 2048 + k * 1024); } } } while (0)
#define PG8_MMA(ai, bj, At, Bt) do { __builtin_amdgcn_s_setprio(1); _Pragma("unroll") for (int m = 0; m < 4; ++m) _Pragma("unroll") for (int n = 0; n < 2; ++n) { \
        if constexpr (FP8) { asm volatile("v_mfma_f32_16x16x128_f8f6f4 %0, %1, %2, %0" : "+v"(acc[ai][bj][m][n]) : "v"(Bt##8[n]), "v"(At##8[m])); } \
        else { _Pragma("unroll") for (int k = 0; k < 2; ++k) acc[ai][bj][m][n] = __builtin_amdgcn_mfma_f32_16x16x32_bf16(Bt[n][k], At[m][k], acc[ai][bj][m][n], 0, 0, 0); } } \
        __builtin_amdgcn_s_setprio(0); } while (0)
#define PG8_WAIT_V(n) asm volatile("s_waitcnt vmcnt(" #n ")" ::: "memory")
#define PG8_WAIT_L(n) asm volatile("s_waitcnt lgkmcnt(" #n ")" ::: "memory")
#define PG8_BAR __builtin_amdgcn_s_barrier()
#define PG8_SCHED __builtin_amdgcn_sched_barrier(0)
    Unit cur, nxt;
    if (!S.next(cur)) return;
    f32x4 acc[2][2][4][2];
#pragma unroll
    for (int a = 0; a < 2; ++a)
#pragma unroll
        for (int b = 0; b < 2; ++b)
#pragma unroll
            for (int m = 0; m < 4; ++m)
#pragma unroll
                for (int n = 0; n < 2; ++n) { acc[a][b][m][n] = (f32x4){0.f, 0.f, 0.f, 0.f}; if constexpr (FP8) asm volatile("" : "+v"(acc[a][b][m][n])); }
    bf16x8 At[4][2], B0[2][2], B1[2][2]; i32x8 At8[4], B08[2], B18[2];
    const char* cA = cur.a; const char* cB = cur.b;
    PG8_STAGE(PG8_SB(0, 0), cB, voffB); PG8_STAGE(PG8_SB(0, 1), cB + hstepB, voffB); PG8_STAGE(PG8_SA(0, 0), cA, voffA); PG8_STAGE(PG8_SA(0, 1), cA + hstepA, voffA);
    if (wr == 1) PG8_BAR;
    PG8_WAIT_V(2); PG8_BAR;
    PG8_STAGE(PG8_SB(1, 0), cB + kstep, voffB); PG8_STAGE(PG8_SA(1, 0), cA + kstep, voffA); PG8_STAGE(PG8_SB(1, 1), cB + hstepB + kstep, voffB);
    PG8_WAIT_V(6); PG8_BAR;
    for (;;) {
        const bool has_next = S.next(nxt);
        const char* nA = has_next ? nxt.a : cA; const char* nB = has_next ? nxt.b : cB;
#pragma unroll 1
        for (int t = 0; t < nt; t += 2) {
            const bool last = (t == nt - 2);
            const char* a1 = cA + (size_t)(t + 1) * kstep;
            const char* a2 = last ? nA : cA + (size_t)(t + 2) * kstep; const char* b2 = last ? nB : cB + (size_t)(t + 2) * kstep;
            const char* a3 = a2 + kstep; const char* b3 = b2 + kstep;
            PG8_LDB(B0, 0, 0); PG8_LDB(B1, 0, 1); PG8_SCHED; PG8_LDA(At, 0, 0); PG8_STAGE(PG8_SA(1, 1), a1 + hstepA, voffA);
            PG8_WAIT_V(8); PG8_WAIT_L(0); PG8_BAR; PG8_MMA(0, 0, At, B0); PG8_MMA(0, 1, At, B1); PG8_BAR; PG8_SCHED;
            PG8_LDA(At, 0, 1); PG8_STAGE(PG8_SB(0, 0), b2, voffB); PG8_STAGE(PG8_SB(0, 1), b2 + hstepB, voffB); PG8_STAGE(PG8_SA(0, 0), a2, voffA);
            PG8_WAIT_V(8); PG8_WAIT_L(0); PG8_BAR; PG8_MMA(1, 0, At, B0); PG8_MMA(1, 1, At, B1); PG8_BAR; PG8_SCHED;
            PG8_LDB(B0, 1, 0); PG8_LDB(B1, 1, 1); PG8_SCHED; PG8_LDA(At, 1, 0); PG8_STAGE(PG8_SA(0, 1), a2 + hstepA, voffA);
            PG8_WAIT_V(8); PG8_WAIT_L(0); PG8_BAR; PG8_MMA(0, 0, At, B0); PG8_MMA(0, 1, At, B1); PG8_BAR; PG8_SCHED;
            PG8_LDA(At, 1, 1); PG8_STAGE(PG8_SB(1, 0), b3, voffB); PG8_STAGE(PG8_SB(1, 1), b3 + hstepB, voffB); PG8_STAGE(PG8_SA(1, 0), a3, voffA);
            PG8_WAIT_V(8); PG8_WAIT_L(0); PG8_BAR; PG8_MMA(1, 0, At, B0); PG8_MMA(1, 1, At, B1); PG8_BAR; PG8_SCHED;
        }
        if (wr == 0) PG8_BAR;
        if constexpr (FP8) { asm volatile("s_nop 15\n\ts_nop 15" ::: "memory"); PG8_SCHED; }
        const unsigned long long e0_ = eacc ? __builtin_amdgcn_s_memtime() : 0ull;
        const bool zero = E(acc, cur, wr, wc, fr, fq);
        if (eacc) { asm volatile("s_waitcnt vmcnt(0)" ::: "memory"); *eacc += __builtin_amdgcn_s_memtime() - e0_; }
        if (!has_next) break;
        if (zero) {
#pragma unroll
            for (int a = 0; a < 2; ++a)
#pragma unroll
                for (int b = 0; b < 2; ++b)
#pragma unroll
                    for (int m = 0; m < 4; ++m)
#pragma unroll
                        for (int n = 0; n < 2; ++n) { acc[a][b][m][n] = (f32x4){0.f, 0.f, 0.f, 0.f}; if constexpr (FP8) asm volatile("" : "+v"(acc[a][b][m][n])); }
        }
        cur = nxt; cA = nA; cB = nB;
        if (wr == 1) PG8_BAR;
    }
    PG8_WAIT_V(0);
    PG8_BAR;
#undef PG8_SA
#undef PG8_SB
#undef PG8_STAGE
#undef PG8_LDA
#undef PG8_LDB
#undef PG8_MMA
#undef PG8_WAIT_V
#undef PG8_WAIT_L
#undef PG8_BAR
#undef PG8_SCHED
}
}
using pg8::Unit;

namespace att {
constexpr int QBLK = 32, KVBLK = 64, LD = 512;
constexpr int SHM_V = KVBLK * 128 * 2, SHM_K = KVBLK * 64 * 2;
constexpr int OFF_V = 0, OFF_K = 3 * SHM_V, OFF_WS = OFF_K + 3 * SHM_K, ATT_LDS = OFF_WS + 8 * 64 * 4;
constexpr float THRL = 8.0f;
#define KSWZ(row, colB) ((row) * 128 + ((colB) ^ ((((row) >> 1) & 7) << 4)))
#define SBAR() __builtin_amdgcn_sched_barrier(0)
__device__ __forceinline__ int crow(int r, int hi) { return (r & 3) + 8 * (r >> 2) + 4 * hi; }

__device__ __forceinline__ void partialSM(f32x16& p0, f32x16& p1, float& m_reg, float& alpha) {
    float pmax = p0[0];
#pragma unroll
    for (int r = 1; r < 16; ++r) pmax = fmaxf(pmax, p0[r]);
#pragma unroll
    for (int r = 0; r < 16; ++r) pmax = fmaxf(pmax, p1[r]);
    { auto rr = __builtin_amdgcn_permlane32_swap(__float_as_uint(pmax), __float_as_uint(pmax), false, false);
      pmax = fmaxf(__uint_as_float(rr[0]), __uint_as_float(rr[1])); }
    if (__builtin_expect(__all(pmax - m_reg <= THRL), 1)) { alpha = 1.f; }
    else { const float mn = fmaxf(m_reg, pmax); alpha = __builtin_amdgcn_exp2f(m_reg - mn); m_reg = mn; }
    const float mm = m_reg;
#pragma unroll
    for (int r = 0; r < 16; ++r) p0[r] = p0[r] - mm;
#pragma unroll
    for (int r = 0; r < 16; ++r) p1[r] = p1[r] - mm;
#pragma unroll
    for (int r = 0; r < 16; ++r) p0[r] = __builtin_amdgcn_exp2f(p0[r]);
}
__device__ __forceinline__ void finishSM(f32x16& p0, f32x16& p1, float alpha, float& l_reg, bf16x8& pa0, bf16x8& pa1, bf16x8& pa2, bf16x8& pa3) {
#pragma unroll
    for (int r = 0; r < 16; ++r) p1[r] = __builtin_amdgcn_exp2f(p1[r]);
    float ps = 0;
#pragma unroll
    for (int r = 0; r < 16; ++r) ps += p0[r];
#pragma unroll
    for (int r = 0; r < 16; ++r) ps += p1[r];
    { auto rr = __builtin_amdgcn_permlane32_swap(__float_as_uint(ps), __float_as_uint(ps), false, false);
      ps = __uint_as_float(rr[0]) + __uint_as_float(rr[1]); }
    l_reg = l_reg * alpha + ps;
#define PK4(P, BASE, OUT) do { unsigned a0 = cvt_pk_bf16(P[BASE + 0], P[BASE + 1]), a1 = cvt_pk_bf16(P[BASE + 2], P[BASE + 3]);   \
    unsigned b0 = cvt_pk_bf16(P[BASE + 4], P[BASE + 5]), b1 = cvt_pk_bf16(P[BASE + 6], P[BASE + 7]);                              \
    auto r0 = __builtin_amdgcn_permlane32_swap(a0, b0, false, false); auto r1 = __builtin_amdgcn_permlane32_swap(a1, b1, false, false); \
    u32x4 w = {r0[0], r1[0], r0[1], r1[1]}; OUT = *reinterpret_cast<bf16x8*>(&w); } while (0)
    PK4(p0, 0, pa0); PK4(p0, 8, pa1); PK4(p1, 0, pa2); PK4(p1, 8, pa3);
#undef PK4
}
__device__ __forceinline__ void qkt(f32x16& p0, f32x16& p1, const char* Ks, const bf16x8* qr, int r32, int hi) {
    p0 = f32x16{}; p1 = f32x16{};
#pragma unroll
    for (int d0 = 0; d0 < 4; ++d0) { const int cb = (d0 * 16 + hi * 8) * 2;
        const bf16x8 b0 = *reinterpret_cast<const bf16x8*>(Ks + KSWZ(r32, cb));
        const bf16x8 b1 = *reinterpret_cast<const bf16x8*>(Ks + KSWZ(32 + r32, cb));
        p0 = __builtin_amdgcn_mfma_f32_32x32x16_bf16(b0, qr[d0], p0, 0, 0, 0);
        p1 = __builtin_amdgcn_mfma_f32_32x32x16_bf16(b1, qr[d0], p1, 0, 0, 0);
 }
}
__device__ __forceinline__ int v_st(int k, int c) { const int kk = (k & ~0xC) | ((k & 4) << 1) | ((k & 8) >> 1); return ((kk >> 3) * 4 + (c >> 5)) * 512 + ((kk & 7) * 32 + (c & 31)) * 2; }
__device__ __forceinline__ int v_rd_base(int lane) { return ((lane & 3) << 3) | (((lane >> 2) & 3) << 6) | (((lane >> 4) & 1) << 5) | (((lane >> 5) & 1) << 8); }
constexpr int v_rd_off(int d0, int ks, int half) { return d0 * 512 + ks * 4096 + half * 2048; }
template <int OFF> __device__ __forceinline__ s16x4 tr_read(int vb) {
    s16x4 r; asm volatile("ds_read_b64_tr_b16 %0, %1 offset:%2" : "=&v"(r) : "v"(vb), "i"(OFF) : "memory"); return r;
}
template <int D0> __device__ __forceinline__ void pv_one(f32x16& od, int vb, bf16x8 pa0, bf16x8 pa1, bf16x8 pa2, bf16x8 pa3) {
    const s16x4 l0 = tr_read<v_rd_off(D0, 0, 0)>(vb), h0 = tr_read<v_rd_off(D0, 0, 1)>(vb), l1 = tr_read<v_rd_off(D0, 1, 0)>(vb), h1 = tr_read<v_rd_off(D0, 1, 1)>(vb);
    const s16x4 l2 = tr_read<v_rd_off(D0, 2, 0)>(vb), h2 = tr_read<v_rd_off(D0, 2, 1)>(vb), l3 = tr_read<v_rd_off(D0, 3, 0)>(vb), h3 = tr_read<v_rd_off(D0, 3, 1)>(vb);
    asm volatile("s_waitcnt lgkmcnt(0)" ::: "memory"); SBAR();
#define PK(L, H) (bf16x8){L[0], L[1], L[2], L[3], H[0], H[1], H[2], H[3]}
    od = __builtin_amdgcn_mfma_f32_32x32x16_bf16(pa0, PK(l0, h0), od, 0, 0, 0);
    od = __builtin_amdgcn_mfma_f32_32x32x16_bf16(pa1, PK(l1, h1), od, 0, 0, 0);
    od = __builtin_amdgcn_mfma_f32_32x32x16_bf16(pa2, PK(l2, h2), od, 0, 0, 0);
    od = __builtin_amdgcn_mfma_f32_32x32x16_bf16(pa3, PK(l3, h3), od, 0, 0, 0);
#undef PK
}
__device__ __forceinline__ void pv_d0(f32x16* o, int vb, bf16x8 pa0, bf16x8 pa1, bf16x8 pa2, bf16x8 pa3) {
    pv_one<0>(o[0], vb, pa0, pa1, pa2, pa3); pv_one<1>(o[1], vb, pa0, pa1, pa2, pa3); pv_one<2>(o[2], vb, pa0, pa1, pa2, pa3); pv_one<3>(o[3], vb, pa0, pa1, pa2, pa3);
}

constexpr int OFF_CVT = 80 * 1024;
struct CvtSide { const float* const* in; unsigned char* ws; LAS unsigned char* buf; int gw, t, tlim; bool pend; };
__device__ __forceinline__ void cvt_side_store(CvtSide& c, int lane) {
    const int t = c.t - 1, mat = t >> 4, i = t & 15, n = lane & 31, kh = lane >> 5, e = c.gw >> 7, w = c.gw & 127, f = (w >> 1) * 32 + n;
    unsigned char* d = c.ws + WS_WGU + (size_t)(e * 4096 + (f >> 2) * 8 + (f & 3) + mat * 4) * 1024 + (512 * (w & 1) + i * 32 + kh * 16);
    const LAS float* b = (const LAS float*)c.buf + kh * 512 + n; float x[16];
#pragma unroll
    for (int k = 0; k < 16; ++k) x[k] = b[k * 32] * 32.0f;
    u32x4 o; o.x = pk_fp8x4(x[0], x[1], x[2], x[3]); o.y = pk_fp8x4(x[4], x[5], x[6], x[7]); o.z = pk_fp8x4(x[8], x[9], x[10], x[11]); o.w = pk_fp8x4(x[12], x[13], x[14], x[15]);
    *(u32x4*)d = o;
    c.pend = false;
}
__device__ __forceinline__ void cvt_side_load(CvtSide& c, int lane) {
    const int t = c.t, mat = t >> 4, i = t & 15, row = lane >> 3, seg = lane & 7, e = c.gw >> 7, w = c.gw & 127;
    const float* s = c.in[26 + mat] + (size_t)e * 1024 * 2048 + (size_t)(512 * (w & 1) + i * 32 + row) * 2048 + (w >> 1) * 32 + seg * 4;
#pragma unroll
    for (int r = 0; r < 4; ++r) __builtin_amdgcn_global_load_lds((const unsigned*)(s + (size_t)(r * 8) * 2048), (LAS unsigned*)(c.buf + r * 1024), 16, 0, 0);
    ++c.t; c.pend = true;
}

__device__ __forceinline__ void attn_unit(const bf16_t* Qb, const bf16_t* Kh, const bf16_t* Vh, bf16_t* Ob, int seq, char* lds, CvtSide& cs, unsigned long long* bacc = nullptr) {
    const int tid = threadIdx.x, wid = tid >> 6, lane = tid & 63, r32 = lane & 31, hi = lane >> 5;
    char* V_lds = lds + OFF_V; char* K_lds = lds + OFF_K;
    float* ws = (float*)(lds + OFF_WS) + wid * 64; float* li_l = ws; float* al_l = ws + 32;
    float m_reg = -1e30f, l_reg = 0; f32x16 o[4] = {}; bf16x8 qr[4];
    const bf16_t* Qw = Qb + (long)(wid * QBLK + r32) * LD + hi * 8;
#pragma unroll
    for (int d0 = 0; d0 < 4; ++d0) qr[d0] = *reinterpret_cast<const bf16x8*>(Qw + d0 * 16);
    const int sr = tid >> 4, sc = (tid & 15) * 8, vst0 = v_st(sr, sc), vst1 = v_st(32 + sr, sc);
    const int kr = tid >> 3, kc = (tid & 7) * 8, kst = KSWZ(kr, kc * 2);
    const int vb0 = (int)(uintptr_t)V_lds + v_rd_base(lane);
    struct { bf16x8 vs0, vs1, ks0; } sr_[1];
#define SLOAD(i, k0) do { sr_[i].vs0 = *reinterpret_cast<const bf16x8*>(&Vh[(long)((k0) + sr) * LD + sc]); sr_[i].vs1 = *reinterpret_cast<const bf16x8*>(&Vh[(long)((k0) + 32 + sr) * LD + sc]); \
    sr_[i].ks0 = *reinterpret_cast<const bf16x8*>(&Kh[(long)((k0) + kr) * LD + kc]); } while (0)
#define SWRITE(b, i) do { *(bf16x8*)(V_lds + (b) * SHM_V + vst0) = sr_[i].vs0; *(bf16x8*)(V_lds + (b) * SHM_V + vst1) = sr_[i].vs1; \
    *(bf16x8*)(K_lds + (b) * SHM_K + kst) = sr_[i].ks0; } while (0)
#define SWAIT() asm volatile("s_waitcnt vmcnt(3)" ::: "memory")
#define RESC(a) do { if (__any((a) < 1.f)) { if (hi == 0) al_l[r32] = (a); asm volatile("s_waitcnt lgkmcnt(0)" ::: "memory"); \
    _Pragma("unroll") for (int d = 0; d < 4; ++d) _Pragma("unroll") for (int r = 0; r < 16; ++r) o[d][r] *= al_l[crow(r, hi)]; } } while (0)
    f32x16 pA0, pA1, pB0, pB1; float alA, alB; bf16x8 pa0, pa1, pa2, pa3; const int NT = seq / KVBLK;
    SLOAD(0, 0); asm volatile("s_waitcnt vmcnt(0)" ::: "memory"); SWRITE(0, 0); SLOAD(0, KVBLK); __syncthreads();
    qkt(pA0, pA1, K_lds, qr, r32, hi); partialSM(pA0, pA1, m_reg, alA);
    SWRITE(1, 0); if (2 < NT) SLOAD(0, 2 * KVBLK); __syncthreads();
    int bp = 0, bc = 1, bn = 2;
    for (int j = 1; j + 1 < NT; j += 2) {
        SWRITE(bn, 0);
        if (cs.pend) { if (SIDE_PROBE != 1) cvt_side_store(cs, lane); else cs.pend = false; }
        SLOAD(0, (j + 2) * KVBLK);
        if ((j & 2) && cs.t < cs.tlim) { if (SIDE_PROBE != 2) cvt_side_load(cs, lane); else { ++cs.t; cs.pend = true; } }
        SBAR(); qkt(pB0, pB1, K_lds + bc * SHM_K, qr, r32, hi);
        finishSM(pA0, pA1, alA, l_reg, pa0, pa1, pa2, pa3); SBAR();
        pv_d0(o, vb0 + bp * SHM_V, pa0, pa1, pa2, pa3); partialSM(pB0, pB1, m_reg, alB);
        RESC(alB); { const unsigned long long b0_ = bacc ? __builtin_amdgcn_s_memtime() : 0ull; __syncthreads(); if (bacc) *bacc += __builtin_amdgcn_s_memtime() - b0_; }
        { const int t_ = bp; bp = bc; bc = bn; bn = t_; }
        SWRITE(bn, 0); if (j + 3 < NT) SLOAD(0, (j + 3) * KVBLK);
        SBAR(); qkt(pA0, pA1, K_lds + bc * SHM_K, qr, r32, hi);
        finishSM(pB0, pB1, alB, l_reg, pa0, pa1, pa2, pa3); SBAR();
        pv_d0(o, vb0 + bp * SHM_V, pa0, pa1, pa2, pa3); partialSM(pA0, pA1, m_reg, alA);
        RESC(alA); { const unsigned long long b0_ = bacc ? __builtin_amdgcn_s_memtime() : 0ull; __syncthreads(); if (bacc) *bacc += __builtin_amdgcn_s_memtime() - b0_; }
        { const int t_ = bp; bp = bc; bc = bn; bn = t_; }
    }
    SBAR(); qkt(pB0, pB1, K_lds + bc * SHM_K, qr, r32, hi);
    finishSM(pA0, pA1, alA, l_reg, pa0, pa1, pa2, pa3); SBAR();
    pv_d0(o, vb0 + bp * SHM_V, pa0, pa1, pa2, pa3); partialSM(pB0, pB1, m_reg, alB);
    RESC(alB);
    finishSM(pB0, pB1, alB, l_reg, pa0, pa1, pa2, pa3); SBAR();
    pv_d0(o, vb0 + bc * SHM_V, pa0, pa1, pa2, pa3);
    if (hi == 0) li_l[r32] = l_reg; asm volatile("s_waitcnt lgkmcnt(0)" ::: "memory");
    float rli[16];
#pragma unroll
    for (int r = 0; r < 16; ++r) rli[r] = __builtin_amdgcn_rcpf(li_l[crow(r, hi)]);
    bf16_t* Ow = Ob + (long)(wid * QBLK) * LD;
#pragma unroll
    for (int r = 0; r < 16; ++r) { const int orow = crow(r, hi);
#pragma unroll
        for (int d0 = 0; d0 < 4; ++d0) Ow[(long)orow * LD + d0 * 32 + r32] = (bf16_t)(cvt_pk_bf16(o[d0][r] * rli[r], 0.f) & 0xffffu); }
    __syncthreads();
#undef SLOAD
#undef SWRITE
#undef SWAIT
#undef RESC
}
#undef KSWZ
#undef SBAR
}


#define XB_TMO      128
#define XB_XCNT(j)  (256  + 64 * (j))
#define XB_XSUB(j)  (1280 + 64 * (j))
#define XB_XGEN(j)  (2304 + 64 * (j))
#define XB_TOP      3328
#define XB_TOPGEN   3392
#define XCD_BAR_WORDS 3456
#define XB_SPIN_CAP (1u << 18)

__device__ __forceinline__ unsigned xb_ld(unsigned* p)              { return __hip_atomic_load(p, __ATOMIC_RELAXED, __HIP_MEMORY_SCOPE_AGENT); }
__device__ __forceinline__ unsigned xb_add(unsigned* p, unsigned v) { return __hip_atomic_fetch_add(p, v, __ATOMIC_RELAXED, __HIP_MEMORY_SCOPE_AGENT); }
__device__ __forceinline__ unsigned xb_xcc_id() { return (unsigned)__builtin_amdgcn_s_getreg((3 << 11) | 20) & 0xFu; }
#define XB_SPIN(cond, bar) do { unsigned _sp = 0; while (cond) { __builtin_amdgcn_s_sleep(1); \
    if ((++_sp & 255u) == 0u) { if (xb_ld(&(bar)[XB_TMO])) break; if (_sp > XB_SPIN_CAP) { atomicAdd(&(bar)[XB_TMO], 1u); break; } } } } while (0)

struct XcdBarrier {
    unsigned* bar; unsigned x;
    volatile LAS unsigned* st;
};

__device__ __forceinline__ XcdBarrier xcd_barrier_post(unsigned* bar, volatile LAS unsigned* st) {
    XcdBarrier b; b.bar = bar; b.x = xb_xcc_id(); b.st = st;
    if (threadIdx.x == 0) (void)xb_add(&bar[XB_XCNT(b.x)], 1u);
    return b;
}
__device__ __forceinline__ void xcd_barrier_complete(unsigned* bar, unsigned x, unsigned& nloc, unsigned& nx) {
    const unsigned G = gridDim.x * gridDim.y * gridDim.z;
    unsigned sum, cnt, mine, sp = 0u;
    for (;;) {
        sum = 0u; cnt = 0u; mine = 0u;
#pragma unroll
        for (unsigned j = 0; j < 16; ++j) { const unsigned c = xb_ld(&bar[XB_XCNT(j)]); sum += c; cnt += (c > 0u) ? 1u : 0u; mine = (j == x) ? c : mine; }
        if (sum == G) break;
        __builtin_amdgcn_s_sleep(1);
        if ((++sp & 255u) == 0u) { if (xb_ld(&bar[XB_TMO])) break; if (sp > XB_SPIN_CAP) { atomicAdd(&bar[XB_TMO], 1u); break; } }
    }
    nloc = mine > 0u ? mine : 1u; nx = cnt > 0u ? cnt : 1u;
}

__device__ __forceinline__ void xcd_barrier(const XcdBarrier& b) {
    asm volatile("s_waitcnt vmcnt(0)" ::: "memory");
    __syncthreads();
    if (threadIdx.x == 0) {
        unsigned* bar = b.bar;
        __builtin_amdgcn_s_waitcnt(0);
        unsigned nloc = b.st[0], nx = b.st[1];
        if (nloc == 0u) { xcd_barrier_complete(bar, b.x, nloc, nx); b.st[0] = nloc; b.st[1] = nx; }
        const unsigned old = xb_add(&bar[XB_XSUB(b.x)], 1u);
        const unsigned gen = old / nloc;
        if (old + 1u == (gen + 1u) * nloc) {
            __builtin_amdgcn_fence(__ATOMIC_RELEASE, "agent");
            asm volatile("s_waitcnt vmcnt(0)" ::: "memory");
            const unsigned og = xb_add(&bar[XB_TOP], 1u);
            const unsigned tg = og / nx;
            if (og + 1u == (tg + 1u) * nx) xb_add(&bar[XB_TOPGEN], 1u);
            else XB_SPIN(xb_ld(&bar[XB_TOPGEN]) == tg, bar);
            __builtin_amdgcn_fence(__ATOMIC_ACQUIRE, "agent");
            xb_add(&bar[XB_XGEN(b.x)], 1u);
            asm volatile("s_waitcnt vmcnt(0)" ::: "memory");
        } else {
            XB_SPIN(xb_ld(&bar[XB_XGEN(b.x)]) == gen, bar);
            __builtin_amdgcn_fence(__ATOMIC_ACQUIRE, "agent");
            asm volatile("s_waitcnt vmcnt(0)" ::: "memory");
        }
    }
    __syncthreads();
}


struct Args { const float* in[29]; float* out; unsigned char* ws; int ph_lo, ph_hi; };
enum { I_X = 0, I_C, I_CTX, I_CCTX, I_WADA, I_BADA, I_NPREMIX, I_NPOSTMIX, I_NPREFFN, I_NPOSTFFN, I_WIN, I_LAMRE, I_LAMIM, I_LOGDT, I_BRE, I_BIM,
       I_CRE, I_CIM, I_S5D, I_WGLU, I_DALAM, I_SUBLN, I_WPA, I_WPB, I_WOUT, I_WROUTER, I_WEG, I_WEU, I_WED };

__device__ __forceinline__ unsigned pk2(float lo, float hi) { return cvt_pk_bf16(lo, hi); }
__device__ __forceinline__ void transpose_item(const float* colp, size_t ld, bf16_t* dst, int dK, LAS float* scr, int lane) {
#pragma unroll 8
    for (int kk = 0; kk < 64; ++kk) scr[kk * 65 + lane] = colp[(size_t)kk * ld];
    asm volatile("s_waitcnt lgkmcnt(0)" ::: "memory");
    const int c = lane & 7;
#pragma unroll
    for (int j = 0; j < 8; ++j) { const int n = (lane >> 3) + 8 * j; const LAS float* s = scr + (8 * c) * 65 + n;
        u32x4 o; o.x = pk2(s[0 * 65], s[1 * 65]); o.y = pk2(s[2 * 65], s[3 * 65]); o.z = pk2(s[4 * 65], s[5 * 65]); o.w = pk2(s[6 * 65], s[7 * 65]);
        *(u32x4*)(dst + (size_t)n * dK + 8 * c) = o; }
    asm volatile("s_waitcnt lgkmcnt(0)" ::: "memory");
}
__device__ __forceinline__ void cvt_item(const float* src, size_t ld, bf16_t* dst, size_t dK, int rstep, int lane) {
    const int ng = lane & 15, kg = lane >> 4;
    f32x4 v[2][8];
#pragma unroll
    for (int h = 0; h < 2; ++h)
#pragma unroll
        for (int i = 0; i < 8; ++i) v[h][i] = *(const f32x4*)(src + (size_t)(h * 32 + kg * 8 + i) * ld + ng * 4);
#pragma unroll
    for (int h = 0; h < 2; ++h)
#pragma unroll
        for (int j = 0; j < 4; ++j) { u32x4 o; o.x = cvt_pk_bf16(v[h][0][j], v[h][1][j]); o.y = cvt_pk_bf16(v[h][2][j], v[h][3][j]); o.z = cvt_pk_bf16(v[h][4][j], v[h][5][j]); o.w = cvt_pk_bf16(v[h][6][j], v[h][7][j]);
            *(u32x4*)(dst + (size_t)(ng * rstep + j) * dK + h * 32 + kg * 8) = o; }
}
__device__ __forceinline__ void cvt_item8(const float* src, size_t ld, unsigned char* dst, size_t dK, int rstep, float scale, int lane) {
    const int ng = lane & 15, kg = lane >> 4;
    f32x4 v[16];
#pragma unroll
    for (int i = 0; i < 16; ++i) v[i] = *(const f32x4*)(src + (size_t)(kg * 16 + i) * ld + ng * 4);
#pragma unroll
    for (int j = 0; j < 4; ++j) { u32x4 o; o.x = pk_fp8x4(v[0][j] * scale, v[1][j] * scale, v[2][j] * scale, v[3][j] * scale); o.y = pk_fp8x4(v[4][j] * scale, v[5][j] * scale, v[6][j] * scale, v[7][j] * scale);
        o.z = pk_fp8x4(v[8][j] * scale, v[9][j] * scale, v[10][j] * scale, v[11][j] * scale); o.w = pk_fp8x4(v[12][j] * scale, v[13][j] * scale, v[14][j] * scale, v[15][j] * scale);
        *(u32x4*)(dst + (size_t)(ng * rstep + j) * dK + kg * 16) = o; }
}
__device__ __forceinline__ int permq(int n) { const int p = n & 31, a = p >> 3, b = p & 7; return (n & ~31) + ((b < 4) ? (4 * a + b) : (16 + 4 * a + (b - 4))); }

__device__ __forceinline__ void mod_task(int col0, const float* c, const float* cctx, const float* wada, const float* bada, float* MOD, LAS float* L) {
    const int tid = threadIdx.x;
    LAS float* sc = L; LAS float* red = L + 9 * 1024;
    for (int i = tid; i < 9 * 1024; i += 512) { const int row = i >> 10, k = i & 1023; const float v = row < 8 ? c[row * 1024 + k] : cctx[k]; sc[i] = v * sigmoidf_(v); }
    __syncthreads();
    const int cl = tid & 31, kg = tid >> 5, col = col0 + cl;
    float acc[9];
#pragma unroll
    for (int r = 0; r < 9; ++r) acc[r] = 0.f;
#pragma unroll 16
    for (int k = kg; k < 1024; k += 16) { const float w = wada[(size_t)k * 6144 + col];
#pragma unroll
        for (int r = 0; r < 9; ++r) acc[r] += sc[r * 1024 + k] * w; }
#pragma unroll
    for (int r = 0; r < 9; ++r) red[(kg * 9 + r) * 32 + cl] = acc[r];
    __syncthreads();
    if (tid < 288) { const int r = tid >> 5, cc = tid & 31; float s = 0.f;
#pragma unroll
        for (int g = 0; g < 16; ++g) s += red[(g * 9 + r) * 32 + cc];
        MOD[r * 6144 + col0 + cc] = s + bada[col0 + cc]; }
    __syncthreads();
}

__device__ __forceinline__ void s5_tables_task(int g, int dir, const Args& A, bf16_t* Bcat, bf16_t* Wcat, LAS float* L) {
    const int tid = threadIdx.x;
    constexpr int CP = 68;
    LAS float* pw_re = L; LAS float* pw_im = L + 1088; LAS float* Bb_re = L + 2176; LAS float* Bb_im = L + 3200; LAS float* C_re = L + 4224; LAS float* C_im = L + 5312;
    LAS float* Kt = L + 6400; LAS float* K0o = L + 10496; LAS float* Bb2_re = L + 10752; LAS float* Bb2_im = L + 11776; LAS float* C2_re = L + 12800; LAS float* C2_im = L + 13824;
    const float* lam_re = A.in[I_LAMRE]; const float* lam_im = A.in[I_LAMIM]; const float* log_dt = A.in[I_LOGDT];
    const float* b_re = A.in[I_BRE]; const float* b_im = A.in[I_BIM]; const float* c_re = A.in[I_CRE]; const float* c_im = A.in[I_CIM]; const float* s5d = A.in[I_S5D];
    { const int which = tid >> 8, p = (tid >> 2) & 63, hq = tid & 3, d = which ? 1 - dir : dir;
      if (which == 0 || dir == 0) { const int gi = d * 32 + g;
        const float lr = fminf(lam_re[gi * 64 + p], -1e-4f), li = lam_im[gi * 64 + p], dt = expf(log_dt[gi]);
        const f32x4 br = *(const f32x4*)(b_re + (size_t)(gi * 64 + p) * 16 + hq * 4), bi = *(const f32x4*)(b_im + (size_t)(gi * 64 + p) * 16 + hq * 4);
        const float lrd = lr * dt, lid = li * dt;
        float sn, cs; sincos_fast(lid, &sn, &cs); const float mag = expf(lrd);
        const float lb_re = mag * cs, lb_im = mag * sn, den = lr * lr + li * li, num_re = lb_re - 1.0f;
        const float co_re = (num_re * lr + lb_im * li) / den, co_im = (lb_im * lr - num_re * li) / den;
        LAS float* dre = which ? Bb2_re : Bb_re; LAS float* dim_ = which ? Bb2_im : Bb_im;
        *(LAS f32x4*)(dre + p * 16 + hq * 4) = co_re * br - co_im * bi; *(LAS f32x4*)(dim_ + p * 16 + hq * 4) = co_re * bi + co_im * br; } }
    for (int i = tid; i < 1088; i += 512) { const int tau = i >> 6, p = i & 63, gi = dir * 32 + g;
        const float lr = fminf(lam_re[gi * 64 + p], -1e-4f), li = lam_im[gi * 64 + p], dt = expf(log_dt[gi]), lrd = lr * dt, lid = li * dt;
        float s2, c2; sincos_fast((float)tau * lid, &s2, &c2); const float m2 = expf((float)tau * lrd);
        pw_re[i] = m2 * c2; pw_im[i] = m2 * s2; }
    for (int i = tid; i < 1024; i += 512) { const int ci_ = (i >> 6) * CP + (i & 63); C_re[ci_] = c_re[(dir * 32 + g) * 1024 + i]; C_im[ci_] = c_im[(dir * 32 + g) * 1024 + i];
        if (dir == 0) { C2_re[i] = c_re[(32 + g) * 1024 + i]; C2_im[i] = c_im[(32 + g) * 1024 + i]; } }
    __syncthreads();
    { const int tau = tid >> 5, chp = (tid >> 1) & 15, ch0 = (tid & 1) * 8; f32x4 a0 = {0.f, 0.f, 0.f, 0.f}, a1 = {0.f, 0.f, 0.f, 0.f};
#pragma unroll 2
      for (int p = 0; p < 64; p += 4) { const f32x4 cr = *(const LAS f32x4*)(C_re + chp * CP + p), ci = *(const LAS f32x4*)(C_im + chp * CP + p), wr_ = *(const LAS f32x4*)(pw_re + tau * 64 + p), wi = *(const LAS f32x4*)(pw_im + tau * 64 + p);
          const f32x4 tr = cr * wr_ - ci * wi, ti = cr * wi + ci * wr_;
#pragma unroll
          for (int q = 0; q < 4; ++q) { const LAS float* br = Bb_re + (p + q) * 16 + ch0; const LAS float* bi = Bb_im + (p + q) * 16 + ch0;
              a0 += tr[q] * *(const LAS f32x4*)br - ti[q] * *(const LAS f32x4*)bi; a1 += tr[q] * *(const LAS f32x4*)(br + 4) - ti[q] * *(const LAS f32x4*)(bi + 4); } }
      *(LAS f32x4*)(Kt + tau * 256 + chp * 16 + ch0) = a0; *(LAS f32x4*)(Kt + tau * 256 + chp * 16 + ch0 + 4) = a1; }
    if (dir == 0 && tid < 256) { const int chp = tid >> 4, ch = tid & 15; float acc = 0.f;
#pragma unroll 4
        for (int p = 0; p < 64; ++p) acc += C2_re[chp * 64 + p] * Bb2_re[p * 16 + ch] - C2_im[chp * 64 + p] * Bb2_im[p * 16 + ch];
        K0o[tid] = acc + (chp == ch ? s5d[g * 16 + ch] : 0.f); }
    __syncthreads();
    bf16_t* Wg = Wcat + (size_t)g * 256 * 512;
#pragma unroll 1
    for (int j = 0; j < 16; ++j) { const int q = tid + 512 * j, n = q >> 5, kc = q & 31, s = kc >> 1, ch0 = (kc & 1) * 8, t = n >> 4, chp = n & 15;
        const bool mine = (dir == 0) ? (s <= t) : (s > t);
        if (mine) { float v[8]; const int tau = (dir == 0) ? (t - s) : (s - t);
#pragma unroll
            for (int i = 0; i < 8; ++i) { v[i] = Kt[tau * 256 + chp * 16 + ch0 + i]; if (tau == 0) v[i] += K0o[chp * 16 + ch0 + i]; }
            u32x4 o; o.x = pk2(v[0], v[1]); o.y = pk2(v[2], v[3]); o.z = pk2(v[4], v[5]); o.w = pk2(v[6], v[7]);
            *(u32x4*)(Wg + (size_t)n * 512 + kc * 8) = o; } }
#pragma unroll 1
    for (int j = 0; j < 8; ++j) { const int q = tid + 512 * j, n = q >> 4, pc = q & 15, ri = pc >> 3, p0 = (pc & 7) * 8, t = n >> 4, chp = n & 15, e = (dir == 0) ? (t + 1) : (16 - t);
        float v[8];
#pragma unroll
        for (int i = 0; i < 8; ++i) { const int p = p0 + i; const float cr = C_re[chp * CP + p], ci = C_im[chp * CP + p], wr_ = pw_re[e * 64 + p], wi = pw_im[e * 64 + p];
            v[i] = (ri == 0) ? (cr * wr_ - ci * wi) : -(cr * wi + ci * wr_); }
        u32x4 o; o.x = pk2(v[0], v[1]); o.y = pk2(v[2], v[3]); o.z = pk2(v[4], v[5]); o.w = pk2(v[6], v[7]);
        *(u32x4*)(Wg + (size_t)n * 512 + 256 + dir * 128 + ri * 64 + p0) = o; }
    bf16_t* Bg = Bcat + (size_t)g * 256 * 256;
#pragma unroll 1
    for (int j = 0; j < 8; ++j) { const int q = tid + 512 * j, nl = q >> 5, ri = nl >> 6, p = nl & 63, kc = q & 31, s = kc >> 1, ch0 = (kc & 1) * 8, e = (dir == 0) ? (15 - s) : s;
        const float wr_ = pw_re[e * 64 + p], wi = pw_im[e * 64 + p]; float v[8];
#pragma unroll
        for (int i = 0; i < 8; ++i) { const float br = Bb_re[p * 16 + ch0 + i], bi = Bb_im[p * 16 + ch0 + i]; v[i] = (ri == 0) ? (wr_ * br - wi * bi) : (wr_ * bi + wi * br); }
        u32x4 o; o.x = pk2(v[0], v[1]); o.y = pk2(v[2], v[3]); o.z = pk2(v[4], v[5]); o.w = pk2(v[6], v[7]);
        *(u32x4*)(Bg + (size_t)(dir * 128 + nl) * 256 + kc * 8) = o; }
    __syncthreads();
}

struct SchedWin { int i, G, c; const char* A; const char* B;
    __device__ __forceinline__ bool next(Unit& u) { const int L = i * G + c; ++i; int pn, b;
        if (L < 2048) { int pm; map_tile(L, 128, 16, pm, pn); b = pm >> 4; u.r0 = (b * 17 + 1 + (pm & 15)) * 256; }
        else if (L < 2096) { const int l = L - 2048, s = l % 6; b = l / 6; pn = s < 2 ? s : s + 2; u.r0 = b * 17 * 256; }
        else return false;
        u.c0 = pn * 256; u.aux = b; u.a = A + (size_t)u.r0 * 2048; u.b = B + (size_t)u.c0 * 2048; return true; } };
struct EpiWin { static constexpr bool PERM = true;
    bf16_t *UH, *Q, *K, *V, *G; const float* rope;
    __device__ __forceinline__ static u32x4 pk8(const f32x4& v0, const f32x4& v1) { u32x4 w; w.x = cvt_pk_bf16(v0[0], v0[1]); w.y = cvt_pk_bf16(v0[2], v0[3]); w.z = cvt_pk_bf16(v1[0], v1[1]); w.w = cvt_pk_bf16(v1[2], v1[3]); return w; }
    __device__ __forceinline__ bool operator()(f32x4 (&acc)[2][2][4][2], const Unit& u, int wr, int wc, int fr, int fq) const {
        const int pn = u.c0 >> 8, b = u.aux, tt0 = u.r0 - b * LT;
        if (pn < 2) {
#pragma unroll
            for (int ai = 0; ai < 2; ++ai)
#pragma unroll
                for (int m = 0; m < 4; ++m) { const int tt = tt0 + ai * 128 + wr * 64 + m * 16 + fr;
#pragma unroll
                    for (int bj = 0; bj < 2; ++bj) { const int c = u.c0 + bj * 128 + wc * 32 + 8 * fq, g = c >> 4, half = (c >> 3) & 1;
                        *(u32x4*)(UH + (((size_t)(b * 32 + g) * NCH + (tt >> 4)) * 512 + (tt & 15) * 16 + half * 8)) = pk8(acc[ai][bj][m][0], acc[ai][bj][m][1]); } }
        } else if (pn < 6) { const bool isq = pn < 4; bf16_t* dst0 = (isq ? Q : K); const float sc = isq ? QSCALE : 1.0f;
            if (tt0 >= CL) {
#pragma unroll
                for (int ai = 0; ai < 2; ++ai) { f32x4 cs[4], sn[4]; const bool gi = (wc & 1) != 0;
#pragma unroll
                    for (int m = 0; m < 4; ++m) { const int t = tt0 + ai * 128 + wr * 64 + m * 16 + fr - CL; const float* rp = rope + (gi ? (t & 63) : (t >> 6)) * 32 + 4 * fq;
                        cs[m] = *(const f32x4*)rp; sn[m] = *(const f32x4*)(rp + 16); }
                    __builtin_amdgcn_sched_barrier(0);
#pragma unroll
                    for (int m = 0; m < 4; ++m) { const size_t r = (size_t)u.r0 + ai * 128 + wr * 64 + m * 16 + fr;
#pragma unroll
                        for (int bj = 0; bj < 2; ++bj) { const int c = u.c0 + bj * 128 + wc * 32 + 8 * fq, cq = (c - 512) & 511; const f32x4 v0 = acc[ai][bj][m][0], v1 = acc[ai][bj][m][1];
                            *(u32x4*)(dst0 + r * 512 + cq) = pk8((v0 * cs[m] - v1 * sn[m]) * sc, (v1 * cs[m] + v0 * sn[m]) * sc); } } }
            } else {
#pragma unroll
                for (int ai = 0; ai < 2; ++ai)
#pragma unroll
                    for (int m = 0; m < 4; ++m) { const size_t r = (size_t)u.r0 + ai * 128 + wr * 64 + m * 16 + fr;
#pragma unroll
                        for (int bj = 0; bj < 2; ++bj) { const int c = u.c0 + bj * 128 + wc * 32 + 8 * fq, cq = (c - 512) & 511;
                            *(u32x4*)(dst0 + r * 512 + cq) = pk8(acc[ai][bj][m][0], acc[ai][bj][m][1]); } } }
        } else if (pn < 8) {
#pragma unroll
            for (int ai = 0; ai < 2; ++ai)
#pragma unroll
                for (int m = 0; m < 4; ++m) { const size_t r = (size_t)u.r0 + ai * 128 + wr * 64 + m * 16 + fr;
#pragma unroll
                    for (int bj = 0; bj < 2; ++bj) { const int c = u.c0 + bj * 128 + wc * 32 + 8 * fq; *(u32x4*)(V + r * 512 + (c - 1536)) = pk8(acc[ai][bj][m][0], acc[ai][bj][m][1]); } }
        } else { const int lt = b * 16 + (tt0 >> 8) - 1;
#pragma unroll
            for (int ai = 0; ai < 2; ++ai)
#pragma unroll
                for (int m = 0; m < 4; ++m)
#pragma unroll
                    for (int bj = 0; bj < 2; ++bj) { f32x4 v0 = acc[ai][bj][m][0], v1 = acc[ai][bj][m][1];
#pragma unroll
                        for (int j = 0; j < 4; ++j) { v0[j] = sigmoidf_(v0[j]); v1[j] = sigmoidf_(v1[j]); }
                        *(u32x4*)(G + (((((((size_t)(lt * 8 + (pn - 8)) * 2 + ai) * 4 + m) * 2 + bj) * 8 + (wr * 4 + wc)) * 64 + (fq * 16 + fr)) * 8)) = pk8(v0, v1); } }
        return true; } };

struct SchedS5a { int i, G, c; const char* UH; const char* Bcat;
    __device__ __forceinline__ bool next(Unit& u) { const int L = i * G + c; ++i; if (L >= 512) return false; const int bg = L >> 1, row0 = (L & 1) * 16;
        u.r0 = bg * NCH + row0; u.c0 = 0; u.aux = 0; u.a = UH + (size_t)u.r0 * 1024; u.b = Bcat + (size_t)(bg & 31) * 256 * 256 * 2; return true; } };
struct EpiS5a { static constexpr bool PERM = false; float* S;
    __device__ __forceinline__ bool operator()(f32x4 (&acc)[2][2][4][2], const Unit& u, int wr, int wc, int fr, int fq) const {
#pragma unroll
        for (int ai = 0; ai < 2; ++ai)
#pragma unroll
            for (int m = 0; m < 4; ++m) { float* rowp = S + ((size_t)u.r0 + ai * 128 + wr * 64 + m * 16 + fr) * 256 + wc * 32 + 4 * fq;
#pragma unroll
                for (int bj = 0; bj < 2; ++bj)
#pragma unroll
                    for (int n = 0; n < 2; ++n) *(f32x4*)(rowp + bj * 128 + n * 16) = acc[ai][bj][m][n]; }
        return true; } };

struct SchedS5aB { int i, bg; const char* UH; const char* Bcat;
    __device__ __forceinline__ bool next(Unit& u) { if (i >= 2) return false; const int row0 = i * 16; ++i;
        u.r0 = bg * NCH + row0; u.c0 = 0; u.aux = 0; u.a = UH + (size_t)u.r0 * 1024; u.b = Bcat + (size_t)(bg & 31) * 256 * 256 * 2; return true; } };
struct SchedS5cB { int i, bg; const char* UH; const char* Wcat;
    __device__ __forceinline__ bool next(Unit& u) { if (i >= 1) return false; ++i;
        u.r0 = (bg >> 5) * SEQ; u.c0 = 0; u.aux = bg & 31; u.a = UH + ((size_t)bg * NCH + 16) * 1024; u.b = Wcat + (size_t)(bg & 31) * 256 * 512 * 2; return true; } };
struct SchedS5c { int i, G, c; const char* UH; const char* Wcat;
    __device__ __forceinline__ bool next(Unit& u) { const int L = i * G + c; ++i; if (L >= 256) return false; const int bg = L;
        u.r0 = (bg >> 5) * SEQ; u.c0 = 0; u.aux = bg & 31; u.a = UH + ((size_t)bg * NCH + 16) * 1024; u.b = Wcat + (size_t)(bg & 31) * 256 * 512 * 2; return true; } };
struct EpiS5c { static constexpr bool PERM = true; bf16_t* YA;
    __device__ __forceinline__ bool operator()(f32x4 (&acc)[2][2][4][2], const Unit& u, int wr, int wc, int fr, int fq) const {
#pragma unroll
        for (int ai = 0; ai < 2; ++ai)
#pragma unroll
            for (int m = 0; m < 4; ++m) { const int chunk = ai * 128 + wr * 64 + m * 16 + fr;
#pragma unroll
                for (int bj = 0; bj < 2; ++bj) { const int cl = bj * 128 + wc * 32 + 8 * fq, tok = cl >> 4, half = (cl >> 3) & 1; const f32x4 v0 = acc[ai][bj][m][0], v1 = acc[ai][bj][m][1];
                    u32x4 w; w.x = cvt_pk_bf16(gelu_tanh(v0[0]), gelu_tanh(v0[1])); w.y = cvt_pk_bf16(gelu_tanh(v0[2]), gelu_tanh(v0[3]));
                    w.z = cvt_pk_bf16(gelu_tanh(v1[0]), gelu_tanh(v1[1])); w.w = cvt_pk_bf16(gelu_tanh(v1[2]), gelu_tanh(v1[3]));
                    *(u32x4*)(YA + ((size_t)u.r0 + chunk * 16 + tok) * 512 + u.aux * 16 + half * 8) = w; } }
        return true; } };

struct SchedGlu { int i, G, c; const char* YA; const char* W;
    __device__ __forceinline__ bool next(Unit& u) { const int L = i * G + c; ++i; if (L >= 256) return false; int pm, pn; map_tile(L, 128, 2, pm, pn);
        u.r0 = pm * 256; u.c0 = pn * 256; u.aux = 0; u.a = YA + (size_t)u.r0 * 1024; u.b = W + (size_t)u.c0 * 1024; return true; } };
struct EpiGlu { static constexpr bool PERM = true; const bf16_t* YA; bf16_t* YY;
    __device__ __forceinline__ bool operator()(f32x4 (&acc)[2][2][4][2], const Unit& u, int wr, int wc, int fr, int fq) const {
#pragma unroll
        for (int ai = 0; ai < 2; ++ai)
#pragma unroll
            for (int m = 0; m < 4; ++m) { const size_t r = (size_t)u.r0 + ai * 128 + wr * 64 + m * 16 + fr;
#pragma unroll
                for (int bj = 0; bj < 2; ++bj) { const int c = u.c0 + bj * 128 + wc * 32 + 8 * fq; const f32x4 v0 = acc[ai][bj][m][0], v1 = acc[ai][bj][m][1];
                    const u32x4 a = *(const u32x4*)(YA + r * 512 + c); u32x4 w;
                    w.x = cvt_pk_bf16(bf_lo(a.x) * sigmoidf_(v0[0]), bf_hi(a.x) * sigmoidf_(v0[1])); w.y = cvt_pk_bf16(bf_lo(a.y) * sigmoidf_(v0[2]), bf_hi(a.y) * sigmoidf_(v0[3]));
                    w.z = cvt_pk_bf16(bf_lo(a.z) * sigmoidf_(v1[0]), bf_hi(a.z) * sigmoidf_(v1[1])); w.w = cvt_pk_bf16(bf_lo(a.w) * sigmoidf_(v1[2]), bf_hi(a.w) * sigmoidf_(v1[3]));
                    *(u32x4*)(YY + r * 1024 + c) = w; } }
        return true; } };

struct SchedProj { int i, G, c, part, pm, pn; const char* YY; const char* WA; const char* WB;
    __device__ __forceinline__ bool next(Unit& u) {
        if (part == 0) { const int L = i * G + c; if (L >= 512) return false; map_tile(L, 128, 4, pm, pn); }
        u.r0 = pm * 256; u.c0 = pn * 256; u.aux = part; u.a = YY + (size_t)u.r0 * 2048 + (part ? 1024 : 0); u.b = (part ? WB : WA) + (size_t)u.c0 * 1024;
        if (part) ++i; part ^= 1; return true; } };
struct EpiProj { static constexpr bool PERM = true; const bf16_t* G; bf16_t* M;
    __device__ __forceinline__ bool operator()(f32x4 (&acc)[2][2][4][2], const Unit& u, int wr, int wc, int fr, int fq) const {
        const bf16_t* gt = G + (unsigned)(((u.r0 >> 8) * 8 + (u.c0 >> 8)) * 65536 + (wr * 4 + wc) * 512 + (fq * 16 + fr) * 8);
        if (u.aux == 0) {
#pragma unroll
            for (int ai = 0; ai < 2; ++ai) { u32x4 ga[4][2], gb[4][2];
#pragma unroll
                for (int m = 0; m < 4; ++m)
#pragma unroll
                    for (int bj = 0; bj < 2; ++bj) { const unsigned go = (unsigned)((((ai * 4 + m) * 2 + bj) * 8) * 512); ga[m][bj] = *(const u32x4*)(gt + go); gb[m][bj] = *(const u32x4*)(gt + go + 4 * 65536); }
                __builtin_amdgcn_sched_barrier(0);
#pragma unroll
                for (int m = 0; m < 4; ++m)
#pragma unroll
                    for (int bj = 0; bj < 2; ++bj) { f32x4& v0 = acc[ai][bj][m][0]; f32x4& v1 = acc[ai][bj][m][1]; const u32x4 a = ga[m][bj], b = gb[m][bj];
                        const float sa[8] = {bf_lo(a.x), bf_hi(a.x), bf_lo(a.y), bf_hi(a.y), bf_lo(a.z), bf_hi(a.z), bf_lo(a.w), bf_hi(a.w)};
                        const float sb[8] = {bf_lo(b.x), bf_hi(b.x), bf_lo(b.y), bf_hi(b.y), bf_lo(b.z), bf_hi(b.z), bf_lo(b.w), bf_hi(b.w)};
#pragma unroll
                        for (int j = 0; j < 4; ++j) { v0[j] *= sa[j] * __builtin_amdgcn_rcpf(fmaxf(sb[j], 1e-20f)); v1[j] *= sa[4 + j] * __builtin_amdgcn_rcpf(fmaxf(sb[4 + j], 1e-20f)); } }
                asm volatile("" ::: "memory"); }
            return false; }
#pragma unroll
        for (int ai = 0; ai < 2; ++ai) { u32x4 gb[4][2];
#pragma unroll
            for (int m = 0; m < 4; ++m)
#pragma unroll
                for (int bj = 0; bj < 2; ++bj) gb[m][bj] = *(const u32x4*)(gt + (unsigned)((((ai * 4 + m) * 2 + bj) * 8) * 512) + 4 * 65536);
            __builtin_amdgcn_sched_barrier(0);
#pragma unroll
            for (int m = 0; m < 4; ++m) { const size_t r = (size_t)u.r0 + ai * 128 + wr * 64 + m * 16 + fr;
#pragma unroll
                for (int bj = 0; bj < 2; ++bj) { const int c = u.c0 + bj * 128 + wc * 32 + 8 * fq; const f32x4 v0 = acc[ai][bj][m][0], v1 = acc[ai][bj][m][1]; const u32x4 b = gb[m][bj];
                    const float sb[8] = {fmaxf(bf_lo(b.x), 1e-20f), fmaxf(bf_hi(b.x), 1e-20f), fmaxf(bf_lo(b.y), 1e-20f), fmaxf(bf_hi(b.y), 1e-20f), fmaxf(bf_lo(b.z), 1e-20f), fmaxf(bf_hi(b.z), 1e-20f), fmaxf(bf_lo(b.w), 1e-20f), fmaxf(bf_hi(b.w), 1e-20f)};
                    u32x4 w; w.x = cvt_pk_bf16(v0[0] * sb[0], v0[1] * sb[1]); w.y = cvt_pk_bf16(v0[2] * sb[2], v0[3] * sb[3]);
                    w.z = cvt_pk_bf16(v1[0] * sb[4], v1[1] * sb[5]); w.w = cvt_pk_bf16(v1[2] * sb[6], v1[3] * sb[7]);
                    *(u32x4*)(M + r * 1024 + c) = w; } }
            asm volatile("" ::: "memory"); }
        return true; } };

struct SchedOut { int i, G, c; const char* M; const char* W;
    __device__ __forceinline__ bool next(Unit& u) { const int L = i * G + c; ++i; if (L >= 512) return false; int pm, pn; map_tile(L, 128, 4, pm, pn);
        u.r0 = pm * 256; u.c0 = pn * 256; u.aux = 0; u.a = M + (size_t)u.r0 * 2048; u.b = W + (size_t)u.c0 * 2048; return true; } };
struct EpiOut { static constexpr bool PERM = true; bf16_t* O;
    __device__ __forceinline__ bool operator()(f32x4 (&acc)[2][2][4][2], const Unit& u, int wr, int wc, int fr, int fq) const {
#pragma unroll
        for (int ai = 0; ai < 2; ++ai)
#pragma unroll
            for (int m = 0; m < 4; ++m) { const size_t r = (size_t)u.r0 + ai * 128 + wr * 64 + m * 16 + fr;
#pragma unroll
                for (int bj = 0; bj < 2; ++bj) { const int c = u.c0 + bj * 128 + wc * 32 + 8 * fq; const f32x4 v0 = acc[ai][bj][m][0], v1 = acc[ai][bj][m][1];
                    u32x4 w; w.x = cvt_pk_bf16(v0[0], v0[1]); w.y = cvt_pk_bf16(v0[2], v0[3]); w.z = cvt_pk_bf16(v1[0], v1[1]); w.w = cvt_pk_bf16(v1[2], v1[3]);
                    *(u32x4*)(O + r * 1024 + c) = w; } }
        return true; } };

constexpr float WSCALE = 32.0f, HSCALE = 4.0f;
struct SchedUp { int i, G, c; const char* XS; const char* W;
    __device__ __forceinline__ bool next(Unit& u) { const int L = i * G + c; ++i; if (L >= 4096) return false; const int e = L >> 8; int pm, pn; map_tile(L & 255, 16, 16, pm, pn);
        u.r0 = e * 4096 + pm * 256; u.c0 = pn * 128; u.aux = e; u.a = XS + (size_t)u.r0 * 1024; u.b = W + ((size_t)e * 4096 + pn * 256) * 1024; return true; } };
struct EpiUp { static constexpr bool PERM = true; unsigned char* HID;
    __device__ __forceinline__ bool operator()(f32x4 (&acc)[2][2][4][2], const Unit& u, int wr, int wc, int fr, int fq) const {
        const float s = 1.0f / WSCALE;
#pragma unroll
        for (int ai = 0; ai < 2; ++ai)
#pragma unroll
            for (int m = 0; m < 4; ++m) { const size_t r = (size_t)u.r0 + ai * 128 + wr * 64 + m * 16 + fr;
#pragma unroll
                for (int bj = 0; bj < 2; ++bj) { const int c = u.c0 + bj * 64 + wc * 16 + 4 * fq; const f32x4 g = acc[ai][bj][m][0] * s, up = acc[ai][bj][m][1] * (s * HSCALE);
                    *(unsigned*)(HID + r * 2048 + c) = pk_fp8x4(g[0] * sigmoidf_(g[0]) * up[0], g[1] * sigmoidf_(g[1]) * up[1], g[2] * sigmoidf_(g[2]) * up[2], g[3] * sigmoidf_(g[3]) * up[3]); } }
        return true; } };

struct SchedDown { int i, G, c; const char* HID; const char* W;
    __device__ __forceinline__ bool next(Unit& u) { const int L = i * G + c; ++i; if (L >= 1024) return false; const int e = L >> 6; int pm, pn; map_tile(L & 63, 16, 4, pm, pn);
        u.r0 = e * 4096 + pm * 256; u.c0 = pn * 256; u.aux = e; u.a = HID + (size_t)u.r0 * 2048; u.b = W + ((size_t)e * 1024 + pn * 256) * 2048; return true; } };
constexpr float YSCALE = 64.0f;
struct EpiDown { static constexpr bool PERM = true; const float* GATEV; unsigned char* YS;
    __device__ __forceinline__ bool operator()(f32x4 (&acc)[2][2][4][2], const Unit& u, int wr, int wc, int fr, int fq) const {
#pragma unroll
        for (int ai = 0; ai < 2; ++ai)
#pragma unroll
            for (int m = 0; m < 4; ++m) { const size_t r = (size_t)u.r0 + ai * 128 + wr * 64 + m * 16 + fr; const float gt = GATEV[r] * (YSCALE / (WSCALE * HSCALE));
#pragma unroll
                for (int bj = 0; bj < 2; ++bj) { const int c = u.c0 + bj * 128 + wc * 32 + 8 * fq; const f32x4 v0 = acc[ai][bj][m][0] * gt, v1 = acc[ai][bj][m][1] * gt;
                    u32x2 w; w.x = pk_fp8x4(v0[0], v0[1], v0[2], v0[3]); w.y = pk_fp8x4(v1[0], v1[1], v1[2], v1[3]);
                    *(u32x2*)(YS + r * 1024 + c) = w; } }
        return true; } };

__device__ __forceinline__ void ld_row(const float* p, int lane, f32x4 (&v)[4]) {
#pragma unroll
    for (int j = 0; j < 4; ++j) v[j] = *(const f32x4*)(p + lane * 4 + 256 * j);
}
__device__ __forceinline__ float sumsq(const f32x4 (&v)[4]) { float s = 0.f;
#pragma unroll
    for (int j = 0; j < 4; ++j) s += (v[j][0] * v[j][0] + v[j][1] * v[j][1]) + (v[j][2] * v[j][2] + v[j][3] * v[j][3]);
    return wave_sum(s); }

template <int NR> __device__ __forceinline__ void rp1_rows(const Args& A, const float* MOD, bf16_t* HN, int r0, int lane, const f32x4 (&w)[4]) {
    f32x4 v[NR][4], sh[NR][4], sc[NR][4];
#pragma unroll
    for (int q = 0; q < NR; ++q) { const int r = r0 + q, b = r / LT, tt = r - b * LT;
        const float* src = tt < CL ? A.in[I_CTX] + ((size_t)b * CL + tt) * DM : A.in[I_X] + ((size_t)b * SEQ + (tt - CL)) * DM;
        const float* mrow = MOD + (tt < CL ? 8 : b) * 6144;
        ld_row(src, lane, v[q]); ld_row(mrow, lane, sh[q]); ld_row(mrow + 1024, lane, sc[q]); }
#pragma unroll
    for (int q = 0; q < NR; ++q) { const float rstd = rsqrtf(sumsq(v[q]) * (1.0f / DM) + EPS);
#pragma unroll
        for (int j = 0; j < 4; ++j) { const f32x4 h = v[q][j] * rstd * w[j] * (sc[q][j] + 1.0f) + sh[q][j];
            u32x2 o; o.x = cvt_pk_bf16(h[0], h[1]); o.y = cvt_pk_bf16(h[2], h[3]); *(u32x2*)(HN + (size_t)(r0 + q) * DM + lane * 4 + 256 * j) = o; } }
}
template <int NR> __device__ __forceinline__ void rp1_lat(const float* X, bf16_t* HN, size_t xrow0, size_t hrow0, int lane, const f32x4 (&c)[4], const f32x4 (&sh)[4]) {
    f32x4 v[NR][4];
#pragma unroll
    for (int q = 0; q < NR; ++q) ld_row(X + (xrow0 + q) * DM, lane, v[q]);
#pragma unroll
    for (int q = 0; q < NR; ++q) { const float rstd = rsqrtf(sumsq(v[q]) * (1.0f / DM) + EPS);
#pragma unroll
        for (int j = 0; j < 4; ++j) { const f32x4 h = v[q][j] * rstd * c[j] + sh[j];
            u32x2 o; o.x = cvt_pk_bf16(h[0], h[1]); o.y = cvt_pk_bf16(h[2], h[3]); *(u32x2*)(HN + (hrow0 + q) * DM + lane * 4 + 256 * j) = o; } }
}
template <int NR> __device__ __forceinline__ void rp1_load(const float* X, size_t xrow0, int lane, f32x4 (&v)[4][4]) {
#pragma unroll
    for (int q = 0; q < NR; ++q) ld_row(X + (xrow0 + q) * DM, lane, v[q]);
}
template <int NR> __device__ __forceinline__ void rp1_proc(f32x4 (&v)[4][4], bf16_t* HN, size_t hrow0, int lane, const f32x4 (&c)[4], const f32x4 (&sh)[4]) {
#pragma unroll
    for (int q = 0; q < NR; ++q) { const float rstd = rsqrtf(sumsq(v[q]) * (1.0f / DM) + EPS);
#pragma unroll
        for (int j = 0; j < 4; ++j) { const f32x4 h = v[q][j] * rstd * c[j] + sh[j];
            u32x2 o; o.x = cvt_pk_bf16(h[0], h[1]); o.y = cvt_pk_bf16(h[2], h[3]); *(u32x2*)(HN + (hrow0 + q) * DM + lane * 4 + 256 * j) = o; } }
}
__device__ __forceinline__ void row_pass1(const Args& A, const float* MOD, bf16_t* HN, int gw, int ngw, int lane) {
    f32x4 w[4]; ld_row(A.in[I_NPREMIX], lane, w);
    const int per = (MR + ngw - 1) / ngw, r0 = gw * per, r1 = min(MR, r0 + per);
    const int b0 = r0 / LT, tt0 = r0 - b0 * LT, b1 = (r1 - 1) / LT;
    if (r0 < r1 && tt0 >= CL && b0 == b1) {
        f32x4 c[4], sh[4]; { f32x4 sc[4]; ld_row(MOD + b0 * 6144, lane, sh); ld_row(MOD + b0 * 6144 + 1024, lane, sc);
#pragma unroll
            for (int j = 0; j < 4; ++j) c[j] = w[j] * (sc[j] + 1.0f); }
        int r = r0;
        if (r1 - r0 == 17) {
            const float* X = A.in[I_X]; const size_t x0 = (size_t)b0 * SEQ + (r0 - b0 * LT - CL); f32x4 va[4][4], vb[4][4];
            rp1_load<4>(X, x0, lane, va); rp1_load<4>(X, x0 + 4, lane, vb);
            rp1_proc<4>(va, HN, (size_t)r0, lane, c, sh); rp1_load<4>(X, x0 + 8, lane, va);
            rp1_proc<4>(vb, HN, (size_t)r0 + 4, lane, c, sh); rp1_load<4>(X, x0 + 12, lane, vb);
            rp1_proc<4>(va, HN, (size_t)r0 + 8, lane, c, sh); rp1_load<1>(X, x0 + 16, lane, va);
            rp1_proc<4>(vb, HN, (size_t)r0 + 12, lane, c, sh);
            rp1_proc<1>(va, HN, (size_t)r0 + 16, lane, c, sh);
            r = r1; }
        for (; r + 4 <= r1; r += 4) rp1_lat<4>(A.in[I_X], HN, (size_t)b0 * SEQ + (r - b0 * LT - CL), (size_t)r, lane, c, sh);
        for (; r < r1; ++r) rp1_lat<1>(A.in[I_X], HN, (size_t)b0 * SEQ + (r - b0 * LT - CL), (size_t)r, lane, c, sh);
    } else {
        int r = r0;
        for (; r + 2 <= r1; r += 2) rp1_rows<2>(A, MOD, HN, r, lane, w);
        if (r < r1) rp1_rows<1>(A, MOD, HN, r, lane, w);
    }
}

__device__ __forceinline__ float reduce16(const float (&v)[16], int lane) {
    float a[8], b4[4], c[2];
    const bool h3 = (lane & 8) != 0, h2 = (lane & 4) != 0;
#pragma unroll
    for (int i = 0; i < 8; ++i) a[i] = swap32_sum(v[i], v[8 + i]);
#pragma unroll
    for (int i = 0; i < 4; ++i) b4[i] = swap16_sum(a[i], a[4 + i]);
#pragma unroll
    for (int i = 0; i < 2; ++i) { const float keep = h3 ? b4[2 + i] : b4[i], send = h3 ? b4[i] : b4[2 + i]; c[i] = keep + dpp_f<DPP_ROR8>(send); }
    const float keep = h2 ? c[1] : c[0], send = h2 ? c[0] : c[1]; float d = keep + dpp_f<DPP_HMIRROR>(send);
    d += dpp_f<DPP_XOR2>(d); d += dpp_f<DPP_XOR1>(d); return d;
}

__device__ __forceinline__ void ld_row_bf(const bf16_t* p, int lane, f32x4 (&v)[4]) {
#pragma unroll
    for (int j = 0; j < 4; ++j) { const u32x2 w = *(const u32x2*)(p + lane * 4 + 256 * j); v[j] = (f32x4){bf_lo(w.x), bf_hi(w.x), bf_lo(w.y), bf_hi(w.y)}; }
}
__device__ __forceinline__ void row_pass2(const Args& A, const float* MOD, const bf16_t* OB, bf16_t* X1, unsigned char* H2, float* AFF, LAS float* WR, int gw, int ngw, int lane) {
    const int per = (ML + ngw - 1) / ngw;
    const int b = (gw * per) >> 12; const float* mrow = MOD + b * 6144;
    const int rbeg = gw * per, rend = min(ML, (gw + 1) * per);
    f32x4 o[4], x[4];
    if (rbeg < rend) { ld_row_bf(OB + (size_t)rbeg * DM, lane, o); ld_row(A.in[I_X] + (size_t)rbeg * DM, lane, x); }
#pragma unroll 1
    for (int r = rbeg; r < rend; ++r) { const int t = r & 4095;
        f32x4 on[4], xn[4];
        { const int rn = (r + 1 < rend) ? r + 1 : r; ld_row_bf(OB + (size_t)rn * DM, lane, on); ld_row(A.in[I_X] + (size_t)rn * DM, lane, xn); }
        const float rs0 = rsqrtf(sumsq(o) * (1.0f / DM) + EPS);
#pragma unroll
        for (int j = 0; j < 4; ++j) { const f32x4 wpost = *(const f32x4*)(A.in[I_NPOSTMIX] + lane * 4 + 256 * j), gm = *(const f32x4*)(mrow + 2048 + lane * 4 + 256 * j);
            x[j] = x[j] + gm * wpost * (o[j] * rs0); u32x2 xb; xb.x = cvt_pk_bf16(x[j][0], x[j][1]); xb.y = cvt_pk_bf16(x[j][2], x[j][3]); *(u32x2*)(X1 + (size_t)r * DM + lane * 4 + 256 * j) = xb; }
        const float rs1 = rsqrtf(sumsq(x) * (1.0f / DM) + EPS);
        int woff = lane * 4; asm volatile("" : "+v"(woff) : "v"(rs1));
        f32x2 lg2[16];
#pragma unroll
        for (int e = 0; e < 16; ++e) lg2[e] = (f32x2){0.f, 0.f};
#pragma unroll
        for (int j = 0; j < 4; ++j) {
            const f32x4 wpre = *(const f32x4*)(A.in[I_NPREFFN] + lane * 4 + 256 * j), sc = *(const f32x4*)(mrow + 4096 + lane * 4 + 256 * j), sh = *(const f32x4*)(mrow + 3072 + lane * 4 + 256 * j);
            const f32x4 h = x[j] * rs1 * wpre * (sc + 1.0f) + sh;
            *(unsigned*)(H2 + (size_t)r * DM + lane * 4 + 256 * j) = pk_fp8x4(h[0], h[1], h[2], h[3]);
#pragma unroll
            for (int e = 0; e < 16; ++e) { const f32x4 ww = *(const LAS f32x4*)(WR + e * 1024 + woff + 256 * j);
                lg2[e] = __builtin_elementwise_fma((f32x2){h[0], h[1]}, (f32x2){ww[0], ww[1]}, lg2[e]); lg2[e] = __builtin_elementwise_fma((f32x2){h[2], h[3]}, (f32x2){ww[2], ww[3]}, lg2[e]); }
            asm volatile("" : "+v"(woff), "+v"(lg2[15]));
        }
        float lg[16];
#pragma unroll
        for (int e = 0; e < 16; ++e) lg[e] = lg2[e][0] + lg2[e][1];
        const float lgt = reduce16(lg, lane);
        float mx = lgt; mx = fmaxf(mx, dpp_f<DPP_HMIRROR>(mx)); mx = fmaxf(mx, dpp_f<DPP_MIRROR>(mx));
        { auto r = __builtin_amdgcn_permlane16_swap(__float_as_uint(mx), __float_as_uint(mx), false, false); mx = fmaxf(__uint_as_float(r[0]), __uint_as_float(r[1])); }
        { auto r = __builtin_amdgcn_permlane32_swap(__float_as_uint(mx), __float_as_uint(mx), false, false); mx = fmaxf(__uint_as_float(r[0]), __uint_as_float(r[1])); }
        const float ex = expf(lgt - mx); float se = ex; se += dpp_f<DPP_HMIRROR>(se); se += dpp_f<DPP_MIRROR>(se); se = swap16_sum(se, se); se = swap32_sum(se, se);
        const int e = ((lane >> 5) & 1) * 8 + ((lane >> 4) & 1) * 4 + ((lane >> 3) & 1) * 2 + ((lane >> 2) & 1);
        if ((lane & 3) == 0) AFF[((size_t)b * NE + e) * SEQ + t] = ex / se;
#pragma unroll
        for (int j = 0; j < 4; ++j) { o[j] = on[j]; x[j] = xn[j]; }
    }
}

__device__ __forceinline__ void fp8x4_add(unsigned w, float s, float* f) {
    typedef float f32x2_ __attribute__((ext_vector_type(2)));
    const f32x2_ lo = __builtin_amdgcn_cvt_pk_f32_fp8((int)w, false), hi = __builtin_amdgcn_cvt_pk_f32_fp8((int)w, true);
    f[0] += s * lo[0]; f[1] += s * lo[1]; f[2] += s * hi[0]; f[3] += s * hi[1]; }
__device__ __forceinline__ void row_final_generic(const Args& A, const float* MOD, const bf16_t* X1, float* OUT, const unsigned char* YS, const int* SLOT, int gw, int ngw, int lane) {
    const int per = (ML + ngw - 1) / ngw;
    for (int r = gw * per; r < min(ML, (gw + 1) * per); ++r) { const int b = r >> 12; const float* mrow = MOD + b * 6144;
        const int myslot = lane < 16 ? SLOT[(size_t)r * 16 + lane] : -1;
        f32x4 x1[4], gf[4], w[4];
#pragma unroll
        for (int j = 0; j < 2; ++j)
#pragma unroll
            for (int q = 0; q < 2; ++q) { const int k = lane * 8 + 512 * j + 4 * q; { const u32x2 w_ = *(const u32x2*)(X1 + (size_t)r * DM + k); x1[2 * j + q] = (f32x4){bf_lo(w_.x), bf_hi(w_.x), bf_lo(w_.y), bf_hi(w_.y)}; } gf[2 * j + q] = *(const f32x4*)(mrow + 5120 + k); w[2 * j + q] = *(const f32x4*)(A.in[I_NPOSTFFN] + k); }
        float f[16];
#pragma unroll
        for (int i = 0; i < 16; ++i) f[i] = 0.f;
        unsigned long long msk = __ballot(myslot >= 0);
        while (msk) { const int e0 = __builtin_ctzll(msk); msk &= msk - 1; const bool two = msk != 0; const int e1 = two ? __builtin_ctzll(msk) : e0; if (two) msk &= msk - 1;
            const int s0 = __builtin_amdgcn_readlane(myslot, e0), s1 = __builtin_amdgcn_readlane(myslot, e1);
            const unsigned char* y0 = YS + ((size_t)e0 * 4096 + b * CAP + s0) * DM; const unsigned char* y1 = YS + ((size_t)e1 * 4096 + b * CAP + s1) * DM;
            u32x2 ya[2], yb[2];
#pragma unroll
            for (int j = 0; j < 2; ++j) { ya[j] = *(const u32x2*)(y0 + lane * 8 + 512 * j); yb[j] = *(const u32x2*)(y1 + lane * 8 + 512 * j); }
            const float m1 = two ? 1.0f : 0.0f;
#pragma unroll
            for (int j = 0; j < 2; ++j) { fp8x4_add(ya[j].x, 1.0f, f + 8 * j); fp8x4_add(ya[j].y, 1.0f, f + 8 * j + 4); fp8x4_add(yb[j].x, m1, f + 8 * j); fp8x4_add(yb[j].y, m1, f + 8 * j + 4); } }
#pragma unroll
        for (int i = 0; i < 16; ++i) f[i] *= (1.0f / YSCALE);
        float ss = 0.f;
#pragma unroll
        for (int i = 0; i < 16; ++i) ss += f[i] * f[i];
        const float rstd = rsqrtf(wave_sum(ss) * (1.0f / DM) + EPS);
#pragma unroll
        for (int j = 0; j < 2; ++j)
#pragma unroll
            for (int q = 0; q < 2; ++q) { const int k = lane * 8 + 512 * j + 4 * q;
                f32x4 fv = {f[8 * j + 4 * q], f[8 * j + 4 * q + 1], f[8 * j + 4 * q + 2], f[8 * j + 4 * q + 3]};
                *(f32x4*)(OUT + (size_t)r * DM + k) = x1[2 * j + q] + gf[2 * j + q] * (fv * rstd * w[2 * j + q]); } }
}
__device__ __forceinline__ void rf_issue(int sl, int r, int b, int lane, const unsigned char* YS, const bf16_t* X1, u32x2 (&ys)[4][2], u32x4 (&xr)[2], float (&mk)[4], unsigned& rest) {
    unsigned m = (unsigned)__ballot(sl >= 0); int e = 0, s = 0;
#pragma unroll
    for (int k = 0; k < 4; ++k) { const bool has = m != 0u; if (has) { e = __builtin_ctz(m); m &= m - 1u; s = __builtin_amdgcn_readlane(sl, e); }
        mk[k] = has ? 1.0f : 0.0f;
        const unsigned char* y = YS + ((size_t)e * 4096 + b * CAP + (s < 0 ? 0 : s)) * DM + lane * 8;
        ys[k][0] = *(const u32x2*)y; ys[k][1] = *(const u32x2*)(y + 512); }
    rest = m;
    xr[0] = *(const u32x4*)(X1 + (size_t)r * DM + lane * 8); xr[1] = *(const u32x4*)(X1 + (size_t)r * DM + 512 + lane * 8);
}
__device__ __forceinline__ void row_final(const Args& A, const float* MOD, const bf16_t* X1, float* OUT, const unsigned char* YS, const int* SLOT, int gw, int ngw, int lane) {
    const int per = (ML + ngw - 1) / ngw, r0 = gw * per, r1 = min(ML, r0 + per);
    if (r0 >= r1) return;
    const int b = r0 >> 12;
    if (((r1 - 1) >> 12) != b) { row_final_generic(A, MOD, X1, OUT, YS, SLOT, gw, ngw, lane); return; }
    const float* mrow = MOD + b * 6144; f32x4 gf[4], w[4];
#pragma unroll
    for (int j = 0; j < 2; ++j)
#pragma unroll
        for (int q = 0; q < 2; ++q) { const int k = lane * 8 + 512 * j + 4 * q; gf[2 * j + q] = *(const f32x4*)(mrow + 5120 + k); w[2 * j + q] = *(const f32x4*)(A.in[I_NPOSTFFN] + k); }
    int slA = lane < 16 ? SLOT[(size_t)r0 * 16 + lane] : -1, slB = lane < 16 ? SLOT[(size_t)min(r0 + 1, r1 - 1) * 16 + lane] : -1;
    u32x2 ysA[4][2]; u32x4 xrA[2]; float mkA[4]; unsigned restA;
    rf_issue(slA, r0, b, lane, YS, X1, ysA, xrA, mkA, restA);
#pragma unroll 1
    for (int r = r0; r < r1; ++r) {
        const int slC = lane < 16 ? SLOT[(size_t)min(r + 2, r1 - 1) * 16 + lane] : -1;
        u32x2 ysB[4][2]; u32x4 xrB[2]; float mkB[4]; unsigned restB;
        rf_issue(slB, min(r + 1, r1 - 1), b, lane, YS, X1, ysB, xrB, mkB, restB);
        float f[16];
#pragma unroll
        for (int i = 0; i < 16; ++i) f[i] = 0.f;
#pragma unroll
        for (int k = 0; k < 4; ++k)
#pragma unroll
            for (int j = 0; j < 2; ++j) { fp8x4_add(ysA[k][j].x, mkA[k], f + 8 * j); fp8x4_add(ysA[k][j].y, mkA[k], f + 8 * j + 4); }
        while (restA) { const int e = __builtin_ctz(restA); restA &= restA - 1u; const int s_ = __builtin_amdgcn_readlane(slA, e);
            const unsigned char* y = YS + ((size_t)e * 4096 + b * CAP + s_) * DM + lane * 8; const u32x2 a0 = *(const u32x2*)y, a1 = *(const u32x2*)(y + 512);
            fp8x4_add(a0.x, 1.0f, f); fp8x4_add(a0.y, 1.0f, f + 4); fp8x4_add(a1.x, 1.0f, f + 8); fp8x4_add(a1.y, 1.0f, f + 12); }
#pragma unroll
        for (int i = 0; i < 16; ++i) f[i] *= (1.0f / YSCALE);
        float ss = 0.f;
#pragma unroll
        for (int i = 0; i < 16; ++i) ss += f[i] * f[i];
        const float rstd = rsqrtf(wave_sum(ss) * (1.0f / DM) + EPS);
#pragma unroll
        for (int j = 0; j < 2; ++j) { const u32x4 xw = xrA[j];
            const f32x4 xa = {bf_lo(xw.x), bf_hi(xw.x), bf_lo(xw.y), bf_hi(xw.y)}, xb = {bf_lo(xw.z), bf_hi(xw.z), bf_lo(xw.w), bf_hi(xw.w)};
            const f32x4 fa = {f[8 * j], f[8 * j + 1], f[8 * j + 2], f[8 * j + 3]}, fb = {f[8 * j + 4], f[8 * j + 5], f[8 * j + 6], f[8 * j + 7]};
            float* op = OUT + (size_t)r * DM + lane * 8 + 512 * j;
            *(f32x4*)op = xa + gf[2 * j] * (fa * rstd * w[2 * j]); *(f32x4*)(op + 4) = xb + gf[2 * j + 1] * (fb * rstd * w[2 * j + 1]); }
#pragma unroll
        for (int k = 0; k < 4; ++k) { ysA[k][0] = ysB[k][0]; ysA[k][1] = ysB[k][1]; mkA[k] = mkB[k]; }
        xrA[0] = xrB[0]; xrA[1] = xrB[1]; restA = restB; slA = slB; slB = slC;
    }
}

__device__ __forceinline__ void yb_combine(const bf16_t* OC, const float* subln, float lam, bf16_t* YY, int gw, int ngw, int lane) {
    float sw[8];
#pragma unroll
    for (int i = 0; i < 8; ++i) sw[i] = subln[(lane & 15) * 8 + i] * 0.8f;
    for (int r = gw; r < ML; r += ngw) {
        const u32x4 a = *(const u32x4*)(OC + (size_t)r * 512 + lane * 8), c = *(const u32x4*)(OC + ((size_t)ML + r) * 512 + lane * 8);
        float d[8] = {bf_lo(a.x) - lam * bf_lo(c.x), bf_hi(a.x) - lam * bf_hi(c.x), bf_lo(a.y) - lam * bf_lo(c.y), bf_hi(a.y) - lam * bf_hi(c.y),
                      bf_lo(a.z) - lam * bf_lo(c.z), bf_hi(a.z) - lam * bf_hi(c.z), bf_lo(a.w) - lam * bf_lo(c.w), bf_hi(a.w) - lam * bf_hi(c.w)};
        float ss = 0.f;
#pragma unroll
        for (int i = 0; i < 8; ++i) ss += d[i] * d[i];
        ss += dpp_f<DPP_XOR1>(ss); ss += dpp_f<DPP_XOR2>(ss); ss += dpp_f<DPP_HMIRROR>(ss); ss += dpp_f<DPP_MIRROR>(ss);
        const float rstd = rsqrtf(ss * (1.0f / 128.0f) + EPS);
        u32x4 w; w.x = cvt_pk_bf16(d[0] * rstd * sw[0], d[1] * rstd * sw[1]); w.y = cvt_pk_bf16(d[2] * rstd * sw[2], d[3] * rstd * sw[3]);
        w.z = cvt_pk_bf16(d[4] * rstd * sw[4], d[5] * rstd * sw[5]); w.w = cvt_pk_bf16(d[6] * rstd * sw[6], d[7] * rstd * sw[7]);
        *(u32x4*)(YY + (size_t)r * 1024 + 512 + lane * 8) = w; }
}

__device__ __forceinline__ void s5_scan(const Args& A, const float* S, bf16_t* UH, int bg) {
    const int tid = threadIdx.x; if (tid >= 128) return;
    const int dir = tid >> 6, p = tid & 63, g = bg & 31, gi = dir * 32 + g;
    const float lr = fminf(A.in[I_LAMRE][gi * 64 + p], -1e-4f), li = A.in[I_LAMIM][gi * 64 + p], dt = expf(A.in[I_LOGDT][gi]);
    float sn, cs; sincos_fast(16.0f * li * dt, &sn, &cs); const float mag = expf(16.0f * lr * dt), ar = mag * cs, aim = mag * sn;
    const float* Sb = S + (size_t)bg * NCH * 256 + dir * 128 + p; bf16_t* Hb = UH + (size_t)bg * NCH * 512 + 256 + dir * 128 + p;
    float hr = 0.f, hi = 0.f;
    for (int i0 = 0; i0 < NCH; i0 += 16) { float sr[16], si[16];
#pragma unroll
        for (int k = 0; k < 16; ++k) { const int i = i0 + k, ch = dir == 0 ? i : (i < 16 ? 15 - i : 287 - i); sr[k] = Sb[(size_t)ch * 256]; si[k] = Sb[(size_t)ch * 256 + 64]; }
#pragma unroll
        for (int k = 0; k < 16; ++k) { const int i = i0 + k, ch = dir == 0 ? i : (i < 16 ? 15 - i : 287 - i);
            Hb[(size_t)ch * 512] = (bf16_t)(cvt_pk_bf16(hr, 0.f) & 0xffffu); Hb[(size_t)ch * 512 + 64] = (bf16_t)(cvt_pk_bf16(hi, 0.f) & 0xffffu);
            const float nr = ar * hr - aim * hi + sr[k], ni = ar * hi + aim * hr + si[k]; hr = nr; hi = ni; } }
}

__device__ __forceinline__ void topk_task(int be, const float* AFF, const unsigned char* H2, int* IDX, float* GATEV, int* SLOT, unsigned char* XS, LAS unsigned* L) {
    const int tid = threadIdx.x, lane = tid & 63, wid = tid >> 6, b = be >> 4, e = be & 15;
    LAS unsigned* hist = L; LAS unsigned* wsum = L + 256; LAS unsigned* bc = L + 272; LAS int* sidx = (LAS int*)(L + 288);
    const float* ap = AFF + (size_t)be * SEQ + tid * 8;
    const f32x4 a0 = *(const f32x4*)ap, a1 = *(const f32x4*)(ap + 4);
    unsigned key[8] = {__float_as_uint(a0[0]), __float_as_uint(a0[1]), __float_as_uint(a0[2]), __float_as_uint(a0[3]), __float_as_uint(a1[0]), __float_as_uint(a1[1]), __float_as_uint(a1[2]), __float_as_uint(a1[3])};
    unsigned prefix = 0, pmask = 0; int need = CAP;
    for (int pass = 0; pass < 4; ++pass) { const int shift = 24 - 8 * pass;
        if (tid < 256) hist[tid] = 0; __syncthreads();
#pragma unroll
        for (int i = 0; i < 8; ++i) if ((key[i] & pmask) == prefix) __hip_atomic_fetch_add(&hist[(key[i] >> shift) & 255u], 1u, __ATOMIC_RELAXED, __HIP_MEMORY_SCOPE_WORKGROUP);
        __syncthreads();
        if (tid < 64) { unsigned c0 = hist[255 - 4 * tid], c1 = hist[254 - 4 * tid], c2 = hist[253 - 4 * tid], c3 = hist[252 - 4 * tid]; unsigned tot = c0 + c1 + c2 + c3, inc = tot;
#pragma unroll
            for (int o = 1; o < 64; o <<= 1) { const unsigned v = __shfl_up(inc, o); if (tid >= o) inc += v; }
            const unsigned exc = inc - tot;
            if (exc < (unsigned)need && inc >= (unsigned)need) { unsigned run = exc; int bin = 255 - 4 * tid; unsigned cs[4] = {c0, c1, c2, c3};
#pragma unroll
                for (int k = 0; k < 4; ++k) { if (run < (unsigned)need && run + cs[k] >= (unsigned)need) { bc[0] = (unsigned)(bin - k); bc[1] = run; } run += cs[k]; } } }
        __syncthreads();
        const unsigned bin = bc[0], above = bc[1];
        prefix |= bin << shift; pmask |= 255u << shift; need -= (int)above;
        __syncthreads(); }
    unsigned cnt = 0;
#pragma unroll
    for (int i = 0; i < 8; ++i) cnt += (key[i] > prefix ? 1u : 0u) + (key[i] == prefix ? 0x10000u : 0u);
    unsigned inc = cnt;
#pragma unroll
    for (int o = 1; o < 64; o <<= 1) { const unsigned v = __shfl_up(inc, o); if (lane >= o) inc += v; }
    if (lane == 63) wsum[wid] = inc; __syncthreads();
    unsigned base = 0;
    for (int w = 0; w < wid; ++w) base += wsum[w];
    unsigned tot = 0;
    for (int w = 0; w < 8; ++w) tot += wsum[w];
    const int ngt = (int)(tot & 0xffffu);
    unsigned run = base + inc - cnt; int rgt = (int)(run & 0xffffu), req = (int)(run >> 16);
#pragma unroll
    for (int i = 0; i < 8; ++i) { const int t = tid * 8 + i; int slot = -1;
        if (key[i] > prefix) { slot = rgt; ++rgt; } else if (key[i] == prefix) { if (req < need) slot = ngt + req; ++req; }
        SLOT[((size_t)b * SEQ + t) * NE + e] = slot;
        if (slot >= 0) { sidx[slot] = t; IDX[be * CAP + slot] = t; GATEV[(size_t)e * 4096 + b * CAP + slot] = __uint_as_float(key[i]); } }
    __syncthreads();
    for (int s0 = wid * 64; s0 < wid * 64 + 64; s0 += 8) { u32x4 v[8];
#pragma unroll
        for (int k = 0; k < 8; ++k) v[k] = *(const u32x4*)(H2 + ((size_t)b * SEQ + sidx[s0 + k]) * DM + lane * 16);
#pragma unroll
        for (int k = 0; k < 8; ++k) *(u32x4*)(XS + ((size_t)e * 4096 + b * CAP + s0 + k) * DM + lane * 16) = v[k]; }
    __syncthreads();
}

constexpr int N_PHASES = 14;
__global__ void __launch_bounds__(512) fwd_kernel(Args args) {
    extern __shared__ __attribute__((aligned(16))) unsigned char lds_raw[];
    LAS unsigned char* lds = (LAS unsigned char*)lds_raw;
    cg::grid_group grid = cg::this_grid();
    const int tid = threadIdx.x, lane = tid & 63, wid = __builtin_amdgcn_readfirstlane(tid >> 6);
    const int G = gridDim.x, blk = blockIdx.x, gw = blk * 8 + wid, ngw = G * 8;
    unsigned char* ws = args.ws;
    float* MOD = (float*)(ws + WS_MOD); float* MISC = (float*)(ws + WS_MISC); float* ROPE = MISC + 256;
    bf16_t* BCAT = (bf16_t*)(ws + WS_BCAT); bf16_t* WCAT = (bf16_t*)(ws + WS_WCAT);
    bf16_t* WINT = (bf16_t*)(ws + WS_WIN); bf16_t* WGLUT = (bf16_t*)(ws + WS_WGLU); bf16_t* WAT = (bf16_t*)(ws + WS_WA); bf16_t* WBT = (bf16_t*)(ws + WS_WB); bf16_t* WOUTT = (bf16_t*)(ws + WS_WOUT);
    float* AFF = (float*)(ws + WS_AFF); int* IDX = (int*)(ws + WS_IDX); float* GATEV = (float*)(ws + WS_GATEV); int* SLOT = (int*)(ws + WS_SLOT);
    bf16_t* HN = (bf16_t*)(ws + WS_HN); bf16_t* UH = (bf16_t*)(ws + WS_UH); bf16_t* QB = (bf16_t*)(ws + WS_Q); bf16_t* KB = (bf16_t*)(ws + WS_K); bf16_t* VB = (bf16_t*)(ws + WS_V);
    bf16_t* GATES = (bf16_t*)(ws + WS_GATES); float* SB = (float*)(ws + WS_S); bf16_t* OC = (bf16_t*)(ws + WS_OC); bf16_t* YA = (bf16_t*)(ws + WS_YA); bf16_t* YY = (bf16_t*)(ws + WS_YY);
    bf16_t* MB = (bf16_t*)(ws + WS_M); unsigned char* H2 = ws + WS_H2; unsigned char* XS = ws + WS_XS; unsigned char* WGU = ws + WS_WGU; unsigned char* HID = ws + WS_HID;
    bf16_t* OB = (bf16_t*)(ws + WS_OB); bf16_t* X1 = (bf16_t*)(ws + WS_X1);
    unsigned char* WD = ws + WS_WD; unsigned char* YS = ws + WS_YS;
    const int lo = args.ph_lo, hi = args.ph_hi;
#ifdef ONLY_PHASE
#define IN(k) ((k) == ONLY_PHASE && lo <= (k) && (k) < hi)
#else
#define IN(k) (lo <= (k) && (k) < hi)
#endif
#define SEAM(k) do { if ((k) != 3 && (k) != 5 && IN(k) && IN((k) + 1)) xcd_barrier(xb); } while (0)
#define PH_BEGIN(k) if ((k) == TIME_PHASE) { t0_ = __builtin_amdgcn_s_memrealtime(); c0_ = __builtin_amdgcn_s_memtime(); } if (IN(k)) { for (int rep_ = 0; rep_ <= ((REPEAT_MASK >> (k)) & 1); ++rep_) { if (rep_) xcd_barrier(xb);
#define PH_END(k) } } if ((k) == TIME_PHASE && !TIME_WITH_SEAM) { t1_ = __builtin_amdgcn_s_memrealtime(); c1_ = __builtin_amdgcn_s_memtime(); } SEAM(k); if ((k) == TIME_PHASE && TIME_WITH_SEAM) { t1_ = __builtin_amdgcn_s_memrealtime(); c1_ = __builtin_amdgcn_s_memtime(); }
    LAS float* Lf = (LAS float*)lds;
    unsigned long long t0_ = 0, t1_ = 0, c0_ = 0, c1_ = 0, eacc_ = 0;
    volatile LAS unsigned* xst = (volatile LAS unsigned*)(lds + 131072 + 256);
    if (tid < 2) xst[tid] = 0u;
    __syncthreads();
    XcdBarrier xb = xcd_barrier_post((unsigned*)(ws + WS_BAR), xst);
    if (args.ph_lo < 0) grid.sync();
    LAS float* scr = Lf + wid * 4160;

    PH_BEGIN(0) {
        for (int task = blk; task < 257; task += G) {
#ifndef P0_NO_S5
            if (task < 64) s5_tables_task(task >> 1, task & 1, args, BCAT, WCAT, Lf);
            else
#endif
#ifndef P0_NO_MOD
            if (task < 256) mod_task((task - 64) * 32, args.in[I_C], args.in[I_CCTX], args.in[I_WADA], args.in[I_BADA], MOD, Lf);
            else
#endif
            {
                for (int i = tid; i < 1024; i += 512) { const int pos = i >> 4, fi = i & 15; const float inv = exp2f(-(float)fi * (13.287712379549449f / 16.0f));
                    float sn, cs; sincos_fast((float)pos * inv, &sn, &cs); ROPE[pos * 32 + fi] = cs; ROPE[pos * 32 + 16 + fi] = sn; }
                if (tid < 64) { const float* l = args.in[I_DALAM]; const float s1 = wave_sum(l[tid] * l[64 + tid]), s2 = wave_sum(l[128 + tid] * l[192 + tid]);
                    if (tid == 0) MISC[0] = expf(s1) - expf(s2) + 0.2f; }
            }
        }
        __syncthreads();
#ifndef P0_NO_TR
        for (int it = gw; it < 1600; it += ngw) {
            if (it < 1024) { const int kb = it >> 6, nb = it & 63, n0 = nb * 64;
                if (n0 >= 512 && n0 < 1536) { const int ng = lane & 15, kg = lane >> 4, cb = n0 + ng * 4, p = cb & 31, row = (cb & ~31) + (p < 16 ? 8 * (p >> 2) : 8 * ((p - 16) >> 2) + 4);
                    const float* src = args.in[I_WIN] + (size_t)kb * 64 * 4096 + cb; f32x4 v[2][8];
#pragma unroll
                    for (int h = 0; h < 2; ++h)
#pragma unroll
                        for (int i = 0; i < 8; ++i) v[h][i] = *(const f32x4*)(src + (size_t)(h * 32 + kg * 8 + i) * 4096);
#pragma unroll
                    for (int h = 0; h < 2; ++h)
#pragma unroll
                        for (int j = 0; j < 4; ++j) { u32x4 o; o.x = cvt_pk_bf16(v[h][0][j], v[h][1][j]); o.y = cvt_pk_bf16(v[h][2][j], v[h][3][j]); o.z = cvt_pk_bf16(v[h][4][j], v[h][5][j]); o.w = cvt_pk_bf16(v[h][6][j], v[h][7][j]);
                            *(u32x4*)(WINT + (size_t)(row + j) * 1024 + kb * 64 + h * 32 + kg * 8) = o; } }
                else cvt_item(args.in[I_WIN] + (size_t)kb * 64 * 4096 + n0, 4096, WINT + (size_t)n0 * 1024 + kb * 64, 1024, 4, lane); }
            else if (it < 1088) { const int r = it - 1024, kb = r >> 3, nb = r & 7;
                cvt_item(args.in[I_WGLU] + (size_t)kb * 64 * 512 + nb * 64, 512, WGLUT + (size_t)nb * 64 * 512 + kb * 64, 512, 4, lane); }
            else if (it < 1344) { const int r = (it - 1088) & 127, kb = r >> 4, nb = r & 15; const bool isb = it >= 1216;
                cvt_item(args.in[isb ? I_WPB : I_WPA] + (size_t)kb * 64 * 1024 + nb * 64, 1024, (isb ? WBT : WAT) + (size_t)nb * 64 * 512 + kb * 64, 512, 4, lane); }
            else { const int r = it - 1344, kb = r >> 4, nb = r & 15;
                cvt_item(args.in[I_WOUT] + (size_t)kb * 64 * 1024 + nb * 64, 1024, WOUTT + (size_t)nb * 64 * 1024 + kb * 64, 1024, 4, lane); }
        }
#endif
    }
    PH_END(0)
    PH_BEGIN(1) { row_pass1(args, MOD, HN, gw, ngw, lane); }
    PH_END(1)
    PH_BEGIN(2) { SchedWin S{0, G, blk, (const char*)HN, (const char*)WINT}; EpiWin E{UH, QB, KB, VB, GATES, ROPE};
        pg8::gemm_phase(lds, 2048, 2048, 2048, S, E); }
    PH_END(2)
    PH_BEGIN(3) { }
    PH_END(3)
    PH_BEGIN(4) {
        for (int bg = blk; bg < 256; bg += G) {
            { SchedS5aB S{0, bg, (const char*)UH, (const char*)BCAT}; EpiS5a E{SB}; pg8::gemm_phase(lds, 1024, 512, 512, S, E); }
            if (tid == 0) __builtin_amdgcn_fence(__ATOMIC_ACQUIRE, "agent");
            asm volatile("s_waitcnt vmcnt(0)" ::: "memory"); __syncthreads();
            s5_scan(args, SB, UH, bg);
            asm volatile("s_waitcnt vmcnt(0)" ::: "memory"); __syncthreads();
            if (tid == 0) __builtin_amdgcn_fence(__ATOMIC_ACQUIRE, "agent");
            asm volatile("s_waitcnt vmcnt(0)" ::: "memory"); __syncthreads();
            { SchedS5cB S{0, bg, (const char*)UH, (const char*)WCAT}; EpiS5c E{YA}; pg8::gemm_phase(lds, 1024, 1024, 1024, S, E); }
        }
        const int vcu = (G % 8 == 0) ? (blk % 8) * (G / 8) + blk / 8 : blk;
        static_assert(I_WEG == 26 && I_WEU == 27, "CvtSide indexes the expert weights by position");
        att::CvtSide cs; { const int gwv = __builtin_amdgcn_readfirstlane(gw); cs.in = args.in; cs.ws = ws; cs.buf = lds + att::OFF_CVT + (gwv & 7) * 4096; cs.gw = gwv; cs.t = 0; cs.tlim = 0; cs.pend = false; }
        for (int i = 0;; ++i) { const int U = i * G + vcu; if (U >= 1024) break; cs.tlim = G == 256 ? 8 * (i + 1) : 0;
            const int bh = U >> 5, rem = U & 31, c = rem >> 4, qb = rem & 15, b = bh >> 2, h = bh & 3;
            att::attn_unit(QB + ((size_t)b * LT + CL + qb * 256) * 512 + h * 128 + c * 64, KB + (size_t)b * LT * 512 + h * 128 + c * 64, VB + (size_t)b * LT * 512 + h * 128,
                           OC + ((size_t)c * ML + (size_t)b * SEQ + qb * 256) * 512 + h * 128, LT, (char*)lds_raw, cs, EPI_PROBE == 4 ? &eacc_ : nullptr); }
        if (cs.pend) att::cvt_side_store(cs, lane);
    }
    PH_END(4)
    PH_BEGIN(5) { }
    PH_END(5)
    PH_BEGIN(6) { SchedGlu S{0, G, blk, (const char*)YA, (const char*)WGLUT}; EpiGlu E{YA, YY};
        pg8::gemm_phase(lds, 1024, 1024, 1024, S, E);
        yb_combine(OC, args.in[I_SUBLN], MISC[0], YY, gw, ngw, lane); }
    PH_END(6)
    PH_BEGIN(7) { SchedProj S{0, G, blk, 0, 0, 0, (const char*)YY, (const char*)WAT, (const char*)WBT}; EpiProj E{GATES, MB};
        pg8::gemm_phase(lds, 2048, 1024, 1024, S, E, EPI_PROBE == 7 ? &eacc_ : nullptr); }
    PH_END(7)
    PH_BEGIN(8) { SchedOut S{0, G, blk, (const char*)MB, (const char*)WOUTT}; EpiOut E{OB};
        pg8::gemm_phase(lds, 2048, 2048, 2048, S, E, EPI_PROBE == 8 ? &eacc_ : nullptr); }
    PH_END(8)
    PH_BEGIN(9) {
        for (int i = tid; i < 16384; i += 512) Lf[(i & 15) * 1024 + (i >> 4)] = args.in[I_WROUTER][i];
        __syncthreads();
        row_pass2(args, MOD, OB, X1, H2, AFF, Lf, gw, ngw, lane);
    }
    PH_END(9)
    PH_BEGIN(10) {
        for (int be = blk; be < 128; be += G) topk_task(be, AFF, H2, IDX, GATEV, SLOT, XS, (LAS unsigned*)lds);
        if (G == 256 && !SIDE_PROBE) { if (blk >= 128) for (int it = (gw - 1024) * 8; it < (gw - 1024) * 8 + 8; ++it) { const int e = it >> 9, r = it & 511, kb = r >> 4, nb = r & 15;
                cvt_item8(args.in[I_WED] + (size_t)e * 2048 * 1024 + (size_t)kb * 64 * 1024 + nb * 64, 1024, WD + ((size_t)e * 1024 + nb * 64) * 2048 + kb * 64, 2048, 4, WSCALE, lane); } }
        else
            for (int it = gw; it < 24576; it += ngw) {
                if (it < 16384) { const int e = it >> 10, r = it & 1023, kb = r >> 6, fb = (r >> 1) & 31, isup = r & 1;
                    cvt_item8(args.in[isup ? I_WEU : I_WEG] + (size_t)e * 1024 * 2048 + (size_t)kb * 64 * 2048 + fb * 64, 2048, WGU + ((size_t)e * 4096 + fb * 128 + isup * 4) * 1024 + kb * 64, 1024, 8, WSCALE, lane); }
                else { const int i2 = it - 16384, e = i2 >> 9, r = i2 & 511, kb = r >> 4, nb = r & 15;
                    cvt_item8(args.in[I_WED] + (size_t)e * 2048 * 1024 + (size_t)kb * 64 * 1024 + nb * 64, 1024, WD + ((size_t)e * 1024 + nb * 64) * 2048 + kb * 64, 2048, 4, WSCALE, lane); } }
    }
    PH_END(10)
    PH_BEGIN(11) { SchedUp S{0, G, blk, (const char*)XS, (const char*)WGU}; EpiUp E{HID};
        pg8::gemm_phase<EpiUp, SchedUp, true>(lds, 1024, 1024, 1024, S, E); }
    PH_END(11)
    PH_BEGIN(12) { SchedDown S{0, G, blk, (const char*)HID, (const char*)WD}; EpiDown E{GATEV, YS};
        pg8::gemm_phase<EpiDown, SchedDown, true>(lds, 2048, 2048, 2048, S, E); }
    PH_END(12)
    PH_BEGIN(13) { row_final(args, MOD, X1, args.out, YS, SLOT, gw, ngw, lane); }
    PH_END(13)
    if (TIME_PHASE >= 0 && blk == 0 && tid == 0) { const unsigned long long d = EPI_PROBE ? eacc_ * 40000ull / (c1_ - c0_ + 1ull) : CLOCK_PROBE ? (c1_ - c0_) * 2000ull / (t1_ - t0_ + 1ull) : (t1_ - t0_) * 4ull, e0 = __builtin_amdgcn_s_memrealtime(); while (__builtin_amdgcn_s_memrealtime() - e0 < d) __builtin_amdgcn_s_sleep(10); }
#undef IN
#undef SEAM
}

extern "C" void kernel_launch(void* const* d_in, const int* in_sizes, int n_in, void* d_out, int out_size, void* d_ws, size_t ws_size, hipStream_t stream) {
    static int grid = 0;
    if (grid == 0) {
        if (n_in != 29 || in_sizes[0] != ML * DM || out_size != ML * DM || ws_size < WS_END) {
            fprintf(stderr, "kernel_launch: unexpected shapes: n_in %d in0 %d out %d ws %zu (need %zu)\n", n_in, n_in > 0 ? in_sizes[0] : -1, out_size, ws_size, (size_t)WS_END); grid = -1; return; }
        int dev = 0, cus = 0, per_cu = 0;
        if (hipGetDevice(&dev) != hipSuccess || hipDeviceGetAttribute(&cus, hipDeviceAttributeMultiprocessorCount, dev) != hipSuccess) { grid = -1; return; }
        if (hipFuncSetAttribute((const void*)fwd_kernel, hipFuncAttributeMaxDynamicSharedMemorySize, LDS_BYTES) != hipSuccess) { fprintf(stderr, "kernel_launch: hipFuncSetAttribute failed\n"); grid = -1; return; }
        if (hipOccupancyMaxActiveBlocksPerMultiprocessor(&per_cu, (const void*)fwd_kernel, 512, LDS_BYTES) != hipSuccess || per_cu < 1) { fprintf(stderr, "kernel_launch: occupancy query gave %d\n", per_cu); per_cu = 1; }
        (void)hipGetLastError();
        grid = cus * 1;
        if (grid > 256) grid = 256;
    }
    if (grid < 0) return;
    if (hipMemsetAsync((char*)d_ws + WS_BAR, 0, XCD_BAR_WORDS * 4, stream) != hipSuccess) { fprintf(stderr, "kernel_launch: memset of the barrier words failed\n"); return; }
    Args a{};
    for (int i = 0; i < 29; ++i) a.in[i] = (const float*)d_in[i];
    a.out = (float*)d_out; a.ws = (unsigned char*)d_ws;
#if MK_PER_PHASE
    for (int p = 0; p < N_PHASES; ++p) { a.ph_lo = p; a.ph_hi = p + 1;
        hipLaunchKernelGGL(fwd_kernel, dim3(grid), dim3(512), LDS_BYTES, stream, a);
        const hipError_t le = hipPeekAtLastError();
        if (le != hipSuccess) { fprintf(stderr, "kernel_launch: launch %d failed: %s\n", p, hipGetErrorName(le)); break; } }
#else
    a.ph_lo = 0; a.ph_hi = N_PHASES;
    void* kargs[] = {&a};
    const hipError_t le = hipLaunchCooperativeKernel((const void*)fwd_kernel, dim3(grid), dim3(512), kargs, LDS_BYTES, stream);
    if (le != hipSuccess) fprintf(stderr, "kernel_launch: cooperative launch failed: %s (grid %d)\n", hipGetErrorString(le), grid);
#endif
}
```

```cpp
#include <hip/hip_runtime.h>
#include <hip/hip_cooperative_groups.h>
#include <cstdio>
#include <cstdint>
namespace cg = cooperative_groups;

#ifndef MK_PER_PHASE
#define MK_PER_PHASE 0
#endif

#ifndef REPEAT_MASK
#define REPEAT_MASK 0
#endif

#define CLOCK_PROBE 0
#define EPI_PROBE 0
#define SIDE_PROBE 0
#define TIME_WITH_SEAM 0
#define TIME_PHASE -1

#define LAS __attribute__((address_space(3)))
typedef unsigned short bf16_t;
typedef short bf16x8 __attribute__((ext_vector_type(8)));
typedef short s16x4 __attribute__((ext_vector_type(4)));
typedef float f32x4 __attribute__((ext_vector_type(4)));
typedef float f32x2 __attribute__((ext_vector_type(2)));
typedef float f32x16 __attribute__((ext_vector_type(16)));
typedef unsigned u32x4 __attribute__((ext_vector_type(4)));
typedef unsigned u32x2 __attribute__((ext_vector_type(2)));

constexpr int NB = 8, SEQ = 4096, CL = 256, LT = SEQ + CL  , DM = 1024;
constexpr int MR = NB * LT  , ML = NB * SEQ  ;
constexpr int NCH = LT / 16;
constexpr int NE = 16, CAP = 512, DE = 2048;
constexpr float EPS = 1e-6f;
constexpr float QSCALE = 0.125f * 1.4426950408889634f;

constexpr size_t MiB = 1u << 20;
constexpr size_t WS_BAR = 0;
constexpr size_t WS_MOD = 64 * 1024;
constexpr size_t WS_MISC = 512 * 1024;
constexpr size_t WS_BCAT = 1 * MiB;
constexpr size_t WS_WCAT = 5 * MiB;
constexpr size_t WS_WIN = 13 * MiB;
constexpr size_t WS_WGLU = 21 * MiB;
constexpr size_t WS_WA = 22 * MiB, WS_WB = 23 * MiB;
constexpr size_t WS_WOUT = 24 * MiB;
constexpr size_t WS_AFF = 26 * MiB;
constexpr size_t WS_IDX = 28 * MiB;
constexpr size_t WS_GATEV = 28 * MiB + 512 * 1024;
constexpr size_t WS_SLOT = 29 * MiB;
constexpr size_t WS_HN = 32 * MiB;
constexpr size_t WS_UH = 100 * MiB;
constexpr size_t WS_Q = 168 * MiB, WS_K = 202 * MiB, WS_V = 236 * MiB;
constexpr size_t WS_GATES = 270 * MiB;
constexpr size_t WS_S = 32 * MiB;
constexpr size_t WS_OC = 430 * MiB;
constexpr size_t WS_YA = 398 * MiB;
constexpr size_t WS_YY = 100 * MiB;
constexpr size_t WS_YB = 462 * MiB;
constexpr size_t WS_M = 168 * MiB;
constexpr size_t WS_H2 = 32 * MiB;
constexpr size_t WS_XS = 64 * MiB;
constexpr size_t WS_WGU = 494 * MiB;
constexpr size_t WS_HID = 224 * MiB;
constexpr size_t WS_WD = 192 * MiB;
constexpr size_t WS_YS = 352 * MiB;
constexpr size_t WS_OB = 270 * MiB;
constexpr size_t WS_X1 = 128 * MiB;
constexpr size_t WS_END = 558 * MiB;

constexpr int LDS_BYTES = 155648;

__device__ __forceinline__ unsigned cvt_pk_bf16(float lo, float hi) { unsigned r; asm volatile("v_cvt_pk_bf16_f32 %0, %1, %2" : "=v"(r) : "v"(lo), "v"(hi)); return r; }
__device__ __forceinline__ float bf_lo(unsigned u) { return __uint_as_float(u << 16); }
__device__ __forceinline__ float bf_hi(unsigned u) { return __uint_as_float(u & 0xffff0000u); }
__device__ __forceinline__ float bf2f(bf16_t b) { return __uint_as_float(((unsigned)b) << 16); }
__device__ __forceinline__ unsigned pk_fp8x4(float a, float b, float c, float d) {
    a = __builtin_amdgcn_fmed3f(a, -448.f, 448.f); b = __builtin_amdgcn_fmed3f(b, -448.f, 448.f); c = __builtin_amdgcn_fmed3f(c, -448.f, 448.f); d = __builtin_amdgcn_fmed3f(d, -448.f, 448.f);
    int w = __builtin_amdgcn_cvt_pk_fp8_f32(a, b, 0, false); w = __builtin_amdgcn_cvt_pk_fp8_f32(c, d, w, true); return (unsigned)w; }
__device__ __forceinline__ float sigmoidf_(float x) { return __builtin_amdgcn_rcpf(1.0f + __expf(-x)); }
template <int CTRL> __device__ __forceinline__ float dpp_f(float v) { return __builtin_bit_cast(float, __builtin_amdgcn_update_dpp(0, __builtin_bit_cast(int, v), CTRL, 0xF, 0xF, true)); }
constexpr int DPP_XOR1 = 0xB1, DPP_XOR2 = 0x4E, DPP_HMIRROR = 0x141, DPP_MIRROR = 0x140, DPP_ROR8 = 0x128;
__device__ __forceinline__ float swap16_sum(float a, float b) { auto r = __builtin_amdgcn_permlane16_swap(__float_as_uint(a), __float_as_uint(b), false, false); return __uint_as_float(r[0]) + __uint_as_float(r[1]); }
__device__ __forceinline__ float swap32_sum(float a, float b) { auto r = __builtin_amdgcn_permlane32_swap(__float_as_uint(a), __float_as_uint(b), false, false); return __uint_as_float(r[0]) + __uint_as_float(r[1]); }
__device__ __forceinline__ float wave_sum(float v) {
    v += dpp_f<DPP_XOR1>(v); v += dpp_f<DPP_XOR2>(v); v += dpp_f<DPP_HMIRROR>(v); v += dpp_f<DPP_MIRROR>(v);
    v = swap16_sum(v, v); return swap32_sum(v, v);
}
__device__ __forceinline__ void sincos_fast(float x, float* sn, float* cs) {
    const float k = rintf(x * 0.15915494309189535f); float r = fmaf(-k, 6.28318548202514648f, x); r = fmaf(-k, -1.74845553e-07f, r);
    *sn = __sinf(r); *cs = __cosf(r); }
__device__ __forceinline__ float gelu_tanh(float x) { const float u = 0.7978845608028654f * (x + 0.044715f * x * x * x); return x * sigmoidf_(2.0f * u); }

__device__ __forceinline__ void map_tile(int wgid, int nM, int nN, int& pm, int& pn) {
    const int nwg = nM * nN, q = nwg / 8, r = nwg % 8, xcd = wgid % 8, off = wgid / 8;
    wgid = (xcd < r ? xcd * (q + 1) : r * (q + 1) + (xcd - r) * q) + off;
    const int nig = 8 * nN, gid = wgid / nig, fm = gid * 8, gsz = (nM - fm) < 8 ? (nM - fm) : 8;
    pm = fm + ((wgid % nig) % gsz); pn = (wgid % nig) / gsz;
}

namespace pg8 {
constexpr int BM = 256, BK = 64, HALF = 128, HTB = HALF * BK * 2, STAGE_BYTES = 8 * HTB;
__device__ __forceinline__ int lds_byte(int r, int c) { const int st = (r >> 4) * 2 + (c >> 5), rr = r & 15, cc = c & 31, ob = rr * 64 + cc * 2; return st * 1024 + (ob ^ (((ob >> 9) & 1) << 5)); }
__device__ __forceinline__ int lds_byte8(int r, int q) { return r * 128 + ((q ^ ((r >> 1) & 3)) << 5); }
__device__ __forceinline__ void stage_rc8(int b, int& R, int& Cb) { R = b >> 7; const int u = (b & 127) >> 4; Cb = (((u >> 1) ^ ((R >> 1) & 3)) << 5) + ((u & 1) << 4); }
__device__ __forceinline__ void stage_rc(int b, int& R, int& C) { const int st = b / 1024, sb = b % 1024, swz = sb ^ (((sb >> 9) & 1) << 5); R = (st >> 1) * 16 + swz / 64; C = (st & 1) * 32 + (swz % 64) / 2; }
__device__ __forceinline__ int perm32(int rho) { const int n = rho >> 4, i = rho & 15; return 8 * (i >> 2) + 4 * n + (i & 3); }

typedef int i32x8 __attribute__((ext_vector_type(8)));
__device__ __forceinline__ i32x8 ld32(const LAS unsigned char* p, int sw) { typedef int i32x4 __attribute__((ext_vector_type(4))); const i32x4 a = *(const LAS i32x4*)(p + sw), b = *(const LAS i32x4*)(p + (sw ^ 16)); return (i32x8){a[0], a[1], a[2], a[3], b[0], b[1], b[2], b[3]}; }
__device__ __forceinline__ i32x8 cat8(bf16x8 lo, bf16x8 hi) { typedef int i32x4 __attribute__((ext_vector_type(4))); const i32x4 a = __builtin_bit_cast(i32x4, lo), b = __builtin_bit_cast(i32x4, hi); return (i32x8){a[0], a[1], a[2], a[3], b[0], b[1], b[2], b[3]}; }
struct Unit { const char* a; const char* b; int r0, c0, aux; };

template <class Epi, class Sched, bool FP8 = false>
__device__ __forceinline__ void gemm_phase(LAS unsigned char* lds, const int ldaB, const int ldbB, const int KB, Sched& S, const Epi& E, unsigned long long* eacc = nullptr) {
    const int tid = threadIdx.x, wid = __builtin_amdgcn_readfirstlane(tid >> 6), lane = tid & 63, wr = wid >> 2, wc = wid & 3, fr = lane & 15, fq = lane >> 4;
    const int nt = KB / 128;
    unsigned voffA, voffB;
    { int R, C; if constexpr (FP8) stage_rc8(tid * 16, R, C); else { stage_rc(tid * 16, R, C); C *= 2; }
      const int Rb = Epi::PERM ? ((R & ~31) + perm32(R & 31)) : R; voffA = (unsigned)(R * ldaB + C); voffB = (unsigned)(Rb * ldbB + C); }
    const int sw8 = (fq & 1) * 16;
    const size_t qvoffA = (size_t)64 * ldaB, qvoffB = (size_t)64 * ldbB;
    const size_t kstep = (size_t)(BK * 2);
    const size_t hstepA = (size_t)HALF * ldaB, hstepB = (size_t)HALF * ldbB;
    const unsigned ldsw = (unsigned)wid * 1024u;
    const int aoff = FP8 ? lds_byte8(wr * 64 + fr, fq) : lds_byte(wr * 64 + fr, fq * 8), boff = FP8 ? lds_byte8(wc * 32 + fr, fq) : lds_byte(wc * 32 + fr, fq * 8);
#define PG8_SA(b, h) (((b) * 2 + (h)) * HTB)
#define PG8_SB(b, h) ((4 + (b) * 2 + (h)) * HTB)
#define PG8_STAGE(bufoff, gbase, voff) do { _Pragma("unroll") for (int _i = 0; _i < 2; ++_i) \
        __builtin_amdgcn_global_load_lds((const unsigned*)((const char*)(gbase) + (_i ? q##voff : (size_t)0) + voff), (LAS unsigned*)(lds + (bufoff) + ldsw + _i * 8192), 16, 0, 0); } while (0)
#define PG8_LDA(dst, b, h) do { _Pragma("unroll") for (int m = 0; m < 4; ++m) { if constexpr (FP8) dst##8[m] = ld32(lds + PG8_SA(b, h) + aoff + m * 2048, sw8); else { _Pragma("unroll") for (int k = 0; k < 2; ++k) dst[m][k] = *(const LAS bf16x8*)(lds + PG8_SA(b, h) + aoff + m * 2048 + k * 1024); } } } while (0)
#define PG8_LDB(dst, b, h) do { _Pragma("unroll") for (int n = 0; n < 2; ++n) { if constexpr (FP8) dst##8[n] = ld32(lds + PG8_SB(b, h) + boff + n * 2048, sw8); else { _Pragma("unroll") for (int k = 0; k < 2; ++k) dst[n][k] = *(const LAS bf16x8*)(lds + PG8_SB(b, h) + boff + n * 2048 + k * 1024); } } } while (0)
#define PG8_MMA(ai, bj, At, Bt) do { __builtin_amdgcn_s_setprio(1); _Pragma("unroll") for (int m = 0; m < 4; ++m) _Pragma("unroll") for (int n = 0; n < 2; ++n) { \
        if constexpr (FP8) { asm volatile("v_mfma_f32_16x16x128_f8f6f4 %0, %1, %2, %0" : "+v"(acc[ai][bj][m][n]) : "v"(Bt##8[n]), "v"(At##8[m])); } \
        else { _Pragma("unroll") for (int k = 0; k < 2; ++k) acc[ai][bj][m][n] = __builtin_amdgcn_mfma_f32_16x16x32_bf16(Bt[n][k], At[m][k], acc[ai][bj][m][n], 0, 0, 0); } } \
        __builtin_amdgcn_s_setprio(0); } while (0)
#define PG8_WAIT_V(n) asm volatile("s_waitcnt vmcnt(" #n ")" ::: "memory")
#define PG8_WAIT_L(n) asm volatile("s_waitcnt lgkmcnt(" #n ")" ::: "memory")
#define PG8_BAR __builtin_amdgcn_s_barrier()
#define PG8_SCHED __builtin_amdgcn_sched_barrier(0)
    Unit cur, nxt;
    if (!S.next(cur)) return;
    f32x4 acc[2][2][4][2];
#pragma unroll
    for (int a = 0; a < 2; ++a)
#pragma unroll
        for (int b = 0; b < 2; ++b)
#pragma unroll
            for (int m = 0; m < 4; ++m)
#pragma unroll
                for (int n = 0; n < 2; ++n) { acc[a][b][m][n] = (f32x4){0.f, 0.f, 0.f, 0.f}; if constexpr (FP8) asm volatile("" : "+v"(acc[a][b][m][n])); }
    bf16x8 At[4][2], B0[2][2], B1[2][2]; i32x8 At8[4], B08[2], B18[2];
    const char* cA = cur.a; const char* cB = cur.b;
    PG8_STAGE(PG8_SB(0, 0), cB, voffB); PG8_STAGE(PG8_SB(0, 1), cB + hstepB, voffB); PG8_STAGE(PG8_SA(0, 0), cA, voffA); PG8_STAGE(PG8_SA(0, 1), cA + hstepA, voffA);
    if (wr == 1) PG8_BAR;
    PG8_WAIT_V(2); PG8_BAR;
    PG8_STAGE(PG8_SB(1, 0), cB + kstep, voffB); PG8_STAGE(PG8_SA(1, 0), cA + kstep, voffA); PG8_STAGE(PG8_SB(1, 1), cB + hstepB + kstep, voffB);
    PG8_WAIT_V(6); PG8_BAR;
    for (;;) {
        const bool has_next = S.next(nxt);
        const char* nA = has_next ? nxt.a : cA; const char* nB = has_next ? nxt.b : cB;
#pragma unroll 1
        for (int t = 0; t < nt; t += 2) {
            const bool last = (t == nt - 2);
            const char* a1 = cA + (size_t)(t + 1) * kstep;
            const char* a2 = last ? nA : cA + (size_t)(t + 2) * kstep; const char* b2 = last ? nB : cB + (size_t)(t + 2) * kstep;
            const char* a3 = a2 + kstep; const char* b3 = b2 + kstep;
            PG8_LDB(B0, 0, 0); PG8_LDB(B1, 0, 1); PG8_SCHED; PG8_LDA(At, 0, 0); PG8_STAGE(PG8_SA(1, 1), a1 + hstepA, voffA);
            PG8_WAIT_V(8); PG8_WAIT_L(0); PG8_BAR; PG8_MMA(0, 0, At, B0); PG8_MMA(0, 1, At, B1); PG8_BAR; PG8_SCHED;
            PG8_LDA(At, 0, 1); PG8_STAGE(PG8_SB(0, 0), b2, voffB); PG8_STAGE(PG8_SB(0, 1), b2 + hstepB, voffB); PG8_STAGE(PG8_SA(0, 0), a2, voffA);
            PG8_WAIT_V(8); PG8_WAIT_L(0); PG8_BAR; PG8_MMA(1, 0, At, B0); PG8_MMA(1, 1, At, B1); PG8_BAR; PG8_SCHED;
            PG8_LDB(B0, 1, 0); PG8_LDB(B1, 1, 1); PG8_SCHED; PG8_LDA(At, 1, 0); PG8_STAGE(PG8_SA(0, 1), a2 + hstepA, voffA);
            PG8_WAIT_V(8); PG8_WAIT_L(0); PG8_BAR; PG8_MMA(0, 0, At, B0); PG8_MMA(0, 1, At, B1); PG8_BAR; PG8_SCHED;
            PG8_LDA(At, 1, 1); PG8_STAGE(PG8_SB(1, 0), b3, voffB); PG8_STAGE(PG8_SB(1, 1), b3 + hstepB, voffB); PG8_STAGE(PG8_SA(1, 0), a3, voffA);
            PG8_WAIT_V(8); PG8_WAIT_L(0); PG8_BAR; PG8_MMA(1, 0, At, B0); PG8_MMA(1, 1, At, B1); PG8_BAR; PG8_SCHED;
        }
        if (wr == 0) PG8_BAR;
        if constexpr (FP8) { asm volatile("s_nop 15\n\ts_nop 15" ::: "memory"); PG8_SCHED; }
        const unsigned long long e0_ = eacc ? __builtin_amdgcn_s_memtime() : 0ull;
        const bool zero = E(acc, cur, wr, wc, fr, fq);
        if (eacc) { asm volatile("s_waitcnt vmcnt(0)" ::: "memory"); *eacc += __builtin_amdgcn_s_memtime() - e0_; }
        if (!has_next) break;
        if (zero) {
#pragma unroll
            for (int a = 0; a < 2; ++a)
#pragma unroll
                for (int b = 0; b < 2; ++b)
#pragma unroll
                    for (int m = 0; m < 4; ++m)
#pragma unroll
                        for (int n = 0; n < 2; ++n) { acc[a][b][m][n] = (f32x4){0.f, 0.f, 0.f, 0.f}; if constexpr (FP8) asm volatile("" : "+v"(acc[a][b][m][n])); }
        }
        cur = nxt; cA = nA; cB = nB;
        if (wr == 1) PG8_BAR;
    }
    PG8_WAIT_V(0);
    PG8_BAR;
#undef PG8_SA
#undef PG8_SB
#undef PG8_STAGE
#undef PG8_LDA
#undef PG8_LDB
#undef PG8_MMA
#undef PG8_WAIT_V
#undef PG8_WAIT_L
#undef PG8_BAR
#undef PG8_SCHED
}
}
using pg8::Unit;

namespace att {
constexpr int QBLK = 32, KVBLK = 64, LD = 512;
constexpr int SHM_V = KVBLK * 128 * 2, SHM_K = KVBLK * 64 * 2;
constexpr int NVB = 5, NKB = 4;
constexpr int OFF_V = 0, OFF_K = NVB * SHM_V, OFF_WS = OFF_K + NKB * SHM_K, ATT_LDS = OFF_WS + 8 * 64 * 4;
constexpr float THRL = 8.0f;
#define KSWZ(row, colB) ((row) * 128 + ((colB) ^ ((((row) >> 1) & 7) << 4)))
#define SBAR() __builtin_amdgcn_sched_barrier(0)
#define ABAR() do { asm volatile("s_waitcnt lgkmcnt(0)" ::: "memory"); __builtin_amdgcn_s_barrier(); asm volatile("" ::: "memory"); } while (0)
__device__ __forceinline__ int crow(int r, int hi) { return (r & 3) + 8 * (r >> 2) + 4 * hi; }

__device__ __forceinline__ void partialSM(f32x16& p0, f32x16& p1, float& m_reg, float& alpha) {
    float pmax = p0[0];
#pragma unroll
    for (int r = 1; r < 16; ++r) pmax = fmaxf(pmax, p0[r]);
#pragma unroll
    for (int r = 0; r < 16; ++r) pmax = fmaxf(pmax, p1[r]);
    { auto rr = __builtin_amdgcn_permlane32_swap(__float_as_uint(pmax), __float_as_uint(pmax), false, false);
      pmax = fmaxf(__uint_as_float(rr[0]), __uint_as_float(rr[1])); }
    if (__builtin_expect(__all(pmax - m_reg <= THRL), 1)) { alpha = 1.f; }
    else { const float mn = fmaxf(m_reg, pmax); alpha = __builtin_amdgcn_exp2f(m_reg - mn); m_reg = mn; }
    const float mm = m_reg;
#pragma unroll
    for (int r = 0; r < 16; ++r) p0[r] = p0[r] - mm;
#pragma unroll
    for (int r = 0; r < 16; ++r) p1[r] = p1[r] - mm;
#pragma unroll
    for (int r = 0; r < 16; ++r) p0[r] = __builtin_amdgcn_exp2f(p0[r]);
}
__device__ __forceinline__ void finishSM(f32x16& p0, f32x16& p1, float alpha, float& l_reg, bf16x8& pa0, bf16x8& pa1, bf16x8& pa2, bf16x8& pa3) {
#pragma unroll
    for (int r = 0; r < 16; ++r) p1[r] = __builtin_amdgcn_exp2f(p1[r]);
    float ps = 0;
#pragma unroll
    for (int r = 0; r < 16; ++r) ps += p0[r];
#pragma unroll
    for (int r = 0; r < 16; ++r) ps += p1[r];
    { auto rr = __builtin_amdgcn_permlane32_swap(__float_as_uint(ps), __float_as_uint(ps), false, false);
      ps = __uint_as_float(rr[0]) + __uint_as_float(rr[1]); }
    l_reg = l_reg * alpha + ps;
#define PK4(P, BASE, OUT) do { unsigned a0 = cvt_pk_bf16(P[BASE + 0], P[BASE + 1]), a1 = cvt_pk_bf16(P[BASE + 2], P[BASE + 3]);   \
    unsigned b0 = cvt_pk_bf16(P[BASE + 4], P[BASE + 5]), b1 = cvt_pk_bf16(P[BASE + 6], P[BASE + 7]);                              \
    auto r0 = __builtin_amdgcn_permlane32_swap(a0, b0, false, false); auto r1 = __builtin_amdgcn_permlane32_swap(a1, b1, false, false); \
    u32x4 w = {r0[0], r1[0], r0[1], r1[1]}; OUT = *reinterpret_cast<bf16x8*>(&w); } while (0)
    PK4(p0, 0, pa0); PK4(p0, 8, pa1); PK4(p1, 0, pa2); PK4(p1, 8, pa3);
#undef PK4
}
__device__ __forceinline__ void qkt(f32x16& p0, f32x16& p1, const char* Ks, const bf16x8* qr, int r32, int hi) {
    p0 = f32x16{}; p1 = f32x16{};
#pragma unroll
    for (int d0 = 0; d0 < 4; ++d0) { const int cb = (d0 * 16 + hi * 8) * 2;
        const bf16x8 b0 = *reinterpret_cast<const bf16x8*>(Ks + KSWZ(r32, cb));
        const bf16x8 b1 = *reinterpret_cast<const bf16x8*>(Ks + KSWZ(32 + r32, cb));
        p0 = __builtin_amdgcn_mfma_f32_32x32x16_bf16(b0, qr[d0], p0, 0, 0, 0);
        p1 = __builtin_amdgcn_mfma_f32_32x32x16_bf16(b1, qr[d0], p1, 0, 0, 0);
 }
}
__device__ __forceinline__ int v_st(int k, int c) { const int kk = (k & ~0xC) | ((k & 4) << 1) | ((k & 8) >> 1); return ((kk >> 3) * 4 + (c >> 5)) * 512 + ((kk & 7) * 32 + (c & 31)) * 2; }
__device__ __forceinline__ int v_rd_base(int lane) { return ((lane & 3) << 3) | (((lane >> 2) & 3) << 6) | (((lane >> 4) & 1) << 5) | (((lane >> 5) & 1) << 8); }
constexpr int v_rd_off(int d0, int ks, int half) { return d0 * 512 + ks * 4096 + half * 2048; }
template <int OFF> __device__ __forceinline__ s16x4 tr_read(int vb) {
    s16x4 r; asm volatile("ds_read_b64_tr_b16 %0, %1 offset:%2" : "=&v"(r) : "v"(vb), "i"(OFF) : "memory"); return r;
}
template <int D0> __device__ __forceinline__ void pv_one(f32x16& od, int vb, bf16x8 pa0, bf16x8 pa1, bf16x8 pa2, bf16x8 pa3) {
    const s16x4 l0 = tr_read<v_rd_off(D0, 0, 0)>(vb), h0 = tr_read<v_rd_off(D0, 0, 1)>(vb), l1 = tr_read<v_rd_off(D0, 1, 0)>(vb), h1 = tr_read<v_rd_off(D0, 1, 1)>(vb);
    const s16x4 l2 = tr_read<v_rd_off(D0, 2, 0)>(vb), h2 = tr_read<v_rd_off(D0, 2, 1)>(vb), l3 = tr_read<v_rd_off(D0, 3, 0)>(vb), h3 = tr_read<v_rd_off(D0, 3, 1)>(vb);
    asm volatile("s_waitcnt lgkmcnt(0)" ::: "memory"); SBAR();
#define PK(L, H) (bf16x8){L[0], L[1], L[2], L[3], H[0], H[1], H[2], H[3]}
    od = __builtin_amdgcn_mfma_f32_32x32x16_bf16(pa0, PK(l0, h0), od, 0, 0, 0);
    od = __builtin_amdgcn_mfma_f32_32x32x16_bf16(pa1, PK(l1, h1), od, 0, 0, 0);
    od = __builtin_amdgcn_mfma_f32_32x32x16_bf16(pa2, PK(l2, h2), od, 0, 0, 0);
    od = __builtin_amdgcn_mfma_f32_32x32x16_bf16(pa3, PK(l3, h3), od, 0, 0, 0);
#undef PK
}
__device__ __forceinline__ void pv_d0(f32x16* o, int vb, bf16x8 pa0, bf16x8 pa1, bf16x8 pa2, bf16x8 pa3) {
    pv_one<0>(o[0], vb, pa0, pa1, pa2, pa3); pv_one<1>(o[1], vb, pa0, pa1, pa2, pa3); pv_one<2>(o[2], vb, pa0, pa1, pa2, pa3); pv_one<3>(o[3], vb, pa0, pa1, pa2, pa3);
}

constexpr int OFF_CVT = 116 * 1024;   static_assert(OFF_CVT >= ATT_LDS, "side-job buffers behind the attention tiles");
struct CvtSide { const float* const* in; unsigned char* ws; LAS unsigned char* buf; int gw, t, tlim; bool pend; };
__device__ __forceinline__ void cvt_side_store(CvtSide& c, int lane) {
    const int t = c.t - 1, mat = t >> 4, i = t & 15, n = lane & 31, kh = lane >> 5, e = c.gw >> 7, w = c.gw & 127, f = (w >> 1) * 32 + n;
    unsigned char* d = c.ws + WS_WGU + (size_t)(e * 4096 + (f >> 2) * 8 + (f & 3) + mat * 4) * 1024 + (512 * (w & 1) + i * 32 + kh * 16);
    const LAS float* b = (const LAS float*)c.buf + kh * 512 + n; float x[16];
#pragma unroll
    for (int k = 0; k < 16; ++k) x[k] = b[k * 32] * 32.0f;
    u32x4 o; o.x = pk_fp8x4(x[0], x[1], x[2], x[3]); o.y = pk_fp8x4(x[4], x[5], x[6], x[7]); o.z = pk_fp8x4(x[8], x[9], x[10], x[11]); o.w = pk_fp8x4(x[12], x[13], x[14], x[15]);
    *(u32x4*)d = o;
    c.pend = false;
}
__device__ __forceinline__ void cvt_side_load(CvtSide& c, int lane) {
    const int t = c.t, mat = t >> 4, i = t & 15, row = lane >> 3, seg = lane & 7, e = c.gw >> 7, w = c.gw & 127;
    const float* s = c.in[26 + mat] + (size_t)e * 1024 * 2048 + (size_t)(512 * (w & 1) + i * 32 + row) * 2048 + (w >> 1) * 32 + seg * 4;
#pragma unroll
    for (int r = 0; r < 4; ++r) __builtin_amdgcn_global_load_lds((const unsigned*)(s + (size_t)(r * 8) * 2048), (LAS unsigned*)(c.buf + r * 1024), 16, 0, 0);
    ++c.t; c.pend = true;
}

__device__ __forceinline__ void attn_unit(const bf16_t* Qb, const bf16_t* Kh, const bf16_t* Vh, bf16_t* Ob, int seq, char* lds, CvtSide& cs, int mode, unsigned long long* bacc = nullptr) {
    const int tid = threadIdx.x, wid = tid >> 6, lane = tid & 63, r32 = lane & 31, hi = lane >> 5;
    char* V_lds = lds + OFF_V; char* K_lds = lds + OFF_K;
    float* ws = (float*)(lds + OFF_WS) + wid * 64; float* li_l = ws; float* al_l = ws + 32;
    float m_reg = -1e30f, l_reg = 0; f32x16 o[4] = {}; bf16x8 qr[4];
    const bf16_t* Qw = Qb + (long)(wid * QBLK + r32) * LD + hi * 8;
#pragma unroll
    for (int d0 = 0; d0 < 4; ++d0) qr[d0] = *reinterpret_cast<const bf16x8*>(Qw + d0 * 16);
    const int sr = tid >> 4, sc = (tid & 15) * 8, vst0 = v_st(sr, sc), vst1 = v_st(32 + sr, sc);
    const int kr = tid >> 3, kc = (tid & 7) * 8, kst = KSWZ(kr, kc * 2);
    const int vb0 = (int)(uintptr_t)V_lds + v_rd_base(lane);
    struct { bf16x8 vs0, vs1, ks0; } sr_[1];
#define SLOAD(i, k0) do { sr_[i].vs0 = *reinterpret_cast<const bf16x8*>(&Vh[(long)((k0) + sr) * LD + sc]); sr_[i].vs1 = *reinterpret_cast<const bf16x8*>(&Vh[(long)((k0) + 32 + sr) * LD + sc]); \
    sr_[i].ks0 = *reinterpret_cast<const bf16x8*>(&Kh[(long)((k0) + kr) * LD + kc]); } while (0)
#define SWRITE(bv, bk, i) do { *(bf16x8*)(V_lds + (bv) * SHM_V + vst0) = sr_[i].vs0; *(bf16x8*)(V_lds + (bv) * SHM_V + vst1) = sr_[i].vs1; \
    *(bf16x8*)(K_lds + (bk) * SHM_K + kst) = sr_[i].ks0; } while (0)
#define SWAIT() asm volatile("s_waitcnt vmcnt(3)" ::: "memory")
#define RESC(a) do { if (__any((a) < 1.f)) { if (hi == 0) al_l[r32] = (a); asm volatile("s_waitcnt lgkmcnt(0)" ::: "memory"); \
    _Pragma("unroll") for (int d = 0; d < 4; ++d) _Pragma("unroll") for (int r = 0; r < 16; ++r) o[d][r] *= al_l[crow(r, hi)]; } } while (0)
    f32x16 pA0, pA1, pB0, pB1; float alA, alB; bf16x8 pa0, pa1, pa2, pa3; const int NT = seq / KVBLK;
#define KOF(t) (((t) & 3) * SHM_K)
#define M5(x) ((x) >= 5 ? (x) - 5 : (x))
    { struct { bf16x8 vs0, vs1, ks0; } p_[3];
#pragma unroll
      for (int t = 0; t < 3; ++t) { p_[t].vs0 = *reinterpret_cast<const bf16x8*>(&Vh[(long)(t * KVBLK + sr) * LD + sc]); p_[t].vs1 = *reinterpret_cast<const bf16x8*>(&Vh[(long)(t * KVBLK + 32 + sr) * LD + sc]);
          p_[t].ks0 = *reinterpret_cast<const bf16x8*>(&Kh[(long)(t * KVBLK + kr) * LD + kc]); }
      SLOAD(0, 3 * KVBLK);
#pragma unroll
      for (int t = 0; t < 3; ++t) { *(bf16x8*)(V_lds + t * SHM_V + vst0) = p_[t].vs0; *(bf16x8*)(V_lds + t * SHM_V + vst1) = p_[t].vs1; *(bf16x8*)(K_lds + t * SHM_K + kst) = p_[t].ks0; } }
    ABAR();
    qkt(pA0, pA1, K_lds, qr, r32, hi); partialSM(pA0, pA1, m_reg, alA);
    ABAR();
    int vj = 1;
    for (int j = 1; j + 1 < NT; j += 2) {
        SWRITE(M5(vj + 2), (j + 2) & 3, 0);
        if (cs.pend) { if (SIDE_PROBE != 1) cvt_side_store(cs, lane); else cs.pend = false; }
        if (j + 3 < NT) SLOAD(0, (j + 3) * KVBLK);
        if ((j & 2) && cs.t < cs.tlim) { if (SIDE_PROBE != 2) cvt_side_load(cs, lane); else { ++cs.t; cs.pend = true; } }
        SBAR(); qkt(pB0, pB1, K_lds + KOF(j), qr, r32, hi);
        finishSM(pA0, pA1, alA, l_reg, pa0, pa1, pa2, pa3); SBAR();
        pv_d0(o, vb0 + M5(vj + 4) * SHM_V, pa0, pa1, pa2, pa3); partialSM(pB0, pB1, m_reg, alB);
        RESC(alB);
        if (j + 3 < NT) SWRITE(M5(vj + 3), (j + 3) & 3, 0);
        if (j + 4 < NT) SLOAD(0, (j + 4) * KVBLK);
        SBAR(); qkt(pA0, pA1, K_lds + KOF(j + 1), qr, r32, hi);
        finishSM(pB0, pB1, alB, l_reg, pa0, pa1, pa2, pa3); SBAR();
        pv_d0(o, vb0 + vj * SHM_V, pa0, pa1, pa2, pa3); partialSM(pA0, pA1, m_reg, alA);
        RESC(alA); { const unsigned long long b0_ = bacc ? __builtin_amdgcn_s_memtime() : 0ull; ABAR(); if (bacc) *bacc += __builtin_amdgcn_s_memtime() - b0_; }
        vj = M5(vj + 2);
    }
    SBAR(); qkt(pB0, pB1, K_lds + KOF(NT - 1), qr, r32, hi);
    finishSM(pA0, pA1, alA, l_reg, pa0, pa1, pa2, pa3); SBAR();
    pv_d0(o, vb0 + M5(vj + 4) * SHM_V, pa0, pa1, pa2, pa3); partialSM(pB0, pB1, m_reg, alB);
    RESC(alB);
    finishSM(pB0, pB1, alB, l_reg, pa0, pa1, pa2, pa3); SBAR();
    pv_d0(o, vb0 + vj * SHM_V, pa0, pa1, pa2, pa3);
#undef KOF
#undef M5
    if (hi == 0) li_l[r32] = l_reg; asm volatile("s_waitcnt lgkmcnt(0)" ::: "memory");
    float rli[16];
#pragma unroll
    for (int r = 0; r < 16; ++r) rli[r] = __builtin_amdgcn_rcpf(li_l[crow(r, hi)]);
    bf16_t* Ow = Ob + (long)(wid * QBLK) * LD;
    if (mode == 0) {
#pragma unroll
        for (int r = 0; r < 16; ++r) { const int orow = crow(r, hi);
#pragma unroll
            for (int d0 = 0; d0 < 4; ++d0) Ow[(long)orow * LD + d0 * 32 + r32] = (bf16_t)(cvt_pk_bf16(o[d0][r] * rli[r], 0.f) & 0xffffu); }
    } else {
        int hi2 = hi, r32b = r32; asm volatile("" : "+v"(hi2), "+v"(r32b));
        const float* subln = cs.in[21]; const float lam = *(const float*)(cs.ws + WS_MISC);
        const long off_ = Ob - (const bf16_t*)(cs.ws + WS_OC); bf16_t* Yb = (bf16_t*)(cs.ws + WS_YB) + off_;
        float sw[4];
#pragma unroll
        for (int d0 = 0; d0 < 4; ++d0) sw[d0] = subln[d0 * 32 + r32b] * 0.8f;
        bf16_t* Yw = Yb + (long)(wid * QBLK) * LD;
#pragma unroll
        for (int rq = 0; rq < 16; rq += 4) { bf16_t o1[4][4];
#pragma unroll
            for (int q = 0; q < 4; ++q)
#pragma unroll
                for (int d0 = 0; d0 < 4; ++d0) o1[d0][q] = __builtin_nontemporal_load(&Ow[(long)crow(rq + q, hi2) * LD + d0 * 32 + r32b]);
            __builtin_amdgcn_sched_barrier(0);
#pragma unroll
            for (int q = 0; q < 4; ++q) { const int r = rq + q; float d[4], ss = 0.f;
#pragma unroll
                for (int d0 = 0; d0 < 4; ++d0) { d[d0] = bf2f(o1[d0][q]) - lam * (o[d0][r] * rli[r]); ss += d[d0] * d[d0]; }
                ss += dpp_f<DPP_XOR1>(ss); ss += dpp_f<DPP_XOR2>(ss); ss += dpp_f<DPP_HMIRROR>(ss); ss += dpp_f<DPP_MIRROR>(ss); ss = swap16_sum(ss, ss);
                const float rstd = rsqrtf(ss * (1.0f / 128.0f) + EPS);
#pragma unroll
                for (int d0 = 0; d0 < 4; ++d0) __builtin_nontemporal_store((bf16_t)(cvt_pk_bf16(d[d0] * rstd * sw[d0], 0.f) & 0xffffu), &Yw[(long)crow(r, hi2) * LD + d0 * 32 + r32b]); }
            asm volatile("" ::: "memory"); __builtin_amdgcn_sched_barrier(0); }
    }
    __syncthreads();
#undef SLOAD
#undef SWRITE
#undef SWAIT
#undef RESC
}
#undef KSWZ
#undef SBAR
#undef ABAR
}


#define XB_TMO      128
#define XB_XCNT(j)  (256  + 64 * (j))
#define XB_XSUB(j)  (1280 + 64 * (j))
#define XB_XGEN(j)  (2304 + 64 * (j))
#define XB_TOP      3328
#define XB_TOPGEN   3392
#define XCD_BAR_WORDS 3456
#define XB_SPIN_CAP (1u << 18)

__device__ __forceinline__ unsigned xb_ld(unsigned* p)              { return __hip_atomic_load(p, __ATOMIC_RELAXED, __HIP_MEMORY_SCOPE_AGENT); }
__device__ __forceinline__ unsigned xb_add(unsigned* p, unsigned v) { return __hip_atomic_fetch_add(p, v, __ATOMIC_RELAXED, __HIP_MEMORY_SCOPE_AGENT); }
__device__ __forceinline__ unsigned xb_xcc_id() { return (unsigned)__builtin_amdgcn_s_getreg((3 << 11) | 20) & 0xFu; }
#define XB_SPIN(cond, bar) do { unsigned _sp = 0; while (cond) { __builtin_amdgcn_s_sleep(1); \
    if ((++_sp & 255u) == 0u) { if (xb_ld(&(bar)[XB_TMO])) break; if (_sp > XB_SPIN_CAP) { atomicAdd(&(bar)[XB_TMO], 1u); break; } } } } while (0)

struct XcdBarrier {
    unsigned* bar; unsigned x;
    volatile LAS unsigned* st;
};

__device__ __forceinline__ XcdBarrier xcd_barrier_post(unsigned* bar, volatile LAS unsigned* st) {
    XcdBarrier b; b.bar = bar; b.x = xb_xcc_id(); b.st = st;
    if (threadIdx.x == 0) (void)xb_add(&bar[XB_XCNT(b.x)], 1u);
    return b;
}
__device__ __forceinline__ void xcd_barrier_complete(unsigned* bar, unsigned x, unsigned& nloc, unsigned& nx) {
    const unsigned G = gridDim.x * gridDim.y * gridDim.z;
    unsigned sum, cnt, mine, sp = 0u;
    for (;;) {
        sum = 0u; cnt = 0u; mine = 0u;
#pragma unroll
        for (unsigned j = 0; j < 16; ++j) { const unsigned c = xb_ld(&bar[XB_XCNT(j)]); sum += c; cnt += (c > 0u) ? 1u : 0u; mine = (j == x) ? c : mine; }
        if (sum == G) break;
        __builtin_amdgcn_s_sleep(1);
        if ((++sp & 255u) == 0u) { if (xb_ld(&bar[XB_TMO])) break; if (sp > XB_SPIN_CAP) { atomicAdd(&bar[XB_TMO], 1u); break; } }
    }
    nloc = mine > 0u ? mine : 1u; nx = cnt > 0u ? cnt : 1u;
}

__device__ __forceinline__ void xcd_barrier(const XcdBarrier& b) {
    asm volatile("s_waitcnt vmcnt(0)" ::: "memory");
    __syncthreads();
    if (threadIdx.x == 0) {
        unsigned* bar = b.bar;
        __builtin_amdgcn_s_waitcnt(0);
        unsigned nloc = b.st[0], nx = b.st[1];
        if (nloc == 0u) { xcd_barrier_complete(bar, b.x, nloc, nx); b.st[0] = nloc; b.st[1] = nx; }
        const unsigned old = xb_add(&bar[XB_XSUB(b.x)], 1u);
        const unsigned gen = old / nloc;
        if (old + 1u == (gen + 1u) * nloc) {
            __builtin_amdgcn_fence(__ATOMIC_RELEASE, "agent");
            asm volatile("s_waitcnt vmcnt(0)" ::: "memory");
            const unsigned og = xb_add(&bar[XB_TOP], 1u);
            const unsigned tg = og / nx;
            if (og + 1u == (tg + 1u) * nx) xb_add(&bar[XB_TOPGEN], 1u);
            else XB_SPIN(xb_ld(&bar[XB_TOPGEN]) == tg, bar);
            __builtin_amdgcn_fence(__ATOMIC_ACQUIRE, "agent");
            xb_add(&bar[XB_XGEN(b.x)], 1u);
            asm volatile("s_waitcnt vmcnt(0)" ::: "memory");
        } else {
            XB_SPIN(xb_ld(&bar[XB_XGEN(b.x)]) == gen, bar);
            __builtin_amdgcn_fence(__ATOMIC_ACQUIRE, "agent");
            asm volatile("s_waitcnt vmcnt(0)" ::: "memory");
        }
    }
    __syncthreads();
}


struct Args { const float* in[29]; float* out; unsigned char* ws; int ph_lo, ph_hi; };
enum { I_X = 0, I_C, I_CTX, I_CCTX, I_WADA, I_BADA, I_NPREMIX, I_NPOSTMIX, I_NPREFFN, I_NPOSTFFN, I_WIN, I_LAMRE, I_LAMIM, I_LOGDT, I_BRE, I_BIM,
       I_CRE, I_CIM, I_S5D, I_WGLU, I_DALAM, I_SUBLN, I_WPA, I_WPB, I_WOUT, I_WROUTER, I_WEG, I_WEU, I_WED };

__device__ __forceinline__ unsigned pk2(float lo, float hi) { return cvt_pk_bf16(lo, hi); }
__device__ __forceinline__ void transpose_item(const float* colp, size_t ld, bf16_t* dst, int dK, LAS float* scr, int lane) {
#pragma unroll 8
    for (int kk = 0; kk < 64; ++kk) scr[kk * 65 + lane] = colp[(size_t)kk * ld];
    asm volatile("s_waitcnt lgkmcnt(0)" ::: "memory");
    const int c = lane & 7;
#pragma unroll
    for (int j = 0; j < 8; ++j) { const int n = (lane >> 3) + 8 * j; const LAS float* s = scr + (8 * c) * 65 + n;
        u32x4 o; o.x = pk2(s[0 * 65], s[1 * 65]); o.y = pk2(s[2 * 65], s[3 * 65]); o.z = pk2(s[4 * 65], s[5 * 65]); o.w = pk2(s[6 * 65], s[7 * 65]);
        *(u32x4*)(dst + (size_t)n * dK + 8 * c) = o; }
    asm volatile("s_waitcnt lgkmcnt(0)" ::: "memory");
}
__device__ __forceinline__ void cvt_item(const float* src, size_t ld, bf16_t* dst, size_t dK, int rstep, int lane) {
    const int ng = lane & 15, kg = lane >> 4;
    f32x4 v[2][8];
#pragma unroll
    for (int h = 0; h < 2; ++h)
#pragma unroll
        for (int i = 0; i < 8; ++i) v[h][i] = __builtin_nontemporal_load((const f32x4*)(src + (size_t)(h * 32 + kg * 8 + i) * ld + ng * 4));
#pragma unroll
    for (int h = 0; h < 2; ++h)
#pragma unroll
        for (int j = 0; j < 4; ++j) { u32x4 o; o.x = cvt_pk_bf16(v[h][0][j], v[h][1][j]); o.y = cvt_pk_bf16(v[h][2][j], v[h][3][j]); o.z = cvt_pk_bf16(v[h][4][j], v[h][5][j]); o.w = cvt_pk_bf16(v[h][6][j], v[h][7][j]);
            *(u32x4*)(dst + (size_t)(ng * rstep + j) * dK + h * 32 + kg * 8) = o; }
}
__device__ __forceinline__ void cvt_item8(const float* src, size_t ld, unsigned char* dst, size_t dK, int rstep, float scale, int lane) {
    const int ng = lane & 15, kg = lane >> 4;
    f32x4 v[16];
#pragma unroll
    for (int i = 0; i < 16; ++i) v[i] = __builtin_nontemporal_load((const f32x4*)(src + (size_t)(kg * 16 + i) * ld + ng * 4));
#pragma unroll
    for (int j = 0; j < 4; ++j) { u32x4 o; o.x = pk_fp8x4(v[0][j] * scale, v[1][j] * scale, v[2][j] * scale, v[3][j] * scale); o.y = pk_fp8x4(v[4][j] * scale, v[5][j] * scale, v[6][j] * scale, v[7][j] * scale);
        o.z = pk_fp8x4(v[8][j] * scale, v[9][j] * scale, v[10][j] * scale, v[11][j] * scale); o.w = pk_fp8x4(v[12][j] * scale, v[13][j] * scale, v[14][j] * scale, v[15][j] * scale);
        __builtin_nontemporal_store(o, (u32x4*)(dst + (size_t)(ng * rstep + j) * dK + kg * 16)); }
}
__device__ __forceinline__ int permq(int n) { const int p = n & 31, a = p >> 3, b = p & 7; return (n & ~31) + ((b < 4) ? (4 * a + b) : (16 + 4 * a + (b - 4))); }

__device__ __forceinline__ void mod_task(int col0, const float* c, const float* cctx, const float* wada, const float* bada, float* MOD, LAS float* L) {
    const int tid = threadIdx.x;
    LAS float* sc = L; LAS float* red = L + 9 * 1024;
    for (int i = tid; i < 9 * 1024; i += 512) { const int row = i >> 10, k = i & 1023; const float v = row < 8 ? c[row * 1024 + k] : cctx[k]; sc[i] = v * sigmoidf_(v); }
    __syncthreads();
    const int cl = tid & 31, kg = tid >> 5, col = col0 + cl;
    float acc[9];
#pragma unroll
    for (int r = 0; r < 9; ++r) acc[r] = 0.f;
#pragma unroll 64
    for (int k = kg; k < 1024; k += 16) { const float w = __builtin_nontemporal_load(&wada[(size_t)k * 6144 + col]);
#pragma unroll
        for (int r = 0; r < 9; ++r) acc[r] += sc[r * 1024 + k] * w; }
#pragma unroll
    for (int r = 0; r < 9; ++r) red[(kg * 9 + r) * 32 + cl] = acc[r];
    __syncthreads();
    if (tid < 288) { const int r = tid >> 5, cc = tid & 31; float s = 0.f;
#pragma unroll
        for (int g = 0; g < 16; ++g) s += red[(g * 9 + r) * 32 + cc];
        MOD[r * 6144 + col0 + cc] = s + bada[col0 + cc]; }
    __syncthreads();
}

__device__ __forceinline__ void s5_tables_task(int g, int dir, const Args& A, bf16_t* Bcat, bf16_t* Wcat, LAS float* L, int hlo = 0, int hn = 2) {
    const int tid = threadIdx.x;
    constexpr int CP = 68;
    LAS float* pw_re = L; LAS float* pw_im = L + 1088; LAS float* Bb_re = L + 2176; LAS float* Bb_im = L + 3200; LAS float* C_re = L + 4224; LAS float* C_im = L + 5312;
    LAS float* Kt = L + 6400; LAS float* K0o = L + 10496; LAS float* Bb2_re = L + 10752; LAS float* Bb2_im = L + 11776; LAS float* C2_re = L + 12800; LAS float* C2_im = L + 13824;
    const float* lam_re = A.in[I_LAMRE]; const float* lam_im = A.in[I_LAMIM]; const float* log_dt = A.in[I_LOGDT];
    const float* b_re = A.in[I_BRE]; const float* b_im = A.in[I_BIM]; const float* c_re = A.in[I_CRE]; const float* c_im = A.in[I_CIM]; const float* s5d = A.in[I_S5D];
    { const int which = tid >> 8, p = (tid >> 2) & 63, hq = tid & 3, d = which ? 1 - dir : dir;
      if (which == 0 || dir == 0) { const int gi = d * 32 + g;
        const float lr = fminf(lam_re[gi * 64 + p], -1e-4f), li = lam_im[gi * 64 + p], dt = expf(log_dt[gi]);
        const f32x4 br = *(const f32x4*)(b_re + (size_t)(gi * 64 + p) * 16 + hq * 4), bi = *(const f32x4*)(b_im + (size_t)(gi * 64 + p) * 16 + hq * 4);
        const float lrd = lr * dt, lid = li * dt;
        float sn, cs; sincos_fast(lid, &sn, &cs); const float mag = expf(lrd);
        const float lb_re = mag * cs, lb_im = mag * sn, den = lr * lr + li * li, num_re = lb_re - 1.0f;
        const float co_re = (num_re * lr + lb_im * li) / den, co_im = (lb_im * lr - num_re * li) / den;
        LAS float* dre = which ? Bb2_re : Bb_re; LAS float* dim_ = which ? Bb2_im : Bb_im;
        *(LAS f32x4*)(dre + p * 16 + hq * 4) = co_re * br - co_im * bi; *(LAS f32x4*)(dim_ + p * 16 + hq * 4) = co_re * bi + co_im * br; } }
    for (int i = tid; i < 1088; i += 512) { const int tau = i >> 6, p = i & 63, gi = dir * 32 + g;
        const float lr = fminf(lam_re[gi * 64 + p], -1e-4f), li = lam_im[gi * 64 + p], dt = expf(log_dt[gi]), lrd = lr * dt, lid = li * dt;
        float s2, c2; sincos_fast((float)tau * lid, &s2, &c2); const float m2 = expf((float)tau * lrd);
        pw_re[i] = m2 * c2; pw_im[i] = m2 * s2; }
    for (int i = tid; i < 1024; i += 512) { const int ci_ = (i >> 6) * CP + (i & 63); C_re[ci_] = c_re[(dir * 32 + g) * 1024 + i]; C_im[ci_] = c_im[(dir * 32 + g) * 1024 + i];
        if (dir == 0) { C2_re[i] = c_re[(32 + g) * 1024 + i]; C2_im[i] = c_im[(32 + g) * 1024 + i]; } }
    __syncthreads();
    { const int tau = tid >> 5, chp = (tid >> 1) & 15, ch0 = (tid & 1) * 8; f32x4 a0 = {0.f, 0.f, 0.f, 0.f}, a1 = {0.f, 0.f, 0.f, 0.f};
#pragma unroll 2
      for (int p = 0; p < 64; p += 4) { const f32x4 cr = *(const LAS f32x4*)(C_re + chp * CP + p), ci = *(const LAS f32x4*)(C_im + chp * CP + p), wr_ = *(const LAS f32x4*)(pw_re + tau * 64 + p), wi = *(const LAS f32x4*)(pw_im + tau * 64 + p);
          const f32x4 tr = cr * wr_ - ci * wi, ti = cr * wi + ci * wr_;
#pragma unroll
          for (int q = 0; q < 4; ++q) { const LAS float* br = Bb_re + (p + q) * 16 + ch0; const LAS float* bi = Bb_im + (p + q) * 16 + ch0;
              a0 += tr[q] * *(const LAS f32x4*)br - ti[q] * *(const LAS f32x4*)bi; a1 += tr[q] * *(const LAS f32x4*)(br + 4) - ti[q] * *(const LAS f32x4*)(bi + 4); } }
      *(LAS f32x4*)(Kt + tau * 256 + chp * 16 + ch0) = a0; *(LAS f32x4*)(Kt + tau * 256 + chp * 16 + ch0 + 4) = a1; }
    if (dir == 0 && tid < 256) { const int chp = tid >> 4, ch = tid & 15; float acc = 0.f;
#pragma unroll 4
        for (int p = 0; p < 64; ++p) acc += C2_re[chp * 64 + p] * Bb2_re[p * 16 + ch] - C2_im[chp * 64 + p] * Bb2_im[p * 16 + ch];
        K0o[tid] = acc + (chp == ch ? s5d[g * 16 + ch] : 0.f); }
    __syncthreads();
    bf16_t* Wg = Wcat + (size_t)g * 256 * 512;
#pragma unroll 1
    for (int j = 8 * hlo; j < 8 * (hlo + hn); ++j) { const int q = tid + 512 * j, n = q >> 5, kc = q & 31, s = kc >> 1, ch0 = (kc & 1) * 8, t = n >> 4, chp = n & 15;
        const bool mine = (dir == 0) ? (s <= t) : (s > t);
        if (mine) { float v[8]; const int tau = (dir == 0) ? (t - s) : (s - t);
#pragma unroll
            for (int i = 0; i < 8; ++i) { v[i] = Kt[tau * 256 + chp * 16 + ch0 + i]; if (tau == 0) v[i] += K0o[chp * 16 + ch0 + i]; }
            u32x4 o; o.x = pk2(v[0], v[1]); o.y = pk2(v[2], v[3]); o.z = pk2(v[4], v[5]); o.w = pk2(v[6], v[7]);
            *(u32x4*)(Wg + (size_t)n * 512 + kc * 8) = o; } }
#pragma unroll 1
    for (int j = 4 * hlo; j < 4 * (hlo + hn); ++j) { const int q = tid + 512 * j, n = q >> 4, pc = q & 15, ri = pc >> 3, p0 = (pc & 7) * 8, t = n >> 4, chp = n & 15, e = (dir == 0) ? (t + 1) : (16 - t);
        float v[8];
#pragma unroll
        for (int i = 0; i < 8; ++i) { const int p = p0 + i; const float cr = C_re[chp * CP + p], ci = C_im[chp * CP + p], wr_ = pw_re[e * 64 + p], wi = pw_im[e * 64 + p];
            v[i] = (ri == 0) ? (cr * wr_ - ci * wi) : -(cr * wi + ci * wr_); }
        u32x4 o; o.x = pk2(v[0], v[1]); o.y = pk2(v[2], v[3]); o.z = pk2(v[4], v[5]); o.w = pk2(v[6], v[7]);
        *(u32x4*)(Wg + (size_t)n * 512 + 256 + dir * 128 + ri * 64 + p0) = o; }
    bf16_t* Bg = Bcat + (size_t)g * 256 * 256;
#pragma unroll 1
    for (int j = 4 * hlo; j < 4 * (hlo + hn); ++j) { const int q = tid + 512 * j, nl = q >> 5, ri = nl >> 6, p = nl & 63, kc = q & 31, s = kc >> 1, ch0 = (kc & 1) * 8, e = (dir == 0) ? (15 - s) : s;
        const float wr_ = pw_re[e * 64 + p], wi = pw_im[e * 64 + p]; float v[8];
#pragma unroll
        for (int i = 0; i < 8; ++i) { const float br = Bb_re[p * 16 + ch0 + i], bi = Bb_im[p * 16 + ch0 + i]; v[i] = (ri == 0) ? (wr_ * br - wi * bi) : (wr_ * bi + wi * br); }
        u32x4 o; o.x = pk2(v[0], v[1]); o.y = pk2(v[2], v[3]); o.z = pk2(v[4], v[5]); o.w = pk2(v[6], v[7]);
        *(u32x4*)(Bg + (size_t)(dir * 128 + 2 * p + ri) * 256 + kc * 8) = o; }
    __syncthreads();
}

struct SchedWin { int i, G, c; const char* A; const char* B;
    __device__ __forceinline__ bool next(Unit& u) { const int L = i * G + c; ++i; int pn, b;
        if (L < 2048) { int pm; map_tile(L, 128, 16, pm, pn); b = pm >> 4; u.r0 = (b * 17 + 1 + (pm & 15)) * 256; }
        else if (L < 2096) { const int l = L - 2048, s = l % 6; b = l / 6; pn = s < 2 ? s : s + 2; u.r0 = b * 17 * 256; }
        else return false;
        u.c0 = pn * 256; u.aux = b; u.a = A + (size_t)u.r0 * 2048; u.b = B + (size_t)u.c0 * 2048; return true; } };
struct EpiWin { static constexpr bool PERM = true;
    bf16_t *UH, *Q, *K, *V, *G; const float* rope;
    __device__ __forceinline__ static u32x4 pk8(const f32x4& v0, const f32x4& v1) { u32x4 w; w.x = cvt_pk_bf16(v0[0], v0[1]); w.y = cvt_pk_bf16(v0[2], v0[3]); w.z = cvt_pk_bf16(v1[0], v1[1]); w.w = cvt_pk_bf16(v1[2], v1[3]); return w; }
    __device__ __forceinline__ bool operator()(f32x4 (&acc)[2][2][4][2], const Unit& u, int wr, int wc, int fr, int fq) const {
        const int pn = u.c0 >> 8, b = u.aux, tt0 = u.r0 - b * LT;
        if (pn < 2) {
#pragma unroll
            for (int ai = 0; ai < 2; ++ai)
#pragma unroll
                for (int m = 0; m < 4; ++m) { const int tt = tt0 + ai * 128 + wr * 64 + m * 16 + fr;
#pragma unroll
                    for (int bj = 0; bj < 2; ++bj) { const int c = u.c0 + bj * 128 + wc * 32 + 8 * fq, g = c >> 4, half = (c >> 3) & 1;
                        *(u32x4*)(UH + (((size_t)(b * 32 + g) * NCH + (tt >> 4)) * 512 + (tt & 15) * 16 + half * 8)) = pk8(acc[ai][bj][m][0], acc[ai][bj][m][1]); } }
        } else if (pn < 6) { const bool isq = pn < 4; bf16_t* dst0 = (isq ? Q : K); const float sc = isq ? QSCALE : 1.0f;
            if (tt0 >= CL) {
#pragma unroll
                for (int ai = 0; ai < 2; ++ai) { f32x4 cs[4], sn[4]; const bool gi = (wc & 1) != 0;
#pragma unroll
                    for (int m = 0; m < 4; ++m) { const int t = tt0 + ai * 128 + wr * 64 + m * 16 + fr - CL; const float* rp = rope + (gi ? (t & 63) : (t >> 6)) * 32 + 4 * fq;
                        cs[m] = *(const f32x4*)rp; sn[m] = *(const f32x4*)(rp + 16); }
                    __builtin_amdgcn_sched_barrier(0);
#pragma unroll
                    for (int m = 0; m < 4; ++m) { const size_t r = (size_t)u.r0 + ai * 128 + wr * 64 + m * 16 + fr;
#pragma unroll
                        for (int bj = 0; bj < 2; ++bj) { const int c = u.c0 + bj * 128 + wc * 32 + 8 * fq, cq = (c - 512) & 511; const f32x4 v0 = acc[ai][bj][m][0], v1 = acc[ai][bj][m][1];
                            *(u32x4*)(dst0 + r * 512 + cq) = pk8((v0 * cs[m] - v1 * sn[m]) * sc, (v1 * cs[m] + v0 * sn[m]) * sc); } } }
            } else {
#pragma unroll
                for (int ai = 0; ai < 2; ++ai)
#pragma unroll
                    for (int m = 0; m < 4; ++m) { const size_t r = (size_t)u.r0 + ai * 128 + wr * 64 + m * 16 + fr;
#pragma unroll
                        for (int bj = 0; bj < 2; ++bj) { const int c = u.c0 + bj * 128 + wc * 32 + 8 * fq, cq = (c - 512) & 511;
                            *(u32x4*)(dst0 + r * 512 + cq) = pk8(acc[ai][bj][m][0], acc[ai][bj][m][1]); } } }
        } else if (pn < 8) {
#pragma unroll
            for (int ai = 0; ai < 2; ++ai)
#pragma unroll
                for (int m = 0; m < 4; ++m) { const size_t r = (size_t)u.r0 + ai * 128 + wr * 64 + m * 16 + fr;
#pragma unroll
                    for (int bj = 0; bj < 2; ++bj) { const int c = u.c0 + bj * 128 + wc * 32 + 8 * fq; *(u32x4*)(V + r * 512 + (c - 1536)) = pk8(acc[ai][bj][m][0], acc[ai][bj][m][1]); } }
        } else { const int lt = b * 16 + (tt0 >> 8) - 1, T = pn - 8;
#pragma unroll
            for (int ai = 0; ai < 2; ++ai)
#pragma unroll
                for (int m = 0; m < 4; ++m) { f32x4 r0, r1, b0, b1;
#pragma unroll
                    for (int j = 0; j < 4; ++j) { const float sa0 = sigmoidf_(acc[ai][0][m][0][j]), sa1 = sigmoidf_(acc[ai][0][m][1][j]); b0[j] = sigmoidf_(acc[ai][1][m][0][j]); b1[j] = sigmoidf_(acc[ai][1][m][1][j]);
                        r0[j] = sa0 * __builtin_amdgcn_rcpf(fmaxf(b0[j], 1e-20f)); r1[j] = sa1 * __builtin_amdgcn_rcpf(fmaxf(b1[j], 1e-20f)); }
                    bf16_t* gp = G + (((((((size_t)(lt * 8 + (T >> 1)) * 2 + ai) * 4 + m) * 2 + (T & 1)) * 8 + (wr * 4 + wc)) * 64 + (fq * 16 + fr)) * 8);
                    __builtin_nontemporal_store(pk8(r0, r1), (u32x4*)gp); __builtin_nontemporal_store(pk8(b0, b1), (u32x4*)(gp + 4 * 65536)); } }
        return true; } };

struct SchedS5a { int i, G, c; const char* UH; const char* Bcat;
    __device__ __forceinline__ bool next(Unit& u) { const int L = i * G + c; ++i; if (L >= 512) return false; const int bg = L >> 1, row0 = (L & 1) * 16;
        u.r0 = bg * NCH + row0; u.c0 = 0; u.aux = 0; u.a = UH + (size_t)u.r0 * 1024; u.b = Bcat + (size_t)(bg & 31) * 256 * 256 * 2; return true; } };
struct EpiS5a { static constexpr bool PERM = true; bf16_t* S;
    __device__ __forceinline__ static u32x4 pk8(const f32x4& v0, const f32x4& v1) { u32x4 w; w.x = cvt_pk_bf16(v0[0], v0[1]); w.y = cvt_pk_bf16(v0[2], v0[3]); w.z = cvt_pk_bf16(v1[0], v1[1]); w.w = cvt_pk_bf16(v1[2], v1[3]); return w; }
    __device__ __forceinline__ bool operator()(f32x4 (&acc)[2][2][4][2], const Unit& u, int wr, int wc, int fr, int fq) const {
        if (u.aux != 0) {
            if (wr == 1) { bf16_t* rowp = S + ((size_t)u.r0 + 240 + fr) * 256 + wc * 32 + 8 * fq;
#pragma unroll
                for (int bj = 0; bj < 2; ++bj) *(u32x4*)(rowp + bj * 128) = pk8(acc[1][bj][3][0], acc[1][bj][3][1]); }
            return true; }
#pragma unroll
        for (int ai = 0; ai < 2; ++ai)
#pragma unroll
            for (int m = 0; m < 4; ++m) { bf16_t* rowp = S + ((size_t)u.r0 + ai * 128 + wr * 64 + m * 16 + fr) * 256 + wc * 32 + 8 * fq;
#pragma unroll
                for (int bj = 0; bj < 2; ++bj) *(u32x4*)(rowp + bj * 128) = pk8(acc[ai][bj][m][0], acc[ai][bj][m][1]); }
        return true; } };

struct SchedS5aB { int i, bg; const char* UH; const char* Bcat;
    __device__ __forceinline__ bool next(Unit& u) { if (i >= 2) return false; const int row0 = i * 16; ++i;
        u.r0 = bg * NCH + row0; u.c0 = 0; u.aux = row0; u.a = UH + (size_t)u.r0 * 1024; u.b = Bcat + (size_t)(bg & 31) * 256 * 256 * 2; return true; } };
struct SchedS5cB { int i, bg; const char* UH; const char* Wcat;
    __device__ __forceinline__ bool next(Unit& u) { if (i >= 1) return false; ++i;
        u.r0 = (bg >> 5) * SEQ; u.c0 = 0; u.aux = bg & 31; u.a = UH + ((size_t)bg * NCH + 16) * 1024; u.b = Wcat + (size_t)(bg & 31) * 256 * 512 * 2; return true; } };
struct SchedS5c { int i, G, c; const char* UH; const char* Wcat;
    __device__ __forceinline__ bool next(Unit& u) { const int L = i * G + c; ++i; if (L >= 256) return false; const int bg = L;
        u.r0 = (bg >> 5) * SEQ; u.c0 = 0; u.aux = bg & 31; u.a = UH + ((size_t)bg * NCH + 16) * 1024; u.b = Wcat + (size_t)(bg & 31) * 256 * 512 * 2; return true; } };
struct EpiS5c { static constexpr bool PERM = true; bf16_t* YA;
    __device__ __forceinline__ bool operator()(f32x4 (&acc)[2][2][4][2], const Unit& u, int wr, int wc, int fr, int fq) const {
#pragma unroll
        for (int ai = 0; ai < 2; ++ai)
#pragma unroll
            for (int m = 0; m < 4; ++m) { const int chunk = ai * 128 + wr * 64 + m * 16 + fr;
#pragma unroll
                for (int bj = 0; bj < 2; ++bj) { const int cl = bj * 128 + wc * 32 + 8 * fq, tok = cl >> 4, half = (cl >> 3) & 1; const f32x4 v0 = acc[ai][bj][m][0], v1 = acc[ai][bj][m][1];
                    u32x4 w; w.x = cvt_pk_bf16(gelu_tanh(v0[0]), gelu_tanh(v0[1])); w.y = cvt_pk_bf16(gelu_tanh(v0[2]), gelu_tanh(v0[3]));
                    w.z = cvt_pk_bf16(gelu_tanh(v1[0]), gelu_tanh(v1[1])); w.w = cvt_pk_bf16(gelu_tanh(v1[2]), gelu_tanh(v1[3]));
                    *(u32x4*)(YA + ((size_t)u.r0 + chunk * 16 + tok) * 512 + u.aux * 16 + half * 8) = w; } }
        return true; } };

struct SchedGlu { int i, G, c; const char* YA; const char* W;
    __device__ __forceinline__ bool next(Unit& u) { const int L = i * G + c; ++i; if (L >= 256) return false; int pm, pn; map_tile(L, 128, 2, pm, pn);
        u.r0 = pm * 256; u.c0 = pn * 256; u.aux = 0; u.a = YA + (size_t)u.r0 * 1024; u.b = W + (size_t)u.c0 * 1024; return true; } };
struct EpiGlu { static constexpr bool PERM = true; const bf16_t* YA; bf16_t* YY;
    __device__ __forceinline__ bool operator()(f32x4 (&acc)[2][2][4][2], const Unit& u, int wr, int wc, int fr, int fq) const {
#pragma unroll
        for (int ai = 0; ai < 2; ++ai) { u32x4 ya[4][2];
#pragma unroll
            for (int m = 0; m < 4; ++m)
#pragma unroll
                for (int bj = 0; bj < 2; ++bj) ya[m][bj] = *(const u32x4*)(YA + ((size_t)u.r0 + ai * 128 + wr * 64 + m * 16 + fr) * 512 + u.c0 + bj * 128 + wc * 32 + 8 * fq);
            __builtin_amdgcn_sched_barrier(0);
#pragma unroll
            for (int m = 0; m < 4; ++m) { const size_t r = (size_t)u.r0 + ai * 128 + wr * 64 + m * 16 + fr;
#pragma unroll
                for (int bj = 0; bj < 2; ++bj) { const int c = u.c0 + bj * 128 + wc * 32 + 8 * fq; const f32x4 v0 = acc[ai][bj][m][0], v1 = acc[ai][bj][m][1]; const u32x4 a = ya[m][bj]; u32x4 w;
                    w.x = cvt_pk_bf16(bf_lo(a.x) * sigmoidf_(v0[0]), bf_hi(a.x) * sigmoidf_(v0[1])); w.y = cvt_pk_bf16(bf_lo(a.y) * sigmoidf_(v0[2]), bf_hi(a.y) * sigmoidf_(v0[3]));
                    w.z = cvt_pk_bf16(bf_lo(a.z) * sigmoidf_(v1[0]), bf_hi(a.z) * sigmoidf_(v1[1])); w.w = cvt_pk_bf16(bf_lo(a.w) * sigmoidf_(v1[2]), bf_hi(a.w) * sigmoidf_(v1[3]));
                    *(u32x4*)(YY + r * 512 + c) = w; } }
            asm volatile("" ::: "memory"); }
        return true; } };

struct SchedProj { int i, G, c, part, pm, pn; const char* YG; const char* YB; const char* WA; const char* WB;
    __device__ __forceinline__ bool next(Unit& u) {
        if (part == 0) { const int L = i * G + c; if (L >= 512) return false; map_tile(L, 128, 4, pm, pn); }
        u.r0 = pm * 256; u.c0 = pn * 256; u.aux = part; u.a = (part ? YB : YG) + (size_t)u.r0 * 1024; u.b = (part ? WB : WA) + (size_t)u.c0 * 1024;
        if (part) ++i; part ^= 1; return true; } };
struct EpiProj { static constexpr bool PERM = true; const bf16_t* G; bf16_t* M;
    __device__ __forceinline__ bool operator()(f32x4 (&acc)[2][2][4][2], const Unit& u, int wr, int wc, int fr, int fq) const {
        const bf16_t* gt = G + (unsigned)(((u.r0 >> 8) * 8 + (u.c0 >> 8)) * 65536 + (wr * 4 + wc) * 512 + (fq * 16 + fr) * 8);
        if (u.aux == 0) {
            u32x4 gr[2][4][2];
#pragma unroll
            for (int ai = 0; ai < 2; ++ai)
#pragma unroll
                for (int m = 0; m < 4; ++m)
#pragma unroll
                    for (int bj = 0; bj < 2; ++bj) gr[ai][m][bj] = *(const u32x4*)(gt + (unsigned)((((ai * 4 + m) * 2 + bj) * 8) * 512));
            __builtin_amdgcn_sched_barrier(0);
#pragma unroll
            for (int ai = 0; ai < 2; ++ai)
#pragma unroll
                for (int m = 0; m < 4; ++m)
#pragma unroll
                    for (int bj = 0; bj < 2; ++bj) { f32x4& v0 = acc[ai][bj][m][0]; f32x4& v1 = acc[ai][bj][m][1]; const u32x4 a = gr[ai][m][bj];
                        v0[0] *= bf_lo(a.x); v0[1] *= bf_hi(a.x); v0[2] *= bf_lo(a.y); v0[3] *= bf_hi(a.y); v1[0] *= bf_lo(a.z); v1[1] *= bf_hi(a.z); v1[2] *= bf_lo(a.w); v1[3] *= bf_hi(a.w); }
            return false; }
        u32x4 gb[2][4][2];
#pragma unroll
        for (int ai = 0; ai < 2; ++ai)
#pragma unroll
            for (int m = 0; m < 4; ++m)
#pragma unroll
                for (int bj = 0; bj < 2; ++bj) gb[ai][m][bj] = *(const u32x4*)(gt + (unsigned)((((ai * 4 + m) * 2 + bj) * 8) * 512) + 4 * 65536);
        __builtin_amdgcn_sched_barrier(0);
#pragma unroll
        for (int ai = 0; ai < 2; ++ai) {
#pragma unroll
            for (int m = 0; m < 4; ++m) { const size_t r = (size_t)u.r0 + ai * 128 + wr * 64 + m * 16 + fr;
#pragma unroll
                for (int bj = 0; bj < 2; ++bj) { const int c = u.c0 + bj * 128 + wc * 32 + 8 * fq; const f32x4 v0 = acc[ai][bj][m][0], v1 = acc[ai][bj][m][1]; const u32x4 b = gb[ai][m][bj];
                    const float sb[8] = {fmaxf(bf_lo(b.x), 1e-20f), fmaxf(bf_hi(b.x), 1e-20f), fmaxf(bf_lo(b.y), 1e-20f), fmaxf(bf_hi(b.y), 1e-20f), fmaxf(bf_lo(b.z), 1e-20f), fmaxf(bf_hi(b.z), 1e-20f), fmaxf(bf_lo(b.w), 1e-20f), fmaxf(bf_hi(b.w), 1e-20f)};
                    u32x4 w; w.x = cvt_pk_bf16(v0[0] * sb[0], v0[1] * sb[1]); w.y = cvt_pk_bf16(v0[2] * sb[2], v0[3] * sb[3]);
                    w.z = cvt_pk_bf16(v1[0] * sb[4], v1[1] * sb[5]); w.w = cvt_pk_bf16(v1[2] * sb[6], v1[3] * sb[7]);
                    *(u32x4*)(M + r * 1024 + c) = w; } }
            asm volatile("" ::: "memory"); }
        return true; } };

struct SchedOut { int i, G, c; const char* M; const char* W;
    __device__ __forceinline__ bool next(Unit& u) { const int L = i * G + c; ++i; if (L >= 512) return false; int pm, pn; map_tile(L, 128, 4, pm, pn);
        u.r0 = pm * 256; u.c0 = pn * 256; u.aux = 0; u.a = M + (size_t)u.r0 * 2048; u.b = W + (size_t)u.c0 * 2048; return true; } };
struct EpiOut { static constexpr bool PERM = true; bf16_t* O;
    __device__ __forceinline__ bool operator()(f32x4 (&acc)[2][2][4][2], const Unit& u, int wr, int wc, int fr, int fq) const {
#pragma unroll
        for (int ai = 0; ai < 2; ++ai)
#pragma unroll
            for (int m = 0; m < 4; ++m) { const size_t r = (size_t)u.r0 + ai * 128 + wr * 64 + m * 16 + fr;
#pragma unroll
                for (int bj = 0; bj < 2; ++bj) { const int c = u.c0 + bj * 128 + wc * 32 + 8 * fq; const f32x4 v0 = acc[ai][bj][m][0], v1 = acc[ai][bj][m][1];
                    u32x4 w; w.x = cvt_pk_bf16(v0[0], v0[1]); w.y = cvt_pk_bf16(v0[2], v0[3]); w.z = cvt_pk_bf16(v1[0], v1[1]); w.w = cvt_pk_bf16(v1[2], v1[3]);
                    *(u32x4*)(O + r * 1024 + c) = w; } }
        return true; } };

constexpr float WSCALE = 32.0f, HSCALE = 4.0f;
struct SchedUp { int i, G, c; const char* XS; const char* W;
    __device__ __forceinline__ bool next(Unit& u) { const int L = i * G + c; ++i; if (L >= 4096) return false; const int e = L >> 8; int pm, pn; map_tile(L & 255, 16, 16, pm, pn);
        u.r0 = e * 4096 + pm * 256; u.c0 = pn * 128; u.aux = e; u.a = XS + (size_t)u.r0 * 1024; u.b = W + ((size_t)e * 4096 + pn * 256) * 1024; return true; } };
struct EpiUp { static constexpr bool PERM = true; unsigned char* HID;
    __device__ __forceinline__ bool operator()(f32x4 (&acc)[2][2][4][2], const Unit& u, int wr, int wc, int fr, int fq) const {
        const float s = 1.0f / WSCALE;
#pragma unroll
        for (int ai = 0; ai < 2; ++ai)
#pragma unroll
            for (int bj = 0; bj < 2; ++bj) { unsigned d[4];
#pragma unroll
                for (int m = 0; m < 4; ++m) { const f32x4 g = acc[ai][bj][m][0] * s, up = acc[ai][bj][m][1] * (s * HSCALE);
                    d[m] = pk_fp8x4(g[0] * sigmoidf_(g[0]) * up[0], g[1] * sigmoidf_(g[1]) * up[1], g[2] * sigmoidf_(g[2]) * up[2], g[3] * sigmoidf_(g[3]) * up[3]); }
                const auto p02 = __builtin_amdgcn_permlane32_swap(d[0], d[2], false, false), p13 = __builtin_amdgcn_permlane32_swap(d[1], d[3], false, false);
                const auto q01 = __builtin_amdgcn_permlane16_swap(p02[0], p13[0], false, false), q23 = __builtin_amdgcn_permlane16_swap(p02[1], p13[1], false, false);
                const u32x4 o = {q01[0], q01[1], q23[0], q23[1]};
                const size_t r = (size_t)u.r0 + ai * 128 + wr * 64 + fq * 16 + fr;
                *(u32x4*)(HID + r * 2048 + u.c0 + bj * 64 + wc * 16) = o; }
        return true; } };

struct SchedDown { int i, G, c; const char* HID; const char* W;
    __device__ __forceinline__ bool next(Unit& u) { const int L = i * G + c; ++i; if (L >= 1024) return false; const int e = L >> 6; int pm, pn; map_tile(L & 63, 16, 4, pm, pn);
        u.r0 = e * 4096 + pm * 256; u.c0 = pn * 256; u.aux = e; u.a = HID + (size_t)u.r0 * 2048; u.b = W + ((size_t)e * 1024 + pn * 256) * 2048; return true; } };
constexpr float YSCALE = 64.0f;
struct EpiDown { static constexpr bool PERM = true; const float* GATEV; unsigned char* YS;
    __device__ __forceinline__ bool operator()(f32x4 (&acc)[2][2][4][2], const Unit& u, int wr, int wc, int fr, int fq) const {
#pragma unroll
        for (int ai = 0; ai < 2; ++ai) { float gt[4];
#pragma unroll
            for (int m = 0; m < 4; ++m) gt[m] = GATEV[(size_t)u.r0 + ai * 128 + wr * 64 + m * 16 + fr] * (YSCALE / (WSCALE * HSCALE));
#pragma unroll
            for (int mp = 0; mp < 4; mp += 2)
#pragma unroll
                for (int bj = 0; bj < 2; ++bj) { unsigned dx[2], dy[2];
#pragma unroll
                    for (int q = 0; q < 2; ++q) { const f32x4 v0 = acc[ai][bj][mp + q][0] * gt[mp + q], v1 = acc[ai][bj][mp + q][1] * gt[mp + q]; dx[q] = pk_fp8x4(v0[0], v0[1], v0[2], v0[3]); dy[q] = pk_fp8x4(v1[0], v1[1], v1[2], v1[3]); }
                    const auto sx = __builtin_amdgcn_permlane16_swap(dx[0], dx[1], false, false), sy = __builtin_amdgcn_permlane16_swap(dy[0], dy[1], false, false);
                    const u32x4 o = {sx[0], sy[0], sx[1], sy[1]};
                    const size_t r = (size_t)u.r0 + ai * 128 + wr * 64 + (mp + (fq & 1)) * 16 + fr;
                    *(u32x4*)(YS + r * 1024 + u.c0 + bj * 128 + wc * 32 + 8 * (fq & ~1)) = o; } }
        return true; } };

__device__ __forceinline__ void ld_row(const float* p, int lane, f32x4 (&v)[4]) {
#pragma unroll
    for (int j = 0; j < 4; ++j) v[j] = *(const f32x4*)(p + lane * 4 + 256 * j);
}
__device__ __forceinline__ void ld_row_nt(const float* p, int lane, f32x4 (&v)[4]) {
#pragma unroll
    for (int j = 0; j < 4; ++j) v[j] = __builtin_nontemporal_load((const f32x4*)(p + lane * 4 + 256 * j));
}
__device__ __forceinline__ float sumsq(const f32x4 (&v)[4]) { float s = 0.f;
#pragma unroll
    for (int j = 0; j < 4; ++j) s += (v[j][0] * v[j][0] + v[j][1] * v[j][1]) + (v[j][2] * v[j][2] + v[j][3] * v[j][3]);
    return wave_sum(s); }

template <int NR> __device__ __forceinline__ void rp1_rows(const Args& A, const float* MOD, bf16_t* HN, int r0, int lane, const f32x4 (&w)[4]) {
    f32x4 v[NR][4], sh[NR][4], sc[NR][4];
#pragma unroll
    for (int q = 0; q < NR; ++q) { const int r = r0 + q, b = r / LT, tt = r - b * LT;
        const float* src = tt < CL ? A.in[I_CTX] + ((size_t)b * CL + tt) * DM : A.in[I_X] + ((size_t)b * SEQ + (tt - CL)) * DM;
        const float* mrow = MOD + (tt < CL ? 8 : b) * 6144;
        ld_row(src, lane, v[q]); ld_row(mrow, lane, sh[q]); ld_row(mrow + 1024, lane, sc[q]); }
#pragma unroll
    for (int q = 0; q < NR; ++q) { const float rstd = rsqrtf(sumsq(v[q]) * (1.0f / DM) + EPS);
#pragma unroll
        for (int j = 0; j < 4; ++j) { const f32x4 h = v[q][j] * rstd * w[j] * (sc[q][j] + 1.0f) + sh[q][j];
            u32x2 o; o.x = cvt_pk_bf16(h[0], h[1]); o.y = cvt_pk_bf16(h[2], h[3]); *(u32x2*)(HN + (size_t)(r0 + q) * DM + lane * 4 + 256 * j) = o; } }
}
template <int NR> __device__ __forceinline__ void rp1_lat(const float* X, bf16_t* HN, size_t xrow0, size_t hrow0, int lane, const f32x4 (&c)[4], const f32x4 (&sh)[4]) {
    f32x4 v[NR][4];
#pragma unroll
    for (int q = 0; q < NR; ++q) ld_row(X + (xrow0 + q) * DM, lane, v[q]);
#pragma unroll
    for (int q = 0; q < NR; ++q) { const float rstd = rsqrtf(sumsq(v[q]) * (1.0f / DM) + EPS);
#pragma unroll
        for (int j = 0; j < 4; ++j) { const f32x4 h = v[q][j] * rstd * c[j] + sh[j];
            u32x2 o; o.x = cvt_pk_bf16(h[0], h[1]); o.y = cvt_pk_bf16(h[2], h[3]); *(u32x2*)(HN + (hrow0 + q) * DM + lane * 4 + 256 * j) = o; } }
}
template <int NR> __device__ __forceinline__ void rp1_load(const float* X, size_t xrow0, int lane, f32x4 (&v)[4][4]) {
#pragma unroll
    for (int q = 0; q < NR; ++q) ld_row_nt(X + (xrow0 + q) * DM, lane, v[q]);
}
template <int NR> __device__ __forceinline__ void rp1_proc(f32x4 (&v)[4][4], bf16_t* HN, size_t hrow0, int lane, const f32x4 (&c)[4], const f32x4 (&sh)[4]) {
#pragma unroll
    for (int q = 0; q < NR; ++q) { const float rstd = rsqrtf(sumsq(v[q]) * (1.0f / DM) + EPS);
#pragma unroll
        for (int j = 0; j < 4; ++j) { const f32x4 h = v[q][j] * rstd * c[j] + sh[j];
            u32x2 o; o.x = cvt_pk_bf16(h[0], h[1]); o.y = cvt_pk_bf16(h[2], h[3]); *(u32x2*)(HN + (hrow0 + q) * DM + lane * 4 + 256 * j) = o; } }
}
__device__ __forceinline__ void row_pass1(const Args& A, const float* MOD, bf16_t* HN, int gw, int ngw, int lane) {
    f32x4 w[4]; ld_row(A.in[I_NPREMIX], lane, w);
    const int per = (MR + ngw - 1) / ngw, r0 = gw * per, r1 = min(MR, r0 + per);
    const int b0 = r0 / LT, tt0 = r0 - b0 * LT, b1 = (r1 - 1) / LT;
    if (r0 < r1 && tt0 >= CL && b0 == b1) {
        f32x4 c[4], sh[4]; { f32x4 sc[4]; ld_row(MOD + b0 * 6144, lane, sh); ld_row(MOD + b0 * 6144 + 1024, lane, sc);
#pragma unroll
            for (int j = 0; j < 4; ++j) c[j] = w[j] * (sc[j] + 1.0f); }
        int r = r0;
        if (r1 - r0 == 17) {
            const float* X = A.in[I_X]; const size_t x0 = (size_t)b0 * SEQ + (r0 - b0 * LT - CL); f32x4 va[4][4], vb[4][4];
            rp1_load<4>(X, x0, lane, va); rp1_load<4>(X, x0 + 4, lane, vb);
            rp1_proc<4>(va, HN, (size_t)r0, lane, c, sh); rp1_load<4>(X, x0 + 8, lane, va);
            rp1_proc<4>(vb, HN, (size_t)r0 + 4, lane, c, sh); rp1_load<4>(X, x0 + 12, lane, vb);
            rp1_proc<4>(va, HN, (size_t)r0 + 8, lane, c, sh); rp1_load<1>(X, x0 + 16, lane, va);
            rp1_proc<4>(vb, HN, (size_t)r0 + 12, lane, c, sh);
            rp1_proc<1>(va, HN, (size_t)r0 + 16, lane, c, sh);
            r = r1; }
        for (; r + 4 <= r1; r += 4) rp1_lat<4>(A.in[I_X], HN, (size_t)b0 * SEQ + (r - b0 * LT - CL), (size_t)r, lane, c, sh);
        for (; r < r1; ++r) rp1_lat<1>(A.in[I_X], HN, (size_t)b0 * SEQ + (r - b0 * LT - CL), (size_t)r, lane, c, sh);
    } else {
        int r = r0;
        for (; r + 2 <= r1; r += 2) rp1_rows<2>(A, MOD, HN, r, lane, w);
        if (r < r1) rp1_rows<1>(A, MOD, HN, r, lane, w);
    }
}

__device__ __forceinline__ float reduce16(const float (&v)[16], int lane) {
    float a[8], b4[4], c[2];
    const bool h3 = (lane & 8) != 0, h2 = (lane & 4) != 0;
#pragma unroll
    for (int i = 0; i < 8; ++i) a[i] = swap32_sum(v[i], v[8 + i]);
#pragma unroll
    for (int i = 0; i < 4; ++i) b4[i] = swap16_sum(a[i], a[4 + i]);
#pragma unroll
    for (int i = 0; i < 2; ++i) { const float keep = h3 ? b4[2 + i] : b4[i], send = h3 ? b4[i] : b4[2 + i]; c[i] = keep + dpp_f<DPP_ROR8>(send); }
    const float keep = h2 ? c[1] : c[0], send = h2 ? c[0] : c[1]; float d = keep + dpp_f<DPP_HMIRROR>(send);
    d += dpp_f<DPP_XOR2>(d); d += dpp_f<DPP_XOR1>(d); return d;
}

__device__ __forceinline__ void ld_row_bf(const bf16_t* p, int lane, f32x4 (&v)[4]) {
#pragma unroll
    for (int j = 0; j < 4; ++j) { const u32x2 w = *(const u32x2*)(p + lane * 4 + 256 * j); v[j] = (f32x4){bf_lo(w.x), bf_hi(w.x), bf_lo(w.y), bf_hi(w.y)}; }
}
__device__ __forceinline__ void row_pass2_generic(const Args& A, const float* MOD, const bf16_t* OB, bf16_t* X1, unsigned char* H2, float* AFF, LAS float* WR, int gw, int ngw, int lane) {
    const int per = (ML + ngw - 1) / ngw;
    const int b = (gw * per) >> 12; const float* mrow = MOD + b * 6144;
    const int rbeg = gw * per, rend = min(ML, (gw + 1) * per);
    f32x4 o[4], x[4];
    if (rbeg < rend) { ld_row_bf(OB + (size_t)rbeg * DM, lane, o); ld_row(A.in[I_X] + (size_t)rbeg * DM, lane, x); }
#pragma unroll 1
    for (int r = rbeg; r < rend; ++r) { const int t = r & 4095;
        f32x4 on[4], xn[4];
        { const int rn = (r + 1 < rend) ? r + 1 : r; ld_row_bf(OB + (size_t)rn * DM, lane, on); ld_row(A.in[I_X] + (size_t)rn * DM, lane, xn); }
        const float rs0 = rsqrtf(sumsq(o) * (1.0f / DM) + EPS);
#pragma unroll
        for (int j = 0; j < 4; ++j) { const f32x4 wpost = *(const f32x4*)(A.in[I_NPOSTMIX] + lane * 4 + 256 * j), gm = *(const f32x4*)(mrow + 2048 + lane * 4 + 256 * j);
            x[j] = x[j] + gm * wpost * (o[j] * rs0); u32x2 xb; xb.x = cvt_pk_bf16(x[j][0], x[j][1]); xb.y = cvt_pk_bf16(x[j][2], x[j][3]); *(u32x2*)(X1 + (size_t)r * DM + lane * 4 + 256 * j) = xb; }
        const float rs1 = rsqrtf(sumsq(x) * (1.0f / DM) + EPS);
        int woff = lane * 4; asm volatile("" : "+v"(woff) : "v"(rs1));
        f32x2 lg2[16];
#pragma unroll
        for (int e = 0; e < 16; ++e) lg2[e] = (f32x2){0.f, 0.f};
#pragma unroll
        for (int j = 0; j < 4; ++j) {
            const f32x4 wpre = *(const f32x4*)(A.in[I_NPREFFN] + lane * 4 + 256 * j), sc = *(const f32x4*)(mrow + 4096 + lane * 4 + 256 * j), sh = *(const f32x4*)(mrow + 3072 + lane * 4 + 256 * j);
            const f32x4 h = x[j] * rs1 * wpre * (sc + 1.0f) + sh;
            *(unsigned*)(H2 + (size_t)r * DM + lane * 4 + 256 * j) = pk_fp8x4(h[0], h[1], h[2], h[3]);
#pragma unroll
            for (int e = 0; e < 16; ++e) { const f32x4 ww = *(const LAS f32x4*)(WR + e * 1024 + woff + 256 * j);
                lg2[e] = __builtin_elementwise_fma((f32x2){h[0], h[1]}, (f32x2){ww[0], ww[1]}, lg2[e]); lg2[e] = __builtin_elementwise_fma((f32x2){h[2], h[3]}, (f32x2){ww[2], ww[3]}, lg2[e]); }
            asm volatile("" : "+v"(woff), "+v"(lg2[15]));
        }
        float lg[16];
#pragma unroll
        for (int e = 0; e < 16; ++e) lg[e] = lg2[e][0] + lg2[e][1];
        const float lgt = reduce16(lg, lane);
        float mx = lgt; mx = fmaxf(mx, dpp_f<DPP_HMIRROR>(mx)); mx = fmaxf(mx, dpp_f<DPP_MIRROR>(mx));
        { auto r = __builtin_amdgcn_permlane16_swap(__float_as_uint(mx), __float_as_uint(mx), false, false); mx = fmaxf(__uint_as_float(r[0]), __uint_as_float(r[1])); }
        { auto r = __builtin_amdgcn_permlane32_swap(__float_as_uint(mx), __float_as_uint(mx), false, false); mx = fmaxf(__uint_as_float(r[0]), __uint_as_float(r[1])); }
        const float ex = expf(lgt - mx); float se = ex; se += dpp_f<DPP_HMIRROR>(se); se += dpp_f<DPP_MIRROR>(se); se = swap16_sum(se, se); se = swap32_sum(se, se);
        const int e = ((lane >> 5) & 1) * 8 + ((lane >> 4) & 1) * 4 + ((lane >> 3) & 1) * 2 + ((lane >> 2) & 1);
        if ((lane & 3) == 0) AFF[((size_t)b * NE + e) * SEQ + t] = ex / se;
#pragma unroll
        for (int j = 0; j < 4; ++j) { o[j] = on[j]; x[j] = xn[j]; }
    }
}
__device__ __forceinline__ void row_pass2(const Args& A, const float* MOD, const bf16_t* OB, bf16_t* X1, unsigned char* H2, float* AFF, LAS float* WR, int gw, int ngw, int lane) {
    if (ngw != 2048) { row_pass2_generic(A, MOD, OB, X1, H2, AFF, WR, gw, ngw, lane); return; }
    LAS float* PL = WR + 16384;
    { const int bb = (blockIdx.x * 128) >> 12; const float* mr = MOD + bb * 6144;
      for (int k = threadIdx.x; k < 1024; k += 512) { PL[k] = mr[2048 + k] * A.in[I_NPOSTMIX][k]; PL[1024 + k] = A.in[I_NPREFFN][k] * (mr[4096 + k] + 1.0f); PL[2048 + k] = mr[3072 + k]; }
      __syncthreads(); }
    const int per = (ML + ngw - 1) / ngw;
    const int b = (gw * per) >> 12;
    const int rbeg = gw * per, rend = min(ML, (gw + 1) * per);
    f32x4 o[4], x[4];
    if (rbeg < rend) { ld_row_bf(OB + (size_t)rbeg * DM, lane, o); ld_row_nt(A.in[I_X] + (size_t)rbeg * DM, lane, x); }
#pragma unroll 1
    for (int r = rbeg; r < rend; ++r) { const int t = r & 4095;
        f32x4 on[4], xn[4];
        { const int rn = (r + 1 < rend) ? r + 1 : r; ld_row_bf(OB + (size_t)rn * DM, lane, on); ld_row_nt(A.in[I_X] + (size_t)rn * DM, lane, xn); }
        const float rs0 = rsqrtf(sumsq(o) * (1.0f / DM) + EPS);
        int poff = lane * 4; asm volatile("" : "+v"(poff) : "v"(rs0));
#pragma unroll
        for (int j = 0; j < 4; ++j) { const f32x4 gwp = *(const LAS f32x4*)(PL + poff + 256 * j);
            x[j] = x[j] + gwp * (o[j] * rs0); u32x2 xb; xb.x = cvt_pk_bf16(x[j][0], x[j][1]); xb.y = cvt_pk_bf16(x[j][2], x[j][3]); __builtin_nontemporal_store(xb, (u32x2*)(X1 + (size_t)r * DM + lane * 4 + 256 * j)); }
        const float rs1 = rsqrtf(sumsq(x) * (1.0f / DM) + EPS);
        int woff = lane * 4; asm volatile("" : "+v"(woff) : "v"(rs1));
        f32x2 lg2[16];
#pragma unroll
        for (int e = 0; e < 16; ++e) lg2[e] = (f32x2){0.f, 0.f};
#pragma unroll
        for (int j = 0; j < 4; ++j) {
            const f32x4 ap = *(const LAS f32x4*)(PL + 1024 + woff + 256 * j), sh = *(const LAS f32x4*)(PL + 2048 + woff + 256 * j);
            const f32x4 h = x[j] * rs1 * ap + sh;
            *(unsigned*)(H2 + (size_t)r * DM + lane * 4 + 256 * j) = pk_fp8x4(h[0], h[1], h[2], h[3]);
#pragma unroll
            for (int e = 0; e < 16; ++e) { const f32x4 ww = *(const LAS f32x4*)(WR + e * 1024 + woff + 256 * j);
                lg2[e] = __builtin_elementwise_fma((f32x2){h[0], h[1]}, (f32x2){ww[0], ww[1]}, lg2[e]); lg2[e] = __builtin_elementwise_fma((f32x2){h[2], h[3]}, (f32x2){ww[2], ww[3]}, lg2[e]); }
            asm volatile("" : "+v"(woff), "+v"(lg2[15]));
        }
        float lg[16];
#pragma unroll
        for (int e = 0; e < 16; ++e) lg[e] = lg2[e][0] + lg2[e][1];
        const float lgt = reduce16(lg, lane);
        float mx = lgt; mx = fmaxf(mx, dpp_f<DPP_HMIRROR>(mx)); mx = fmaxf(mx, dpp_f<DPP_MIRROR>(mx));
        { auto r = __builtin_amdgcn_permlane16_swap(__float_as_uint(mx), __float_as_uint(mx), false, false); mx = fmaxf(__uint_as_float(r[0]), __uint_as_float(r[1])); }
        { auto r = __builtin_amdgcn_permlane32_swap(__float_as_uint(mx), __float_as_uint(mx), false, false); mx = fmaxf(__uint_as_float(r[0]), __uint_as_float(r[1])); }
        const float ex = expf(lgt - mx); float se = ex; se += dpp_f<DPP_HMIRROR>(se); se += dpp_f<DPP_MIRROR>(se); se = swap16_sum(se, se); se = swap32_sum(se, se);
        const int e = ((lane >> 5) & 1) * 8 + ((lane >> 4) & 1) * 4 + ((lane >> 3) & 1) * 2 + ((lane >> 2) & 1);
        if ((lane & 3) == 0) AFF[((size_t)b * NE + e) * SEQ + t] = ex / se;
#pragma unroll
        for (int j = 0; j < 4; ++j) { o[j] = on[j]; x[j] = xn[j]; }
    }
}

__device__ __forceinline__ void fp8x4_add(unsigned w, float s, float* f) {
    typedef float f32x2_ __attribute__((ext_vector_type(2)));
    const f32x2_ lo = __builtin_amdgcn_cvt_pk_f32_fp8((int)w, false), hi = __builtin_amdgcn_cvt_pk_f32_fp8((int)w, true);
    f[0] += s * lo[0]; f[1] += s * lo[1]; f[2] += s * hi[0]; f[3] += s * hi[1]; }
__device__ __forceinline__ void row_final_generic(const Args& A, const float* MOD, const bf16_t* X1, float* OUT, const unsigned char* YS, const int* SLOT, int gw, int ngw, int lane) {
    const int per = (ML + ngw - 1) / ngw;
    for (int r = gw * per; r < min(ML, (gw + 1) * per); ++r) { const int b = r >> 12; const float* mrow = MOD + b * 6144;
        const int myslot = lane < 16 ? SLOT[(size_t)r * 16 + lane] : -1;
        f32x4 x1[4], gf[4], w[4];
#pragma unroll
        for (int j = 0; j < 2; ++j)
#pragma unroll
            for (int q = 0; q < 2; ++q) { const int k = lane * 8 + 512 * j + 4 * q; { const u32x2 w_ = *(const u32x2*)(X1 + (size_t)r * DM + k); x1[2 * j + q] = (f32x4){bf_lo(w_.x), bf_hi(w_.x), bf_lo(w_.y), bf_hi(w_.y)}; } gf[2 * j + q] = *(const f32x4*)(mrow + 5120 + k); w[2 * j + q] = *(const f32x4*)(A.in[I_NPOSTFFN] + k); }
        float f[16];
#pragma unroll
        for (int i = 0; i < 16; ++i) f[i] = 0.f;
        unsigned long long msk = __ballot(myslot >= 0);
        while (msk) { const int e0 = __builtin_ctzll(msk); msk &= msk - 1; const bool two = msk != 0; const int e1 = two ? __builtin_ctzll(msk) : e0; if (two) msk &= msk - 1;
            const int s0 = __builtin_amdgcn_readlane(myslot, e0), s1 = __builtin_amdgcn_readlane(myslot, e1);
            const unsigned char* y0 = YS + ((size_t)e0 * 4096 + b * CAP + s0) * DM; const unsigned char* y1 = YS + ((size_t)e1 * 4096 + b * CAP + s1) * DM;
            u32x2 ya[2], yb[2];
#pragma unroll
            for (int j = 0; j < 2; ++j) { ya[j] = *(const u32x2*)(y0 + lane * 8 + 512 * j); yb[j] = *(const u32x2*)(y1 + lane * 8 + 512 * j); }
            const float m1 = two ? 1.0f : 0.0f;
#pragma unroll
            for (int j = 0; j < 2; ++j) { fp8x4_add(ya[j].x, 1.0f, f + 8 * j); fp8x4_add(ya[j].y, 1.0f, f + 8 * j + 4); fp8x4_add(yb[j].x, m1, f + 8 * j); fp8x4_add(yb[j].y, m1, f + 8 * j + 4); } }
#pragma unroll
        for (int i = 0; i < 16; ++i) f[i] *= (1.0f / YSCALE);
        float ss = 0.f;
#pragma unroll
        for (int i = 0; i < 16; ++i) ss += f[i] * f[i];
        const float rstd = rsqrtf(wave_sum(ss) * (1.0f / DM) + EPS);
#pragma unroll
        for (int j = 0; j < 2; ++j)
#pragma unroll
            for (int q = 0; q < 2; ++q) { const int k = lane * 8 + 512 * j + 4 * q;
                f32x4 fv = {f[8 * j + 4 * q], f[8 * j + 4 * q + 1], f[8 * j + 4 * q + 2], f[8 * j + 4 * q + 3]};
                *(f32x4*)(OUT + (size_t)r * DM + k) = x1[2 * j + q] + gf[2 * j + q] * (fv * rstd * w[2 * j + q]); } }
}
__device__ __forceinline__ void rf_issue(int sl, int r, int b, int lane, const unsigned char* YS, const bf16_t* X1, u32x2 (&ys)[4][2], u32x4 (&xr)[2], float (&mk)[4], unsigned& rest) {
    unsigned m = (unsigned)__ballot(sl >= 0); int e = 0, s = 0;
#pragma unroll
    for (int k = 0; k < 4; ++k) { const bool has = m != 0u; if (has) { e = __builtin_ctz(m); m &= m - 1u; s = __builtin_amdgcn_readlane(sl, e); }
        mk[k] = has ? 1.0f : 0.0f;
        const unsigned char* y = YS + ((size_t)e * 4096 + b * CAP + (s < 0 ? 0 : s)) * DM + lane * 8;
        ys[k][0] = *(const u32x2*)y; ys[k][1] = *(const u32x2*)(y + 512); }
    rest = m;
    xr[0] = *(const u32x4*)(X1 + (size_t)r * DM + lane * 8); xr[1] = *(const u32x4*)(X1 + (size_t)r * DM + 512 + lane * 8);
}
__device__ __forceinline__ void row_final(const Args& A, const float* MOD, const bf16_t* X1, float* OUT, const unsigned char* YS, const int* SLOT, int gw, int ngw, int lane) {
    const int per = (ML + ngw - 1) / ngw, r0 = gw * per, r1 = min(ML, r0 + per);
    if (r0 >= r1) return;
    const int b = r0 >> 12;
    if (((r1 - 1) >> 12) != b) { row_final_generic(A, MOD, X1, OUT, YS, SLOT, gw, ngw, lane); return; }
    const float* mrow = MOD + b * 6144; f32x4 gf[4], w[4];
#pragma unroll
    for (int j = 0; j < 2; ++j)
#pragma unroll
        for (int q = 0; q < 2; ++q) { const int k = lane * 8 + 512 * j + 4 * q; gf[2 * j + q] = *(const f32x4*)(mrow + 5120 + k); w[2 * j + q] = *(const f32x4*)(A.in[I_NPOSTFFN] + k); }
    int slA = lane < 16 ? SLOT[(size_t)r0 * 16 + lane] : -1, slB = lane < 16 ? SLOT[(size_t)min(r0 + 1, r1 - 1) * 16 + lane] : -1;
    u32x2 ysA[4][2]; u32x4 xrA[2]; float mkA[4]; unsigned restA;
    rf_issue(slA, r0, b, lane, YS, X1, ysA, xrA, mkA, restA);
#pragma unroll 1
    for (int r = r0; r < r1; ++r) {
        const int slC = lane < 16 ? SLOT[(size_t)min(r + 2, r1 - 1) * 16 + lane] : -1;
        u32x2 ysB[4][2]; u32x4 xrB[2]; float mkB[4]; unsigned restB;
        rf_issue(slB, min(r + 1, r1 - 1), b, lane, YS, X1, ysB, xrB, mkB, restB);
        float f[16];
#pragma unroll
        for (int i = 0; i < 16; ++i) f[i] = 0.f;
#pragma unroll
        for (int k = 0; k < 4; ++k)
#pragma unroll
            for (int j = 0; j < 2; ++j) { fp8x4_add(ysA[k][j].x, mkA[k], f + 8 * j); fp8x4_add(ysA[k][j].y, mkA[k], f + 8 * j + 4); }
        while (restA) { const int e = __builtin_ctz(restA); restA &= restA - 1u; const int s_ = __builtin_amdgcn_readlane(slA, e);
            const unsigned char* y = YS + ((size_t)e * 4096 + b * CAP + s_) * DM + lane * 8; const u32x2 a0 = *(const u32x2*)y, a1 = *(const u32x2*)(y + 512);
            fp8x4_add(a0.x, 1.0f, f); fp8x4_add(a0.y, 1.0f, f + 4); fp8x4_add(a1.x, 1.0f, f + 8); fp8x4_add(a1.y, 1.0f, f + 12); }
#pragma unroll
        for (int i = 0; i < 16; ++i) f[i] *= (1.0f / YSCALE);
        float ss = 0.f;
#pragma unroll
        for (int i = 0; i < 16; ++i) ss += f[i] * f[i];
        const float rstd = rsqrtf(wave_sum(ss) * (1.0f / DM) + EPS);
#pragma unroll
        for (int j = 0; j < 2; ++j) { const u32x4 xw = xrA[j];
            const f32x4 xa = {bf_lo(xw.x), bf_hi(xw.x), bf_lo(xw.y), bf_hi(xw.y)}, xb = {bf_lo(xw.z), bf_hi(xw.z), bf_lo(xw.w), bf_hi(xw.w)};
            const f32x4 fa = {f[8 * j], f[8 * j + 1], f[8 * j + 2], f[8 * j + 3]}, fb = {f[8 * j + 4], f[8 * j + 5], f[8 * j + 6], f[8 * j + 7]};
            float* op = OUT + (size_t)r * DM + lane * 8 + 512 * j;
            *(f32x4*)op = xa + gf[2 * j] * (fa * rstd * w[2 * j]); *(f32x4*)(op + 4) = xb + gf[2 * j + 1] * (fb * rstd * w[2 * j + 1]); }
#pragma unroll
        for (int k = 0; k < 4; ++k) { ysA[k][0] = ysB[k][0]; ysA[k][1] = ysB[k][1]; mkA[k] = mkB[k]; }
        xrA[0] = xrB[0]; xrA[1] = xrB[1]; restA = restB; slA = slB; slB = slC;
    }
}

__device__ __forceinline__ void yb_combine(const bf16_t* OC, const float* subln, float lam, bf16_t* YY, int gw, int ngw, int lane) {
    float sw[8];
#pragma unroll
    for (int i = 0; i < 8; ++i) sw[i] = subln[(lane & 15) * 8 + i] * 0.8f;
    for (int r = gw; r < ML; r += ngw) {
        const u32x4 a = *(const u32x4*)(OC + (size_t)r * 512 + lane * 8), c = *(const u32x4*)(OC + ((size_t)ML + r) * 512 + lane * 8);
        float d[8] = {bf_lo(a.x) - lam * bf_lo(c.x), bf_hi(a.x) - lam * bf_hi(c.x), bf_lo(a.y) - lam * bf_lo(c.y), bf_hi(a.y) - lam * bf_hi(c.y),
                      bf_lo(a.z) - lam * bf_lo(c.z), bf_hi(a.z) - lam * bf_hi(c.z), bf_lo(a.w) - lam * bf_lo(c.w), bf_hi(a.w) - lam * bf_hi(c.w)};
        float ss = 0.f;
#pragma unroll
        for (int i = 0; i < 8; ++i) ss += d[i] * d[i];
        ss += dpp_f<DPP_XOR1>(ss); ss += dpp_f<DPP_XOR2>(ss); ss += dpp_f<DPP_HMIRROR>(ss); ss += dpp_f<DPP_MIRROR>(ss);
        const float rstd = rsqrtf(ss * (1.0f / 128.0f) + EPS);
        u32x4 w; w.x = cvt_pk_bf16(d[0] * rstd * sw[0], d[1] * rstd * sw[1]); w.y = cvt_pk_bf16(d[2] * rstd * sw[2], d[3] * rstd * sw[3]);
        w.z = cvt_pk_bf16(d[4] * rstd * sw[4], d[5] * rstd * sw[5]); w.w = cvt_pk_bf16(d[6] * rstd * sw[6], d[7] * rstd * sw[7]);
        *(u32x4*)(YY + (size_t)r * 1024 + 512 + lane * 8) = w; }
}

__device__ __forceinline__ void s5_scan(const Args& A, const bf16_t* S, bf16_t* UH, int bg, const bf16_t* Wcat) {
    const int tid = threadIdx.x;
    if (tid >= 128) {
        const char* wp = (const char*)(Wcat + (size_t)(bg & 31) * 256 * 512); const char* up = (const char*)(UH + ((size_t)bg * NCH + 16) * 512);
        unsigned acc_ = 0;
        for (int l = tid - 128; l < 2048; l += 384) acc_ += *(const unsigned*)(wp + (size_t)l * 128);
        for (int l = tid - 128; l < 1024; l += 384) acc_ += *(const unsigned*)(up + (size_t)(l >> 2) * 1024 + (l & 3) * 128);
        asm volatile("" :: "v"(acc_));
        return; }
    const int dir = tid >> 6, p = tid & 63, g = bg & 31, gi = dir * 32 + g;
    const float lr = fminf(A.in[I_LAMRE][gi * 64 + p], -1e-4f), li = A.in[I_LAMIM][gi * 64 + p], dt = expf(A.in[I_LOGDT][gi]);
    float sn, cs; sincos_fast(16.0f * li * dt, &sn, &cs); const float mag = expf(16.0f * lr * dt), ar = mag * cs, aim = mag * sn;
    const bf16_t* Sb = S + (size_t)bg * NCH * 256 + dir * 128 + 2 * p; bf16_t* Hb = UH + (size_t)bg * NCH * 512 + 256 + dir * 128 + p;
    float hr = 0.f, hi = 0.f;
    for (int i0 = 0; i0 < NCH; i0 += 16) { unsigned wv[16];
#pragma unroll
        for (int k = 0; k < 16; ++k) { const int i = i0 + k, ch = dir == 0 ? i : (i < 16 ? 15 - i : 287 - i); wv[k] = *(const unsigned*)(Sb + (size_t)ch * 256); }
        __builtin_amdgcn_sched_barrier(0);
#pragma unroll
        for (int k = 0; k < 16; ++k) { const int i = i0 + k, ch = dir == 0 ? i : (i < 16 ? 15 - i : 287 - i);
            Hb[(size_t)ch * 512] = (bf16_t)(cvt_pk_bf16(hr, 0.f) & 0xffffu); Hb[(size_t)ch * 512 + 64] = (bf16_t)(cvt_pk_bf16(hi, 0.f) & 0xffffu);
            const float nr = ar * hr - aim * hi + bf_lo(wv[k]), ni = ar * hi + aim * hr + bf_hi(wv[k]); hr = nr; hi = ni; } }
}

__device__ __forceinline__ void topk_task(int be, const float* AFF, const unsigned char* H2, int* IDX, float* GATEV, int* SLOT, unsigned char* XS, LAS unsigned* L) {
    const int tid = threadIdx.x, lane = tid & 63, wid = tid >> 6, b = be >> 4, e = be & 15;
    LAS unsigned* hist = L; LAS unsigned* wsum = L + 256; LAS unsigned* bc = L + 272; LAS int* sidx = (LAS int*)(L + 288);
    const float* ap = AFF + (size_t)be * SEQ + tid * 8;
    const f32x4 a0 = *(const f32x4*)ap, a1 = *(const f32x4*)(ap + 4);
    unsigned key[8] = {__float_as_uint(a0[0]), __float_as_uint(a0[1]), __float_as_uint(a0[2]), __float_as_uint(a0[3]), __float_as_uint(a1[0]), __float_as_uint(a1[1]), __float_as_uint(a1[2]), __float_as_uint(a1[3])};
    unsigned prefix = 0, pmask = 0; int need = CAP;
    for (int pass = 0; pass < 4; ++pass) { const int shift = 24 - 8 * pass;
        if (tid < 256) hist[tid] = 0; __syncthreads();
#pragma unroll
        for (int i = 0; i < 8; ++i) if ((key[i] & pmask) == prefix) __hip_atomic_fetch_add(&hist[(key[i] >> shift) & 255u], 1u, __ATOMIC_RELAXED, __HIP_MEMORY_SCOPE_WORKGROUP);
        __syncthreads();
        if (tid < 64) { unsigned c0 = hist[255 - 4 * tid], c1 = hist[254 - 4 * tid], c2 = hist[253 - 4 * tid], c3 = hist[252 - 4 * tid]; unsigned tot = c0 + c1 + c2 + c3, inc = tot;
#pragma unroll
            for (int o = 1; o < 64; o <<= 1) { const unsigned v = __shfl_up(inc, o); if (tid >= o) inc += v; }
            const unsigned exc = inc - tot;
            if (exc < (unsigned)need && inc >= (unsigned)need) { unsigned run = exc; int bin = 255 - 4 * tid; unsigned cs[4] = {c0, c1, c2, c3};
#pragma unroll
                for (int k = 0; k < 4; ++k) { if (run < (unsigned)need && run + cs[k] >= (unsigned)need) { bc[0] = (unsigned)(bin - k); bc[1] = run; } run += cs[k]; } } }
        __syncthreads();
        const unsigned bin = bc[0], above = bc[1];
        prefix |= bin << shift; pmask |= 255u << shift; need -= (int)above;
        __syncthreads(); }
    unsigned cnt = 0;
#pragma unroll
    for (int i = 0; i < 8; ++i) cnt += (key[i] > prefix ? 1u : 0u) + (key[i] == prefix ? 0x10000u : 0u);
    unsigned inc = cnt;
#pragma unroll
    for (int o = 1; o < 64; o <<= 1) { const unsigned v = __shfl_up(inc, o); if (lane >= o) inc += v; }
    if (lane == 63) wsum[wid] = inc; __syncthreads();
    unsigned base = 0;
    for (int w = 0; w < wid; ++w) base += wsum[w];
    unsigned tot = 0;
    for (int w = 0; w < 8; ++w) tot += wsum[w];
    const int ngt = (int)(tot & 0xffffu);
    unsigned run = base + inc - cnt; int rgt = (int)(run & 0xffffu), req = (int)(run >> 16);
#pragma unroll
    for (int i = 0; i < 8; ++i) { const int t = tid * 8 + i; int slot = -1;
        if (key[i] > prefix) { slot = rgt; ++rgt; } else if (key[i] == prefix) { if (req < need) slot = ngt + req; ++req; }
        SLOT[((size_t)b * SEQ + t) * NE + e] = slot;
        if (slot >= 0) { sidx[slot] = t; IDX[be * CAP + slot] = t; GATEV[(size_t)e * 4096 + b * CAP + slot] = __uint_as_float(key[i]); } }
    __syncthreads();
    for (int s0 = wid * 64; s0 < wid * 64 + 64; s0 += 16) { u32x4 v[16];
#pragma unroll
        for (int k = 0; k < 16; ++k) v[k] = *(const u32x4*)(H2 + ((size_t)b * SEQ + sidx[s0 + k]) * DM + lane * 16);
#pragma unroll
        for (int k = 0; k < 16; ++k) *(u32x4*)(XS + ((size_t)e * 4096 + b * CAP + s0 + k) * DM + lane * 16) = v[k]; }
    __syncthreads();
}

constexpr int N_PHASES = 14;
__global__ void __launch_bounds__(512) fwd_kernel(Args args) {
    extern __shared__ __attribute__((aligned(16))) unsigned char lds_raw[];
    LAS unsigned char* lds = (LAS unsigned char*)lds_raw;
    cg::grid_group grid = cg::this_grid();
    const int tid = threadIdx.x, lane = tid & 63, wid = __builtin_amdgcn_readfirstlane(tid >> 6);
    const int G = gridDim.x, blk = blockIdx.x, gw = blk * 8 + wid, ngw = G * 8;
    unsigned char* ws = args.ws;
    float* MOD = (float*)(ws + WS_MOD); float* MISC = (float*)(ws + WS_MISC); float* ROPE = MISC + 256;
    bf16_t* BCAT = (bf16_t*)(ws + WS_BCAT); bf16_t* WCAT = (bf16_t*)(ws + WS_WCAT);
    bf16_t* WINT = (bf16_t*)(ws + WS_WIN); bf16_t* WGLUT = (bf16_t*)(ws + WS_WGLU); bf16_t* WAT = (bf16_t*)(ws + WS_WA); bf16_t* WBT = (bf16_t*)(ws + WS_WB); bf16_t* WOUTT = (bf16_t*)(ws + WS_WOUT);
    float* AFF = (float*)(ws + WS_AFF); int* IDX = (int*)(ws + WS_IDX); float* GATEV = (float*)(ws + WS_GATEV); int* SLOT = (int*)(ws + WS_SLOT);
    bf16_t* HN = (bf16_t*)(ws + WS_HN); bf16_t* UH = (bf16_t*)(ws + WS_UH); bf16_t* QB = (bf16_t*)(ws + WS_Q); bf16_t* KB = (bf16_t*)(ws + WS_K); bf16_t* VB = (bf16_t*)(ws + WS_V);
    bf16_t* GATES = (bf16_t*)(ws + WS_GATES); bf16_t* SB = (bf16_t*)(ws + WS_S); bf16_t* OC = (bf16_t*)(ws + WS_OC); bf16_t* YA = (bf16_t*)(ws + WS_YA); bf16_t* YY = (bf16_t*)(ws + WS_YY);
    bf16_t* MB = (bf16_t*)(ws + WS_M); unsigned char* H2 = ws + WS_H2; unsigned char* XS = ws + WS_XS; unsigned char* WGU = ws + WS_WGU; unsigned char* HID = ws + WS_HID;
    bf16_t* OB = (bf16_t*)(ws + WS_OB); bf16_t* X1 = (bf16_t*)(ws + WS_X1);
    unsigned char* WD = ws + WS_WD; unsigned char* YS = ws + WS_YS;
    const int lo = args.ph_lo, hi = args.ph_hi;
#ifdef ONLY_PHASE
#define IN(k) ((k) == ONLY_PHASE && lo <= (k) && (k) < hi)
#else
#define IN(k) (lo <= (k) && (k) < hi)
#endif
#define SEAM(k) do { if ((k) != 3 && (k) != 5 && IN(k) && IN((k) + 1)) xcd_barrier(xb); } while (0)
#define PH_BEGIN(k) if ((k) == TIME_PHASE) { t0_ = __builtin_amdgcn_s_memrealtime(); c0_ = __builtin_amdgcn_s_memtime(); } if (IN(k)) { for (int rep_ = 0; rep_ <= ((REPEAT_MASK >> (k)) & 1); ++rep_) { if (rep_) xcd_barrier(xb);
#define PH_END(k) } } if ((k) == TIME_PHASE && !TIME_WITH_SEAM) { t1_ = __builtin_amdgcn_s_memrealtime(); c1_ = __builtin_amdgcn_s_memtime(); } SEAM(k); if ((k) == TIME_PHASE && TIME_WITH_SEAM) { t1_ = __builtin_amdgcn_s_memrealtime(); c1_ = __builtin_amdgcn_s_memtime(); }
    LAS float* Lf = (LAS float*)lds;
    unsigned long long t0_ = 0, t1_ = 0, c0_ = 0, c1_ = 0, eacc_ = 0;
    volatile LAS unsigned* xst = (volatile LAS unsigned*)(lds + 148 * 1024 + 256);
    if (tid < 2) xst[tid] = 0u;
    __syncthreads();
    XcdBarrier xb = xcd_barrier_post((unsigned*)(ws + WS_BAR), xst);
    if (args.ph_lo < 0) grid.sync();
    LAS float* scr = Lf + wid * 4160;

    const bool p2_tail = (G == 256); const int nS5 = p2_tail ? 0 : 64;
    auto small_items = [&](int it_lo, int it_hi, int w0, int nw) __attribute__((always_inline)) {
    for (int it = it_lo + w0; it < it_hi; it += nw) {
        if (it < 1024) { const int kb = it >> 6, nb = it & 63, n0 = nb * 64;
            if (n0 >= 512 && n0 < 1536) { const int ng = lane & 15, kg = lane >> 4, cb = n0 + ng * 4, p = cb & 31, row = (cb & ~31) + (p < 16 ? 8 * (p >> 2) : 8 * ((p - 16) >> 2) + 4);
                const float* src = args.in[I_WIN] + (size_t)kb * 64 * 4096 + cb; f32x4 v[2][8];
#pragma unroll
                for (int h = 0; h < 2; ++h)
#pragma unroll
                    for (int i = 0; i < 8; ++i) v[h][i] = *(const f32x4*)(src + (size_t)(h * 32 + kg * 8 + i) * 4096);
#pragma unroll
                for (int h = 0; h < 2; ++h)
#pragma unroll
                    for (int j = 0; j < 4; ++j) { u32x4 o; o.x = cvt_pk_bf16(v[h][0][j], v[h][1][j]); o.y = cvt_pk_bf16(v[h][2][j], v[h][3][j]); o.z = cvt_pk_bf16(v[h][4][j], v[h][5][j]); o.w = cvt_pk_bf16(v[h][6][j], v[h][7][j]);
                        *(u32x4*)(WINT + (size_t)(row + j) * 1024 + kb * 64 + h * 32 + kg * 8) = o; } }
            else { const int cg = n0 - 2048, dr = n0 < 2048 ? n0 : 2048 + ((cg & 1023) >> 7) * 256 + (cg >= 1024 ? 128 : 0) + (cg & 127);
                cvt_item(args.in[I_WIN] + (size_t)kb * 64 * 4096 + n0, 4096, WINT + (size_t)dr * 1024 + kb * 64, 1024, 4, lane); } }
        else if (it < 1088) { const int r = it - 1024, kb = r >> 3, nb = r & 7;
            cvt_item(args.in[I_WGLU] + (size_t)kb * 64 * 512 + nb * 64, 512, WGLUT + (size_t)nb * 64 * 512 + kb * 64, 512, 4, lane); }
        else if (it < 1344) { const int r = (it - 1088) & 127, kb = r >> 4, nb = r & 15; const bool isb = it >= 1216;
            cvt_item(args.in[isb ? I_WPB : I_WPA] + (size_t)kb * 64 * 1024 + nb * 64, 1024, (isb ? WBT : WAT) + (size_t)nb * 64 * 512 + kb * 64, 512, 4, lane); }
        else { const int r = it - 1344, kb = r >> 4, nb = r & 15;
            cvt_item(args.in[I_WOUT] + (size_t)kb * 64 * 1024 + nb * 64, 1024, WOUTT + (size_t)nb * 64 * 1024 + kb * 64, 1024, 4, lane); }
    } };
    PH_BEGIN(0) {
        for (int task = blk; task < nS5 + 193; task += G) {
            if (task < nS5) s5_tables_task(task >> 1, task & 1, args, BCAT, WCAT, Lf);
            else if (task < nS5 + 192) mod_task((task - nS5) * 32, args.in[I_C], args.in[I_CCTX], args.in[I_WADA], args.in[I_BADA], MOD, Lf);
            else {
                for (int i = tid; i < 1024; i += 512) { const int pos = i >> 4, fi = i & 15; const float inv = exp2f(-(float)fi * (13.287712379549449f / 16.0f));
                    float sn, cs; sincos_fast((float)pos * inv, &sn, &cs); ROPE[pos * 32 + fi] = cs; ROPE[pos * 32 + 16 + fi] = sn; }
                if (tid < 64) { const float* l = args.in[I_DALAM]; const float s1 = wave_sum(l[tid] * l[64 + tid]), s2 = wave_sum(l[128 + tid] * l[192 + tid]);
                    if (tid == 0) MISC[0] = expf(s1) - expf(s2) + 0.2f; }
            }
        }
        __syncthreads();
        if (p2_tail) { if (blk >= 192) small_items(0, 1024, gw - 192 * 8, 64 * 8); }
        else small_items(0, 1600, gw, ngw);
    }
    PH_END(0)
    PH_BEGIN(1) { row_pass1(args, MOD, HN, gw, ngw, lane); }
    PH_END(1)
    PH_BEGIN(2) { SchedWin S{0, G, blk, (const char*)HN, (const char*)WINT}; EpiWin E{UH, QB, KB, VB, GATES, ROPE};
        pg8::gemm_phase(lds, 2048, 2048, 2048, S, E);
        if (p2_tail) {
            if (blk >= 48 && blk < 176) { const int t_ = (blk - 48) >> 1; s5_tables_task(t_ >> 1, t_ & 1, args, BCAT, WCAT, Lf, (blk - 48) & 1, 1); }
            else if (blk >= 176) small_items(1024, 1600, gw - 176 * 8, (256 - 176) * 8); } }
    PH_END(2)
    PH_BEGIN(3) { }
    PH_END(3)
    PH_BEGIN(4) {
        const unsigned long long s5t0_ = EPI_PROBE == 41 ? __builtin_amdgcn_s_memtime() : 0ull;
        for (int bg = blk; bg < 256; bg += G) {
            const unsigned long long q0_ = EPI_PROBE >= 42 ? __builtin_amdgcn_s_memtime() : 0ull;
            { SchedS5aB S{0, bg, (const char*)UH, (const char*)BCAT}; EpiS5a E{SB}; pg8::gemm_phase(lds, 1024, 512, 512, S, E); }
            const unsigned long long q1_ = EPI_PROBE >= 42 ? __builtin_amdgcn_s_memtime() : 0ull;
            if (tid == 0) __builtin_amdgcn_fence(__ATOMIC_ACQUIRE, "agent");
            asm volatile("s_waitcnt vmcnt(0)" ::: "memory"); __syncthreads();
            s5_scan(args, SB, UH, bg, WCAT);
            asm volatile("s_waitcnt vmcnt(0)" ::: "memory"); __syncthreads();
            if (tid == 0) __builtin_amdgcn_fence(__ATOMIC_ACQUIRE, "agent");
            asm volatile("s_waitcnt vmcnt(0)" ::: "memory"); __syncthreads();
            const unsigned long long q2_ = EPI_PROBE >= 42 ? __builtin_amdgcn_s_memtime() : 0ull;
            { SchedS5cB S{0, bg, (const char*)UH, (const char*)WCAT}; EpiS5c E{YA}; pg8::gemm_phase(lds, 1024, 1024, 1024, S, E); }
            if (EPI_PROBE == 42) eacc_ += q1_ - q0_; if (EPI_PROBE == 43) eacc_ += q2_ - q1_; if (EPI_PROBE == 44) eacc_ += __builtin_amdgcn_s_memtime() - q2_;
        }
        if (EPI_PROBE == 41) eacc_ += __builtin_amdgcn_s_memtime() - s5t0_;
        const int vcu = (G % 8 == 0) ? (blk % 8) * (G / 8) + blk / 8 : blk;
        static_assert(I_WEG == 26 && I_WEU == 27, "CvtSide indexes the expert weights by position");
        att::CvtSide cs; { const int gwv = __builtin_amdgcn_readfirstlane(gw); cs.in = args.in; cs.ws = ws; cs.buf = lds + att::OFF_CVT + (gwv & 7) * 4096; cs.gw = gwv; cs.t = 0; cs.tlim = 0; cs.pend = false; }
        static_assert(I_SUBLN == 21, "attn_unit indexes da_subln by position");
        for (int u2 = 0;; ++u2) { const int i = u2 >> 1, c = u2 & 1, P = i * G + vcu; if (P >= 512) break; cs.tlim = G == 256 ? 8 * (u2 + 1) : 0;
            const int bh = P >> 4, qb = P & 15, b = bh >> 2, h = bh & 3;
            att::attn_unit(QB + ((size_t)b * LT + CL + qb * 256) * 512 + h * 128 + c * 64, KB + (size_t)b * LT * 512 + h * 128 + c * 64, VB + (size_t)b * LT * 512 + h * 128,
                           OC + ((size_t)b * SEQ + qb * 256) * 512 + h * 128, LT, (char*)lds_raw, cs, c, EPI_PROBE == 4 ? &eacc_ : nullptr); }
        if (cs.pend) att::cvt_side_store(cs, lane);
    }
    PH_END(4)
    PH_BEGIN(5) { }
    PH_END(5)
    PH_BEGIN(6) { SchedGlu S{0, G, blk, (const char*)YA, (const char*)WGLUT}; EpiGlu E{YA, YY};
        pg8::gemm_phase(lds, 1024, 1024, 1024, S, E);
        }
    PH_END(6)
    PH_BEGIN(7) { SchedProj S{0, G, blk, 0, 0, 0, (const char*)YY, (const char*)(ws + WS_YB), (const char*)WAT, (const char*)WBT}; EpiProj E{GATES, MB};
        pg8::gemm_phase(lds, 1024, 1024, 1024, S, E, EPI_PROBE == 7 ? &eacc_ : nullptr); }
    PH_END(7)
    PH_BEGIN(8) { SchedOut S{0, G, blk, (const char*)MB, (const char*)WOUTT}; EpiOut E{OB};
        pg8::gemm_phase(lds, 2048, 2048, 2048, S, E, EPI_PROBE == 8 ? &eacc_ : nullptr); }
    PH_END(8)
    PH_BEGIN(9) {
        for (int i = tid; i < 16384; i += 512) Lf[(i & 15) * 1024 + (i >> 4)] = args.in[I_WROUTER][i];
        __syncthreads();
        row_pass2(args, MOD, OB, X1, H2, AFF, Lf, gw, ngw, lane);
    }
    PH_END(9)
    PH_BEGIN(10) {
        for (int be = blk; be < 128; be += G) topk_task(be, AFF, H2, IDX, GATEV, SLOT, XS, (LAS unsigned*)lds);
        if (G == 256 && !SIDE_PROBE) {
            const int it0 = blk >= 128 ? (gw - 1024) * 7 : 7168 + gw, nit = blk >= 128 ? 7 : 1;
            for (int it = it0; it < it0 + nit; ++it) { const int e = it >> 9, r = it & 511, kb = r >> 4, nb = r & 15;
                cvt_item8(args.in[I_WED] + (size_t)e * 2048 * 1024 + (size_t)kb * 64 * 1024 + nb * 64, 1024, WD + ((size_t)e * 1024 + nb * 64) * 2048 + kb * 64, 2048, 4, WSCALE, lane); } }
        else
            for (int it = gw; it < 24576; it += ngw) {
                if (it < 16384) { const int e = it >> 10, r = it & 1023, kb = r >> 6, fb = (r >> 1) & 31, isup = r & 1;
                    cvt_item8(args.in[isup ? I_WEU : I_WEG] + (size_t)e * 1024 * 2048 + (size_t)kb * 64 * 2048 + fb * 64, 2048, WGU + ((size_t)e * 4096 + fb * 128 + isup * 4) * 1024 + kb * 64, 1024, 8, WSCALE, lane); }
                else { const int i2 = it - 16384, e = i2 >> 9, r = i2 & 511, kb = r >> 4, nb = r & 15;
                    cvt_item8(args.in[I_WED] + (size_t)e * 2048 * 1024 + (size_t)kb * 64 * 1024 + nb * 64, 1024, WD + ((size_t)e * 1024 + nb * 64) * 2048 + kb * 64, 2048, 4, WSCALE, lane); } }
    }
    PH_END(10)
    PH_BEGIN(11) { SchedUp S{0, G, blk, (const char*)XS, (const char*)WGU}; EpiUp E{HID};
        pg8::gemm_phase<EpiUp, SchedUp, true>(lds, 1024, 1024, 1024, S, E); }
    PH_END(11)
    PH_BEGIN(12) { SchedDown S{0, G, blk, (const char*)HID, (const char*)WD}; EpiDown E{GATEV, YS};
        pg8::gemm_phase<EpiDown, SchedDown, true>(lds, 2048, 2048, 2048, S, E); }
    PH_END(12)
    PH_BEGIN(13) { row_final(args, MOD, X1, args.out, YS, SLOT, gw, ngw, lane); }
    PH_END(13)
    if (TIME_PHASE >= 0 && blk == 0 && tid == 0) { const unsigned long long d = EPI_PROBE ? eacc_ * (EPI_PROBE >= 41 ? 400000ull : 40000ull) / (c1_ - c0_ + 1ull) : CLOCK_PROBE ? (c1_ - c0_) * 2000ull / (t1_ - t0_ + 1ull) : (t1_ - t0_) * 4ull, e0 = __builtin_amdgcn_s_memrealtime(); while (__builtin_amdgcn_s_memrealtime() - e0 < d) __builtin_amdgcn_s_sleep(10); }
#undef IN
#undef SEAM
}

extern "C" void kernel_launch(void* const* d_in, const int* in_sizes, int n_in, void* d_out, int out_size, void* d_ws, size_t ws_size, hipStream_t stream) {
    static int grid = 0;
    if (grid == 0) {
        if (n_in != 29 || in_sizes[0] != ML * DM || out_size != ML * DM || ws_size < WS_END) {
            fprintf(stderr, "kernel_launch: unexpected shapes: n_in %d in0 %d out %d ws %zu (need %zu)\n", n_in, n_in > 0 ? in_sizes[0] : -1, out_size, ws_size, (size_t)WS_END); grid = -1; return; }
        int dev = 0, cus = 0, per_cu = 0;
        if (hipGetDevice(&dev) != hipSuccess || hipDeviceGetAttribute(&cus, hipDeviceAttributeMultiprocessorCount, dev) != hipSuccess) { grid = -1; return; }
        if (hipFuncSetAttribute((const void*)fwd_kernel, hipFuncAttributeMaxDynamicSharedMemorySize, LDS_BYTES) != hipSuccess) { fprintf(stderr, "kernel_launch: hipFuncSetAttribute failed\n"); grid = -1; return; }
        if (hipOccupancyMaxActiveBlocksPerMultiprocessor(&per_cu, (const void*)fwd_kernel, 512, LDS_BYTES) != hipSuccess || per_cu < 1) { fprintf(stderr, "kernel_launch: occupancy query gave %d\n", per_cu); per_cu = 1; }
        (void)hipGetLastError();
        grid = cus * 1;
        if (grid > 256) grid = 256;
    }
    if (grid < 0) return;
    if (hipMemsetAsync((char*)d_ws + WS_BAR, 0, XCD_BAR_WORDS * 4, stream) != hipSuccess) { fprintf(stderr, "kernel_launch: memset of the barrier words failed\n"); return; }
    Args a{};
    for (int i = 0; i < 29; ++i) a.in[i] = (const float*)d_in[i];
    a.out = (float*)d_out; a.ws = (unsigned char*)d_ws;
#if MK_PER_PHASE
    for (int p = 0; p < N_PHASES; ++p) { a.ph_lo = p; a.ph_hi = p + 1;
        hipLaunchKernelGGL(fwd_kernel, dim3(grid), dim3(512), LDS_BYTES, stream, a);
        const hipError_t le = hipPeekAtLastError();
        if (le != hipSuccess) { fprintf(stderr, "kernel_launch: launch %d failed: %s\n", p, hipGetErrorName(le)); break; } }
#else
    a.ph_lo = 0; a.ph_hi = N_PHASES;
    void* kargs[] = {&a};
    const hipError_t le = hipLaunchCooperativeKernel((const void*)fwd_kernel, dim3(grid), dim3(512), kargs, LDS_BYTES, stream);
    if (le != hipSuccess) fprintf(stderr, "kernel_launch: cooperative launch failed: %s (grid %d)\n", hipGetErrorString(le), grid);
#endif
}
```
